# Optimizing an MI355X kernel written in HIP

```python
import jax, jax.numpy as jnp
from jax import lax
import numpy as np

D_MODEL = 1024
BATCH = 8
SEQ = 2048
DEPTH = 1
DEC_BATCH = 128
DEC_SEQ = 4
PAST_LEN = 16384
PAGE_SIZE = 128

RWKV_HEAD = 64
D_RWKV = D_MODEL // 2
N_RWKV_HEADS = D_RWKV // RWKV_HEAD
DECAY_LORA = 64
AAA_LORA = 64
GATE_LORA = 128
D_SHIFT = 3 * D_RWKV + DECAY_LORA + AAA_LORA + GATE_LORA
D_POOL = D_MODEL - D_RWKV
POOL_WINDOWS = (2, 4, 8, 16)
N_POOL_GROUPS = len(POOL_WINDOWS)
POOL_GROUP = D_POOL // N_POOL_GROUPS
POOL_BUF = max(POOL_WINDOWS) - 1
D_IN = D_SHIFT + D_POOL
N_KEYS = 128
N_EXPERTS = N_KEYS * N_KEYS
PEER_HEADS = 8
PEER_TOPK = 16
PEER_DK = 256
PEER_DK_HALF = PEER_DK // 2
PEER_BLOCK = 128
PLE_DIM = 256
NORM_EPS = 1e-6
LNX_EPS = 64e-5

kernel_name = 'hybrid_rwkv7_pool_peer_step'


def rmsnorm(x, g):
    xf = x.astype(jnp.float32)
    y = xf * lax.rsqrt(jnp.mean(xf * xf, axis=-1, keepdims=True) + NORM_EPS)
    return (y * g.astype(jnp.float32)).astype(x.dtype)


def wkv_scan(s0, r, w, k, v, kk, a):
    def step(s, inp):
        r_t, w_t, k_t, v_t, kk_t, a_t = inp
        s_kk = jnp.einsum('bhij,bhj->bhi', s, -kk_t)
        s = (s * w_t[:, :, None, :]
             + s_kk[..., None] * (kk_t * a_t)[:, :, None, :]
             + v_t[..., None] * k_t[:, :, None, :])
        return s, jnp.einsum('bhij,bhj->bhi', s, r_t)
    xs = tuple(jnp.moveaxis(t.astype(jnp.float32), 1, 0) for t in (r, w, k, v, kk, a))
    s_final, out = lax.scan(step, s0.astype(jnp.float32), xs)
    return jnp.moveaxis(out, 0, 1), s_final


def rwkv7_mix(z, shift_prev, s0, mu, decay_w0, decay_b, a_0, a_b, g_b, k_k, k_a, r_k, lnx_g, lnx_b):
    B, T, _ = z.shape
    z_prev = jnp.concatenate([shift_prev[:, None, :].astype(z.dtype), z[:, :-1]], axis=1)
    zs = z + (z_prev - z) * mu
    r = zs[..., :D_RWKV]
    k = zs[..., D_RWKV:2 * D_RWKV]
    v = zs[..., 2 * D_RWKV:3 * D_RWKV]
    o = 3 * D_RWKV
    zw = zs[..., o:o + DECAY_LORA]
    za = zs[..., o + DECAY_LORA:o + DECAY_LORA + AAA_LORA]
    zg = zs[..., o + DECAY_LORA + AAA_LORA:]
    w_log = -jax.nn.softplus(-(decay_w0 + jnp.tanh(zw) @ decay_b).astype(jnp.float32)) - 0.5
    decay = jnp.exp(-jnp.exp(w_log))
    a = jax.nn.sigmoid(a_0 + za @ a_b)
    g = jax.nn.sigmoid(zg) @ g_b

    def heads(t):
        return t.reshape(B, T, N_RWKV_HEADS, RWKV_HEAD)

    r, k, v, a, decay = heads(r), heads(k), heads(v), heads(a), heads(decay)
    kkf = (k * k_k.reshape(N_RWKV_HEADS, RWKV_HEAD)).astype(jnp.float32)
    kk = kkf / jnp.maximum(jnp.sqrt(jnp.sum(kkf * kkf, axis=-1, keepdims=True)), 1e-12)
    k = k * (1 + (a - 1) * k_a.reshape(N_RWKV_HEADS, RWKV_HEAD))
    out, s_final = wkv_scan(s0, r, decay, k, v, kk, a)
    mean = jnp.mean(out, axis=-1, keepdims=True)
    var = jnp.mean(jnp.square(out - mean), axis=-1, keepdims=True)
    out = ((out - mean) * lax.rsqrt(var + LNX_EPS)).reshape(B, T, D_RWKV)
    out = out * lnx_g.astype(jnp.float32) + lnx_b.astype(jnp.float32)
    bonus = jnp.sum((r * k * r_k).astype(jnp.float32), axis=-1, keepdims=True) * v.astype(jnp.float32)
    y = (out + bonus.reshape(B, T, D_RWKV)) * g.astype(jnp.float32)
    return y.astype(z.dtype), z[:, -1], s_final


def pool_mix(u, buf, start_pos, pool_w, pool_scale):
    B, T, _ = u.shape
    ext = jnp.concatenate([buf.astype(u.dtype), u], axis=1)
    c = jnp.cumsum(ext.astype(jnp.float32), axis=1)
    c = jnp.concatenate([jnp.zeros((B, 1, D_POOL), jnp.float32), c], axis=1)
    pos = start_pos + jnp.arange(T, dtype=jnp.int32)
    lo = POOL_BUF + 1
    diffs = []
    for gi, wdw in enumerate(POOL_WINDOWS):
        sl = slice(gi * POOL_GROUP, (gi + 1) * POOL_GROUP)
        s = c[:, lo:lo + T, sl] - c[:, lo - wdw:lo - wdw + T, sl]
        cnt = jnp.minimum(pos + 1, wdw).astype(jnp.float32)
        diffs.append(s / cnt[None, :, None] - u[:, :, sl].astype(jnp.float32))
    pooled = jnp.stack(diffs, axis=2)
    y = jnp.einsum('btgc,gcd->btgd', pooled, pool_w.astype(jnp.float32)).reshape(B, T, D_POOL)
    y = y * pool_scale.astype(jnp.float32)
    return y.astype(u.dtype), ext[:, -POOL_BUF:]


def peer_ffn(xn, wq, sub_keys, u_tab, v_tab):
    B, T, D = xn.shape
    flat = xn.reshape(-1, D)
    n = flat.shape[0]
    pad = (-n) % PEER_BLOCK
    blocks = jnp.pad(flat, ((0, pad), (0, 0))).reshape(-1, PEER_BLOCK, D)

    def block_fn(xb):
        q = (xb @ wq).reshape(PEER_BLOCK, PEER_HEADS, 2, PEER_DK_HALF)
        s1 = jnp.einsum('thc,nc->thn', q[:, :, 0], sub_keys[0])
        s2 = jnp.einsum('thc,nc->thn', q[:, :, 1], sub_keys[1])
        v1, i1 = lax.top_k(s1, PEER_TOPK)
        v2, i2 = lax.top_k(s2, PEER_TOPK)
        cand = (v1[..., :, None] + v2[..., None, :]).reshape(PEER_BLOCK, PEER_HEADS, PEER_TOPK * PEER_TOPK)
        sc, ci = lax.top_k(cand, PEER_TOPK)
        e1 = jnp.take_along_axis(i1, ci // PEER_TOPK, axis=-1)
        e2 = jnp.take_along_axis(i2, ci % PEER_TOPK, axis=-1)
        expert = e1 * N_KEYS + e2
        gate = jax.nn.softmax(sc.astype(jnp.float32), axis=-1)
        ue = jnp.take(u_tab, expert, axis=0)
        act = jax.nn.gelu(jnp.einsum('thkd,td->thk', ue, xb).astype(jnp.float32), approximate=False) * gate
        ve = jnp.take(v_tab, expert, axis=0)
        return jnp.einsum('thk,thkd->td', act.astype(xb.dtype), ve)

    out = lax.map(block_fn, blocks).reshape(-1, D)[:n]
    return out.reshape(B, T, D)


def hybrid_layer(x, p, start_pos, shift_prev, wkv_prev, pool_prev, lw):
    n1 = rmsnorm(x, lw['norm_mix_g'])
    z = n1 @ lw['w_in']
    y_r, shift_new, wkv_new = rwkv7_mix(
        z[..., :D_SHIFT], shift_prev, wkv_prev, lw['shift_mu'], lw['decay_w0'], lw['decay_b'],
        lw['a_0'], lw['a_b'], lw['g_b'], lw['k_k'], lw['k_a'], lw['r_k'], lw['lnx_g'], lw['lnx_b'])
    y_p, pool_new = pool_mix(z[..., D_SHIFT:], pool_prev, start_pos, lw['pool_w'], lw['pool_scale'])
    h = x + jnp.concatenate([y_r, y_p], axis=-1) @ lw['w_out']
    h = h + peer_ffn(rmsnorm(h, lw['norm_ffn_g']), lw['peer_wq'], lw['peer_keys'], lw['peer_u'], lw['peer_v'])
    gate = jax.nn.sigmoid((rmsnorm(h, lw['norm_ple_g']) @ lw['ple_gate_w']).astype(jnp.float32))
    h = h + ((p @ lw['ple_w']).astype(jnp.float32) * gate).astype(h.dtype)
    return h, shift_new, wkv_new, pool_new


def setup_inputs(seed: int = 0) -> dict:
    key = jax.random.key(seed)
    ks = list(jax.random.split(key, 40))

    def nrm(shape, scale):
        return scale * jax.random.normal(ks.pop(), shape, jnp.float32)

    def unif(shape, lo, hi):
        return jax.random.uniform(ks.pop(), shape, jnp.float32, lo, hi)

    L = DEPTH
    return {
        'x_prompt': nrm((BATCH, SEQ, D_MODEL), 1.0),
        'x_sample': nrm((DEC_BATCH, DEC_SEQ, D_MODEL), 1.0),
        'state_shift': nrm((L, DEC_BATCH, D_SHIFT), 1.0),
        'state_wkv': nrm((L, DEC_BATCH, N_RWKV_HEADS, RWKV_HEAD, RWKV_HEAD), 0.3),
        'state_pool': nrm((L, DEC_BATCH, POOL_BUF, D_POOL), 1.0),
        'p_prompt': nrm((L, BATCH, SEQ, PLE_DIM), 1.0),
        'p_sample': nrm((L, DEC_BATCH, DEC_SEQ, PLE_DIM), 1.0),
        'norm_mix_g': 1.0 + nrm((L, D_MODEL), 0.02),
        'w_in': nrm((L, D_MODEL, D_IN), D_MODEL ** -0.5),
        'shift_mu': unif((L, D_SHIFT), 0.0, 1.0),
        'decay_w0': unif((L, D_RWKV), -4.0, 0.0),
        'decay_b': nrm((L, DECAY_LORA, D_RWKV), 0.1 * DECAY_LORA ** -0.5),
        'a_0': nrm((L, D_RWKV), 0.1),
        'a_b': nrm((L, AAA_LORA, D_RWKV), 0.5 * AAA_LORA ** -0.5),
        'g_b': nrm((L, GATE_LORA, D_RWKV), GATE_LORA ** -0.5),
        'k_k': 0.85 + nrm((L, D_RWKV), 0.05),
        'k_a': 1.0 + nrm((L, D_RWKV), 0.05),
        'r_k': nrm((L, N_RWKV_HEADS, RWKV_HEAD), 0.1),
        'lnx_g': 1.0 + nrm((L, D_RWKV), 0.02),
        'lnx_b': nrm((L, D_RWKV), 0.01),
        'pool_w': nrm((L, N_POOL_GROUPS, POOL_GROUP, POOL_GROUP), POOL_GROUP ** -0.5),
        'pool_scale': 1.0 + nrm((L, D_POOL), 0.02),
        'w_out': nrm((L, D_MODEL, D_MODEL), 0.5 * D_MODEL ** -0.5),
        'norm_ffn_g': 1.0 + nrm((L, D_MODEL), 0.02),
        'peer_wq': nrm((L, D_MODEL, PEER_HEADS * PEER_DK), D_MODEL ** -0.5),
        'peer_keys': nrm((L, 2, N_KEYS, PEER_DK_HALF), PEER_DK_HALF ** -0.5),
        'peer_u': nrm((L, N_EXPERTS, D_MODEL), D_MODEL ** -0.5),
        'peer_v': nrm((L, N_EXPERTS, D_MODEL), 0.2),
        'norm_ple_g': 1.0 + nrm((L, D_MODEL), 0.02),
        'ple_w': nrm((L, PLE_DIM, D_MODEL), PLE_DIM ** -0.5),
        'ple_gate_w': nrm((L, D_MODEL, D_MODEL), D_MODEL ** -0.5),
        'final_norm_g': 1.0 + nrm((D_MODEL,), 0.02),
    }


def reference(x_prompt, x_sample, state_shift, state_wkv, state_pool, p_prompt, p_sample,
              norm_mix_g, w_in, shift_mu, decay_w0, decay_b, a_0, a_b, g_b, k_k, k_a, r_k,
              lnx_g, lnx_b, pool_w, pool_scale, w_out, norm_ffn_g, peer_wq, peer_keys,
              peer_u, peer_v, norm_ple_g, ple_w, ple_gate_w, final_norm_g):
    hp, hs = x_prompt, x_sample
    sh_p, wk_p, po_p, sh_s, wk_s, po_s = [], [], [], [], [], []
    for i in range(DEPTH):
        lw = dict(norm_mix_g=norm_mix_g[i], w_in=w_in[i], shift_mu=shift_mu[i], decay_w0=decay_w0[i],
                  decay_b=decay_b[i], a_0=a_0[i], a_b=a_b[i], g_b=g_b[i], k_k=k_k[i], k_a=k_a[i],
                  r_k=r_k[i], lnx_g=lnx_g[i], lnx_b=lnx_b[i], pool_w=pool_w[i], pool_scale=pool_scale[i],
                  w_out=w_out[i], norm_ffn_g=norm_ffn_g[i], peer_wq=peer_wq[i], peer_keys=peer_keys[i],
                  peer_u=peer_u[i], peer_v=peer_v[i], norm_ple_g=norm_ple_g[i], ple_w=ple_w[i],
                  ple_gate_w=ple_gate_w[i])
        hp, s1, s2, s3 = hybrid_layer(
            hp, p_prompt[i], 0,
            jnp.zeros((BATCH, D_SHIFT), hp.dtype),
            jnp.zeros((BATCH, N_RWKV_HEADS, RWKV_HEAD, RWKV_HEAD), jnp.float32),
            jnp.zeros((BATCH, POOL_BUF, D_POOL), hp.dtype), lw)
        sh_p.append(s1)
        wk_p.append(s2.astype(state_wkv.dtype))
        po_p.append(s3)
        hs, t1, t2, t3 = hybrid_layer(hs, p_sample[i], PAST_LEN, state_shift[i], state_wkv[i], state_pool[i], lw)
        sh_s.append(t1)
        wk_s.append(t2.astype(state_wkv.dtype))
        po_s.append(t3)
    y_prompt = rmsnorm(hp, final_norm_g)
    y_sample = rmsnorm(hs, final_norm_g)
    return (y_prompt, y_sample, jnp.stack(sh_p), jnp.stack(wk_p), jnp.stack(po_p),
            jnp.stack(sh_s), jnp.stack(wk_s), jnp.stack(po_s))
```

```cpp
#include <hip/hip_runtime.h>
#include <hip/hip_bf16.h>
#include <hip/hip_cooperative_groups.h>
#include <stdint.h>
#include <cstdio>
namespace cg = cooperative_groups;

typedef __attribute__((ext_vector_type(8))) short bf16x8;
typedef __attribute__((ext_vector_type(4))) float f32x4;
typedef unsigned short bfraw;

#define NT 16896
#define NPR 16384
#define DM 1024
#define DIN 2304
#define DSH 1792
#define LDP 1088

struct Params {
  const float *x_prompt, *x_sample, *state_shift, *state_wkv, *state_pool, *p_prompt, *p_sample;
  const float *norm_mix_g, *w_in, *shift_mu, *decay_w0, *decay_b, *a_0, *a_b, *g_b, *k_k, *k_a, *r_k;
  const float *lnx_g, *lnx_b, *pool_w, *pool_scale, *w_out, *norm_ffn_g, *peer_wq, *peer_keys;
  const float *peer_u, *peer_v, *norm_ple_g, *ple_w, *ple_gate_w, *final_norm_g;
  float* out;
  bfraw *Wt_in, *Wt_out, *Wt_q, *Wt_pg, *Wt_ple, *Wt_dec, *Wt_a, *Wt_g, *Wt_pool;
  float *ssq1, *rstd2, *ssq3, *bonus;
  unsigned* bar;
  bfraw *regPQ;
  bfraw *regA;
  bfraw *regB;
  bfraw *regY;
  bfraw *regP;
  bfraw *regZ;
  int phase_lo, phase_hi;
};

#define O_Y 0
#define O_SHP 17301504
#define O_WKP 17315840
#define O_POP 17577984
#define O_SHS 17639424
#define O_WKS 17868800
#define O_POS 22063104

typedef float f32x2_ __attribute__((ext_vector_type(2)));
typedef __bf16 bf16x2_t __attribute__((ext_vector_type(2)));
__device__ __forceinline__ unsigned int pack2(float a, float b) {
  f32x2_ v = {a, b};
  bf16x2_t r = __builtin_convertvector(v, bf16x2_t);
  return __builtin_bit_cast(unsigned int, r);
}
__device__ __forceinline__ unsigned short f2bf(float f) { return (unsigned short)(pack2(f, 0.f) & 0xffffu); }
__device__ __forceinline__ float bf2f(unsigned short h) { return __uint_as_float(((unsigned int)h) << 16); }
__device__ __forceinline__ void unpack8(uint4 v, float* f) {
  f[0] = __uint_as_float(v.x << 16); f[1] = __uint_as_float(v.x & 0xffff0000u);
  f[2] = __uint_as_float(v.y << 16); f[3] = __uint_as_float(v.y & 0xffff0000u);
  f[4] = __uint_as_float(v.z << 16); f[5] = __uint_as_float(v.z & 0xffff0000u);
  f[6] = __uint_as_float(v.w << 16); f[7] = __uint_as_float(v.w & 0xffff0000u);
}
__device__ __forceinline__ uint4 pack8(const float* f) {
  uint4 v; v.x = pack2(f[0], f[1]); v.y = pack2(f[2], f[3]); v.z = pack2(f[4], f[5]); v.w = pack2(f[6], f[7]); return v;
}
__device__ __forceinline__ float wsum(float v) {
#pragma unroll
  for (int o = 32; o > 0; o >>= 1) v += __shfl_xor(v, o, 64);
  return v;
}
__device__ __forceinline__ float wmaxf(float v) {
#pragma unroll
  for (int o = 32; o > 0; o >>= 1) v = fmaxf(v, __shfl_xor(v, o, 64));
  return v;
}
__device__ __forceinline__ float sigmoidf_(float x) { return 1.f / (1.f + __expf(-x)); }

#define LROW 80
template <bool SEQ = false, class AL, class BL>
__device__ __forceinline__ void gemm_main(f32x4 (&acc)[4][4], AL aload, BL bload, int K, bfraw* sA, bfraw* sB) {
  int tid0_ = threadIdx.x; asm volatile("" : "+v"(tid0_));
  const int tid = tid0_, lane = tid & 63, wid = tid >> 6, wr = wid >> 1, wc = wid & 1, fr = lane & 15, fq = lane >> 4;
  uint4 ra0[4], rb0[4], ra1[4], rb1[4];
#define G_LOAD(ra_, rb_, kk_) _Pragma("unroll") for (int i = 0; i < 4; ++i) { int ch = tid + 256 * i; ra_[i] = aload(ch >> 3, (kk_) + (ch & 7) * 8); rb_[i] = bload(ch >> 3, (kk_) + (ch & 7) * 8); if (SEQ) __builtin_amdgcn_sched_barrier(0); }
#define G_STORE(ra_, rb_) _Pragma("unroll") for (int i = 0; i < 4; ++i) { int ch = tid + 256 * i; int r = ch >> 3, c = (ch & 7) * 8; *(uint4*)(sA + r * LROW + c) = ra_[i]; *(uint4*)(sB + r * LROW + c) = rb_[i]; }
#define G_COMPUTE _Pragma("unroll") for (int kk = 0; kk < 2; ++kk) { bf16x8 af[4], bfr[4]; \
        _Pragma("unroll") for (int m = 0; m < 4; ++m) af[m] = *(const bf16x8*)(sA + (wr * 64 + m * 16 + fr) * LROW + kk * 32 + fq * 8); \
        _Pragma("unroll") for (int n = 0; n < 4; ++n) bfr[n] = *(const bf16x8*)(sB + (wc * 64 + n * 16 + fr) * LROW + kk * 32 + fq * 8); \
      __builtin_amdgcn_s_setprio(1); \
      _Pragma("unroll") for (int m = 0; m < 4; ++m) _Pragma("unroll") for (int n = 0; n < 4; ++n) \
        acc[m][n] = __builtin_amdgcn_mfma_f32_16x16x32_bf16(af[m], bfr[n], acc[m][n], 0, 0, 0); \
      __builtin_amdgcn_s_setprio(0); }
  G_LOAD(ra0, rb0, 0)
  if (SEQ) {
#pragma unroll 1
    for (int k0 = 0; k0 < K; k0 += 64) {
      __syncthreads();
      G_STORE(ra0, rb0)
      __syncthreads();
      if (k0 + 64 < K) { G_LOAD(ra0, rb0, k0 + 64) }
      G_COMPUTE
    }
    __syncthreads();
    return;
  }
  if (K > 64) { G_LOAD(ra1, rb1, 64) }
#pragma unroll 1
  for (int k0 = 0; k0 < K; k0 += 128) {
    __syncthreads();
    G_STORE(ra0, rb0)
    __syncthreads();
    if (k0 + 128 < K) { G_LOAD(ra0, rb0, k0 + 128) }
    G_COMPUTE
    if (k0 + 64 < K) {
      __syncthreads();
      G_STORE(ra1, rb1)
      __syncthreads();
      if (k0 + 192 < K) { G_LOAD(ra1, rb1, k0 + 192) }
      G_COMPUTE
    }
  }
  __syncthreads();
}
#define ZERO_ACC(acc) _Pragma("unroll") for (int m_ = 0; m_ < 4; ++m_) _Pragma("unroll") for (int n_ = 0; n_ < 4; ++n_) acc[m_][n_] = f32x4{0.f, 0.f, 0.f, 0.f};
#define EPI_VARS const int tid = threadIdx.x, lane = tid & 63, wid = tid >> 6, wr = wid >> 1, wc = wid & 1, fr = lane & 15, fq = lane >> 4; (void)tid;
#define EPI_LOOP _Pragma("unroll") for (int m = 0; m < 4; ++m) _Pragma("unroll") for (int n = 0; n < 4; ++n) _Pragma("unroll") for (int j = 0; j < 4; ++j)
#define EPI_RC const int row = wr * 64 + m * 16 + fq * 4 + j, col = wc * 64 + n * 16 + fr;

__device__ __forceinline__ int swz(int row, int col) { return row * 128 + (col ^ (((row >> 2) & 1) << 4)); }
__device__ __forceinline__ int acc_to_lds_(const f32x4 (&acc)[4][4], float* sS) {
  EPI_VARS
  EPI_LOOP { EPI_RC sS[swz(row, col)] = acc[m][n][j]; }
  __syncthreads();
  int t_ = threadIdx.x; asm volatile("" : "+v"(t_));
  return t_;
}
#define acc_to_lds(acc, sS) const int etid_ = acc_to_lds_(acc, sS);
#define SEG_VARS(i_) const int idx_ = etid_ + 256 * (i_); const int row = idx_ >> 5, c4 = (idx_ & 31) * 4; const float4 v = *(const float4*)(sS + swz(row, c4));

__device__ __forceinline__ bool xcd_job(int it, int nct, int G, int& rt, int& ct) {
  const int x = blockIdx.x & 7, lr = blockIdx.x >> 3, nl = gridDim.x >> 3;
  const int j = lr + it * nl;
  const int nrt = (132 - x + 7) >> 3;
  if (j >= nrt * nct) return false;
  const int per = nrt * G; const int grp = j / per, rem = j - grp * per;
  rt = (rem / G) * 8 + x; ct = grp * G + rem % G;
  return true;
}

struct PlainLoad {
  const bfraw* base; int ld;
  __device__ __forceinline__ uint4 operator()(int r, int k) const { return *(const uint4*)(base + (size_t)r * ld + k); }
};

__device__ __forceinline__ void row_ssq_store(float (&ps)[4][4], float* sred, float* dst  ) {
  EPI_VARS
#pragma unroll
  for (int m = 0; m < 4; ++m)
#pragma unroll
    for (int j = 0; j < 4; ++j) {
      float v = ps[m][j];
      v += __shfl_xor(v, 1, 64); v += __shfl_xor(v, 2, 64); v += __shfl_xor(v, 4, 64); v += __shfl_xor(v, 8, 64);
      if (fr == 0) sred[wc * 128 + wr * 64 + m * 16 + fq * 4 + j] = v;
    }
  __syncthreads();
  if (tid < 128) dst[tid] = sred[tid] + sred[128 + tid];
  __syncthreads();
}

__device__ void transpose_tile(const float* src, int R, int C, bfraw* dst, const float* scale, int tile, float* sT, int dld = 0) {
  if (dld == 0) dld = R;
  int tc = C / 64; int tk = tile / tc, tn = tile % tc; int k0 = tk * 64, n0 = tn * 64;
  int tid = threadIdx.x, c = tid & 63, r0 = tid >> 6;
  __syncthreads();
  for (int i = 0; i < 16; ++i) { int r = r0 + 4 * i; sT[r * 65 + c] = src[(size_t)(k0 + r) * C + n0 + c]; }
  __syncthreads();
  float sc = scale ? scale[k0 + c] : 1.f;
  for (int i = 0; i < 16; ++i) { int r = r0 + 4 * i; dst[(size_t)(n0 + r) * dld + k0 + c] = f2bf(sT[c * 65 + r] * sc); }
}

__device__ void fold_job(const Params& P, int job, float* sm) {
  int hp = job >> 5, rem = job & 31, kt = rem >> 1, keyt = rem & 1;
  int p = hp & 1;
  float* sK = sm; float* sW = sm + 64 * 65;
  int tid = threadIdx.x, tx = tid & 15, ty = tid >> 4;
  float acc[4][4];
#pragma unroll
  for (int i = 0; i < 4; ++i)
#pragma unroll
    for (int j = 0; j < 4; ++j) acc[i][j] = 0.f;
  for (int ch = 0; ch < 2; ++ch) {
    __syncthreads();
    int c = tid & 63, r0 = tid >> 6;
    for (int i = 0; i < 16; ++i) {
      int r = r0 + 4 * i;
      sK[r * 65 + c] = P.peer_keys[((size_t)p * 128 + keyt * 64 + r) * 128 + ch * 64 + c];
      sW[r * 65 + c] = P.peer_wq[(size_t)(kt * 64 + r) * 2048 + hp * 128 + ch * 64 + c];
    }
    __syncthreads();
    for (int cc = 0; cc < 64; ++cc) {
      float kv[4], wv[4];
#pragma unroll
      for (int i = 0; i < 4; ++i) { kv[i] = sK[(ty * 4 + i) * 65 + cc]; wv[i] = sW[(tx * 4 + i) * 65 + cc]; }
#pragma unroll
      for (int i = 0; i < 4; ++i)
#pragma unroll
        for (int j = 0; j < 4; ++j) acc[i][j] += kv[i] * wv[j];
    }
  }
#pragma unroll
  for (int i = 0; i < 4; ++i) {
    int key = keyt * 64 + ty * 4 + i; int k = kt * 64 + tx * 4;
    float g0 = P.norm_ffn_g[k], g1 = P.norm_ffn_g[k + 1], g2 = P.norm_ffn_g[k + 2], g3 = P.norm_ffn_g[k + 3];
    uint2 v; v.x = pack2(acc[i][0] * g0, acc[i][1] * g1); v.y = pack2(acc[i][2] * g2, acc[i][3] * g3);
    *(uint2*)(P.Wt_q + (size_t)(hp * 128 + key) * 1024 + k) = v;
  }
}

__device__ __forceinline__ const float* xrow(const Params& P, int tau) {
  return tau < NPR ? P.x_prompt + (size_t)tau * 1024 : P.x_sample + (size_t)(tau - NPR) * 1024;
}

__device__ void prep_transpose(const Params& P, int t, float* sT) {
  if (t < 576) transpose_tile(P.w_in, 1024, 2304, P.Wt_in, nullptr, t, sT, LDP);
  else if (t < 832) transpose_tile(P.w_out, 1024, 1024, P.Wt_out, nullptr, t - 576, sT);
  else if (t < 1088) transpose_tile(P.ple_gate_w, 1024, 1024, P.Wt_pg, P.norm_ple_g, t - 832, sT);
  else if (t < 1152) transpose_tile(P.ple_w, 256, 1024, P.Wt_ple, nullptr, t - 1088, sT);
  else if (t < 1160) transpose_tile(P.decay_b, 64, 512, P.Wt_dec, nullptr, t - 1152, sT);
  else if (t < 1168) transpose_tile(P.a_b, 64, 512, P.Wt_a, nullptr, t - 1160, sT);
  else if (t < 1184) transpose_tile(P.g_b, 128, 512, P.Wt_g, nullptr, t - 1168, sT);
  else { int u = t - 1184; int gi = u >> 2; transpose_tile(P.pool_w + gi * 16384, 128, 128, P.Wt_pool + gi * 16384, nullptr, u & 3, sT); }
}
__device__ void late_prep_job(const Params& P, int job, char* smem) {
  if (job < 576) prep_transpose(P, 576 + job, (float*)smem);
  else fold_job(P, job - 576, (float*)smem);
}
#define N_LATE_PREP 1088

__device__ void phase0(const Params& P, char* smem) {
  const int NJ_RMS = NT / 4, NJ_TR = 576 + 48, NJ_POOLCP = 704;
  const int total = NJ_RMS + NJ_TR + NJ_POOLCP;
  int tid = threadIdx.x, lane = tid & 63, wid = tid >> 6;
  for (int job = blockIdx.x; job < total; job += gridDim.x) {
    if (job < NJ_RMS) {
      int tau = job * 4 + wid;
      const float* xr = xrow(P, tau);
      float4 v[4]; float ss = 0.f;
#pragma unroll
      for (int j = 0; j < 4; ++j) { v[j] = *(const float4*)(xr + lane * 4 + 256 * j); ss += v[j].x * v[j].x + v[j].y * v[j].y + v[j].z * v[j].z + v[j].w * v[j].w; }
      ss = wsum(ss);
      float rs = rsqrtf(ss * (1.f / 1024.f) + 1e-6f);
#pragma unroll
      for (int j = 0; j < 4; ++j) {
        float4 g = *(const float4*)(P.norm_mix_g + lane * 4 + 256 * j);
        uint2 o; o.x = pack2(v[j].x * rs * g.x, v[j].y * rs * g.y); o.y = pack2(v[j].z * rs * g.z, v[j].w * rs * g.w);
        *(uint2*)(P.regA + (size_t)tau * LDP + lane * 4 + 256 * j) = o;
      }
    } else if (job < NJ_RMS + NJ_TR) {
      int t = job - NJ_RMS;
      prep_transpose(P, t < 576 ? t : 1152 + (t - 576), (float*)smem);
    } else {
      int e0 = (job - NJ_RMS - NJ_TR) * 1024 + tid * 4;
      if (e0 < 128 * 11 * 512) {
        int b = e0 / (11 * 512), rem = e0 % (11 * 512), j = rem / 512, c = rem % 512;
        float4 v = *(const float4*)(P.state_pool + ((size_t)b * 15 + j + 4) * 512 + c);
        *(float4*)(P.out + O_POS + ((size_t)b * 15 + j) * 512 + c) = v;
      }
    }
  }
}

__device__ void phase1(const Params& P, char* smem) {
  bfraw* sA = (bfraw*)smem; bfraw* sB = sA + 128 * LROW;
  const int nct = DIN / 128;
  for (int it = 0;; ++it) {
    int rt, ct; if (!xcd_job(it, nct, 9, rt, ct)) break; int row0 = rt * 128, col0 = ct * 128;
    f32x4 acc[4][4]; ZERO_ACC(acc)
    gemm_main(acc, PlainLoad{P.regA + (size_t)row0 * LDP, LDP}, PlainLoad{P.Wt_in + (size_t)col0 * LDP, LDP}, 1024, sA, sB);
    float* sS = (float*)smem;
    acc_to_lds(acc, sS);
#pragma unroll 4
    for (int i = 0; i < 16; ++i) {
      SEG_VARS(i)
      int tau = row0 + row, c = col0 + c4;
      uint2 o; o.x = pack2(v.x, v.y); o.y = pack2(v.z, v.w);
      *(uint2*)(P.regZ + (size_t)tau * DIN + c) = o;
      if (tau < NPR) {
        int t = tau & 2047, b = tau >> 11;
        if (c < DSH) { if (t == 2047) *(float4*)(P.out + O_SHP + b * DSH + c) = v; }
        else if (t >= 2033) *(float4*)(P.out + O_POP + ((size_t)b * 15 + (t - 2033)) * 512 + (c - DSH)) = v;
      } else {
        int s = tau - NPR, b = s >> 2, t = s & 3;
        if (c < DSH) { if (t == 3) *(float4*)(P.out + O_SHS + b * DSH + c) = v; }
        else *(float4*)(P.out + O_POS + ((size_t)b * 15 + 11 + t) * 512 + (c - DSH)) = v;
      }
    }
  }
}

struct LoraLoad {
  const Params* P; int row0; int cb; int mode;
  __device__ __forceinline__ uint4 operator()(int r, int k) const {
    int tau = row0 + r; int zc = cb + k;
    float z[8], zp[8];
    unpack8(*(const uint4*)(P->regZ + (size_t)tau * DIN + zc), z);
    bool first; int b;
    if (tau < NPR) { first = (tau & 2047) == 0; b = 0; } else { int s = tau - NPR; first = (s & 3) == 0; b = s >> 2; }
    if (!first) unpack8(*(const uint4*)(P->regZ + (size_t)(tau - 1) * DIN + zc), zp);
    else if (tau < NPR) { for (int i = 0; i < 8; ++i) zp[i] = 0.f; }
    else {
      float4 a = *(const float4*)(P->state_shift + (size_t)b * DSH + zc), c = *(const float4*)(P->state_shift + (size_t)b * DSH + zc + 4);
      zp[0] = a.x; zp[1] = a.y; zp[2] = a.z; zp[3] = a.w; zp[4] = c.x; zp[5] = c.y; zp[6] = c.z; zp[7] = c.w;
    }
    float4 m0 = *(const float4*)(P->shift_mu + zc), m1 = *(const float4*)(P->shift_mu + zc + 4);
    float mu[8] = {m0.x, m0.y, m0.z, m0.w, m1.x, m1.y, m1.z, m1.w};
    float o[8];
#pragma unroll
    for (int i = 0; i < 8; ++i) {
      float zs = z[i] + (zp[i] - z[i]) * mu[i];
      o[i] = mode == 0 ? (1.f - 2.f / (1.f + __expf(2.f * zs))) : (mode == 1 ? zs : sigmoidf_(zs));
    }
    return pack8(o);
  }
};

struct PoolLoad {
  const Params* P; int row0; int gi;
  __device__ __forceinline__ uint4 operator()(int r, int k) const {
    int tau = row0 + r; int pc = gi * 128 + k; int zc = DSH + pc; int w = 2 << gi;
    float u[8], s[8], t8[8];
    unpack8(*(const uint4*)(P->regZ + (size_t)tau * DIN + zc), u);
#pragma unroll
    for (int i = 0; i < 8; ++i) s[i] = u[i];
    float cnt;
    if (tau < NPR) {
      int t = tau & 2047; int nv = min(t + 1, w); cnt = (float)nv;
      for (int d = 1; d < nv; ++d) {
        unpack8(*(const uint4*)(P->regZ + (size_t)(tau - d) * DIN + zc), t8);
#pragma unroll
        for (int i = 0; i < 8; ++i) s[i] += t8[i];
      }
    } else {
      int sidx = tau - NPR, b = sidx >> 2, t = sidx & 3; cnt = (float)w;
      for (int d = 1; d < w; ++d) {
        if (t - d >= 0) unpack8(*(const uint4*)(P->regZ + (size_t)(tau - d) * DIN + zc), t8);
        else {
          const float* sp = P->state_pool + ((size_t)b * 15 + (15 + t - d)) * 512 + pc;
          float4 a = *(const float4*)sp, c = *(const float4*)(sp + 4);
          t8[0] = a.x; t8[1] = a.y; t8[2] = a.z; t8[3] = a.w; t8[4] = c.x; t8[5] = c.y; t8[6] = c.z; t8[7] = c.w;
        }
#pragma unroll
        for (int i = 0; i < 8; ++i) s[i] += t8[i];
      }
    }
    float inv = 1.f / cnt; float o[8];
#pragma unroll
    for (int i = 0; i < 8; ++i) o[i] = s[i] * inv - u[i];
    return pack8(o);
  }
};

__device__ void phase2(const Params& P, char* smem) {
  bfraw* sA = (bfraw*)smem; bfraw* sB = sA + 128 * LROW;
  float* Wd = (float*)P.regA; bfraw* Aa = P.regB; bfraw* Gg = P.regB + (size_t)NT * 512;
  for (int job = blockIdx.x; job < 4224; job += gridDim.x) {
    int item = job * 256 + threadIdx.x; int tau = item >> 6, chunk = item & 63;
    PoolLoad pl{&P, 0, chunk >> 4};
    *(uint4*)(P.regP + (size_t)tau * 512 + chunk * 8) = pl(tau, (chunk & 15) * 8);
  }
  for (int job = blockIdx.x; job < 1584; job += gridDim.x) {
    int kind = job / 528, jj = job % 528, rt = jj >> 2, ct = jj & 3; int row0 = rt * 128;
    f32x4 acc[4][4]; ZERO_ACC(acc)
    float* sS = (float*)smem;
    if (kind == 0) {
      gemm_main<true>(acc, LoraLoad{&P, row0, 1536, 0}, PlainLoad{P.Wt_dec + (size_t)ct * 128 * 64, 64}, 64, sA, sB);
      acc_to_lds(acc, sS);
#pragma unroll 4
      for (int i = 0; i < 16; ++i) { SEG_VARS(i) int c = ct * 128 + c4;
        float4 w0 = *(const float4*)(P.decay_w0 + c); float4 o;
        o.x = __expf(-0.6065306597f * sigmoidf_(w0.x + v.x)); o.y = __expf(-0.6065306597f * sigmoidf_(w0.y + v.y));
        o.z = __expf(-0.6065306597f * sigmoidf_(w0.z + v.z)); o.w = __expf(-0.6065306597f * sigmoidf_(w0.w + v.w));
        *(float4*)(Wd + (size_t)(row0 + row) * 512 + c) = o; }
    } else if (kind == 1) {
      gemm_main<true>(acc, LoraLoad{&P, row0, 1600, 1}, PlainLoad{P.Wt_a + (size_t)ct * 128 * 64, 64}, 64, sA, sB);
      acc_to_lds(acc, sS);
#pragma unroll 4
      for (int i = 0; i < 16; ++i) { SEG_VARS(i) int c = ct * 128 + c4;
        float4 a0 = *(const float4*)(P.a_0 + c); uint2 o;
        o.x = pack2(sigmoidf_(a0.x + v.x), sigmoidf_(a0.y + v.y)); o.y = pack2(sigmoidf_(a0.z + v.z), sigmoidf_(a0.w + v.w));
        *(uint2*)(Aa + (size_t)(row0 + row) * 512 + c) = o; }
    } else if (kind == 2) {
      gemm_main<true>(acc, LoraLoad{&P, row0, 1664, 2}, PlainLoad{P.Wt_g + (size_t)ct * 128 * 128, 128}, 128, sA, sB);
      acc_to_lds(acc, sS);
#pragma unroll 4
      for (int i = 0; i < 16; ++i) { SEG_VARS(i) int c = ct * 128 + c4;
        uint2 o; o.x = pack2(v.x, v.y); o.y = pack2(v.z, v.w);
        *(uint2*)(Gg + (size_t)(row0 + row) * 512 + c) = o; }
    }
  }
}

__device__ void wkv_direct(const Params& P, int unit, float* sw) {
  const int lane = threadIdx.x & 63;
  const float* Wd = (const float*)P.regA; const bfraw* Aa = P.regB; const bfraw* Gg = P.regB + (size_t)NT * 512;
  bool prompt = unit < 64; int b, h, T, tok0;
  if (prompt) { b = unit >> 3; h = unit & 7; T = 2048; tok0 = b * 2048; }
  else { int u = unit - 64; b = u >> 3; h = u & 7; T = 4; tok0 = NPR + 4 * b; }
  float S[64];
  if (prompt) {
#pragma unroll
    for (int j = 0; j < 64; ++j) S[j] = 0.f;
  } else {
    const float* sp = P.state_wkv + (((size_t)b * 8 + h) * 64 + lane) * 64;
#pragma unroll
    for (int j = 0; j < 16; ++j) { float4 v = *(const float4*)(sp + j * 4); S[j * 4] = v.x; S[j * 4 + 1] = v.y; S[j * 4 + 2] = v.z; S[j * 4 + 3] = v.w; }
  }
  const int hc = h * 64 + lane;
  const float mu_r = P.shift_mu[hc], mu_k = P.shift_mu[512 + hc], mu_v = P.shift_mu[1024 + hc];
  const float kkw = P.k_k[hc], kaw = P.k_a[hc], rkw = P.r_k[hc], lg = P.lnx_g[hc], lb = P.lnx_b[hc];
  float pr, pk, pv;
  if (prompt) { pr = pk = pv = 0.f; }
  else { const float* ss = P.state_shift + (size_t)b * DSH; pr = ss[hc]; pk = ss[512 + hc]; pv = ss[1024 + hc]; }
  float* s_kk = sw; float* s_w = sw + 64; float* s_ka = sw + 128; float* s_k = sw + 192; float* s_r = sw + 256;
  for (int t = 0; t < T; ++t) {
    int tau = tok0 + t;
    const bfraw* zr = P.regZ + (size_t)tau * DIN;
    float zr_ = bf2f(zr[hc]), zk_ = bf2f(zr[512 + hc]), zv_ = bf2f(zr[1024 + hc]);
    float r = zr_ + (pr - zr_) * mu_r, k = zk_ + (pk - zk_) * mu_k, v = zv_ + (pv - zv_) * mu_v;
    pr = zr_; pk = zk_; pv = zv_;
    float a = bf2f(Aa[(size_t)tau * 512 + hc]), w = Wd[(size_t)tau * 512 + hc], g = bf2f(Gg[(size_t)tau * 512 + hc]);
    float kkf = k * kkw; float nrm = sqrtf(wsum(kkf * kkf)); float kk = kkf / fmaxf(nrm, 1e-12f);
    float k2 = k * (1.f + (a - 1.f) * kaw);
    float ka = kk * a;
    float bsum = wsum(r * k2 * rkw);
    __builtin_amdgcn_wave_barrier();
    s_kk[lane] = kk; s_w[lane] = w; s_ka[lane] = ka; s_k[lane] = k2; s_r[lane] = r;
    __builtin_amdgcn_wave_barrier();
    float skk = 0.f;
#pragma unroll
    for (int j = 0; j < 16; ++j) { float4 q = *(const float4*)(s_kk + j * 4); skk += S[j * 4] * q.x + S[j * 4 + 1] * q.y + S[j * 4 + 2] * q.z + S[j * 4 + 3] * q.w; }
    skk = -skk;
    float o = 0.f;
#pragma unroll
    for (int j = 0; j < 16; ++j) {
      float4 qw = *(const float4*)(s_w + j * 4), qa = *(const float4*)(s_ka + j * 4), qk = *(const float4*)(s_k + j * 4), qr = *(const float4*)(s_r + j * 4);
      S[j * 4] = S[j * 4] * qw.x + skk * qa.x + v * qk.x; o += S[j * 4] * qr.x;
      S[j * 4 + 1] = S[j * 4 + 1] * qw.y + skk * qa.y + v * qk.y; o += S[j * 4 + 1] * qr.y;
      S[j * 4 + 2] = S[j * 4 + 2] * qw.z + skk * qa.z + v * qk.z; o += S[j * 4 + 2] * qr.z;
      S[j * 4 + 3] = S[j * 4 + 3] * qw.w + skk * qa.w + v * qk.w; o += S[j * 4 + 3] * qr.w;
    }
    float mean = wsum(o) * (1.f / 64.f); float dd = o - mean; float var = wsum(dd * dd) * (1.f / 64.f);
    float y = (dd * rsqrtf(var + 64e-5f) * lg + lb + bsum * v) * g;
    P.regY[(size_t)tau * 1024 + hc] = f2bf(y);
  }
  float* so = P.out + (prompt ? O_WKP : O_WKS) + (((size_t)b * 8 + h) * 64 + lane) * 64;
#pragma unroll
  for (int j = 0; j < 16; ++j) *(float4*)(so + j * 4) = make_float4(S[j * 4], S[j * 4 + 1], S[j * 4 + 2], S[j * 4 + 3]);
}

#define MFMA16(a, b, c) __builtin_amdgcn_mfma_f32_16x16x32_bf16(a, b, c, 0, 0, 0)
__device__ void wkv_chunk_pre(const Params& P, int unit, char* smem) {
  const int tid = threadIdx.x, lane = tid & 63, w = tid >> 6, fr = lane & 15, fq = lane >> 4;
  bfraw* Ah = (bfraw*)smem; bfraw* Bh = Ah + 2304; bfraw* Kh = Bh + 2304; bfraw* Rh = Kh + 2304;
  bfraw* AhT = Rh + 2304;
  bfraw* Vt = AhT + 2560; bfraw* NakT = Vt + 2560; bfraw* MbrT = NakT + 1280; bfraw* MkrT = MbrT + 1280; bfraw* Tt = MkrT + 1280;
  bfraw* VN = Tt + 1280; bfraw* nAt = VN + 2560; bfraw* nD0 = nAt + 2560;
  float* G = (float*)(nD0 + 2560);
  float* gC = G + 2048;
  float* NabT = G;
  const float* Wd = (const float*)P.regA; const bfraw* Aa = P.regB;
  const int b = unit >> 9, h = (unit >> 6) & 7, c = unit & 63;
  const int tok0 = b * 2048 + c * 32;
  __syncthreads();
  {
    const int t = tid >> 3, jg = tid & 7, j0 = jg * 8, hc = h * 64 + j0;
    const int tau = tok0 + t;
    const bool first = (c == 0 && t == 0);
    const bfraw* zr = P.regZ + (size_t)tau * DIN;
    float zr_[8], zk_[8], zv_[8], pr[8], pk[8], pv[8];
    unpack8(*(const uint4*)(zr + hc), zr_); unpack8(*(const uint4*)(zr + 512 + hc), zk_); unpack8(*(const uint4*)(zr + 1024 + hc), zv_);
    if (!first) { unpack8(*(const uint4*)(zr - DIN + hc), pr); unpack8(*(const uint4*)(zr - DIN + 512 + hc), pk); unpack8(*(const uint4*)(zr - DIN + 1024 + hc), pv); }
    else {
#pragma unroll
      for (int i = 0; i < 8; ++i) { pr[i] = 0.f; pk[i] = 0.f; pv[i] = 0.f; }
    }
    float a[8], wd[8], r[8], k[8], v[8], kk[8], k2[8];
    unpack8(*(const uint4*)(Aa + (size_t)tau * 512 + hc), a);
    { float4 x = *(const float4*)(Wd + (size_t)tau * 512 + hc), y = *(const float4*)(Wd + (size_t)tau * 512 + hc + 4);
      wd[0] = x.x; wd[1] = x.y; wd[2] = x.z; wd[3] = x.w; wd[4] = y.x; wd[5] = y.y; wd[6] = y.z; wd[7] = y.w; }
    float ss = 0.f, bs = 0.f;
#pragma unroll
    for (int i = 0; i < 8; ++i) {
      float mr = P.shift_mu[hc + i], mk = P.shift_mu[512 + hc + i], mv = P.shift_mu[1024 + hc + i];
      r[i] = zr_[i] + (pr[i] - zr_[i]) * mr; k[i] = zk_[i] + (pk[i] - zk_[i]) * mk; v[i] = zv_[i] + (pv[i] - zv_[i]) * mv;
      float kkf = k[i] * P.k_k[hc + i]; kk[i] = kkf; ss += kkf * kkf;
      k2[i] = k[i] * (1.f + (a[i] - 1.f) * P.k_a[hc + i]);
      bs += r[i] * k2[i] * P.r_k[hc + i];
    }
    ss += __shfl_xor(ss, 1, 64); ss += __shfl_xor(ss, 2, 64); ss += __shfl_xor(ss, 4, 64);
    bs += __shfl_xor(bs, 1, 64); bs += __shfl_xor(bs, 2, 64); bs += __shfl_xor(bs, 4, 64);
    if (jg == 0) P.bonus[(size_t)tau * 8 + h] = bs;
    float inv = 1.f / fmaxf(sqrtf(ss), 1e-12f);
    *(float4*)(G + t * 64 + j0) = make_float4(wd[0], wd[1], wd[2], wd[3]);
    *(float4*)(G + t * 64 + j0 + 4) = make_float4(wd[4], wd[5], wd[6], wd[7]);
    __syncthreads();
    if (tid < 64) {
      float g = 1.f;
      for (int t2 = 0; t2 < 32; ++t2) { g *= G[t2 * 64 + tid]; G[t2 * 64 + tid] = g; }
      gC[tid] = g;
    }
    __syncthreads();
    float ah[8], bh[8], kh[8], rh[8];
#pragma unroll
    for (int i = 0; i < 8; ++i) {
      float gt = G[t * 64 + j0 + i]; float gp = t > 0 ? G[(t - 1) * 64 + j0 + i] : 1.f; float ig = 1.f / gt;
      float kkn = kk[i] * inv;
      ah[i] = kkn * gp; bh[i] = kkn * a[i] * ig; kh[i] = k2[i] * ig; rh[i] = r[i] * gt;
    }
    uint4 pa = pack8(ah);
    *(uint4*)(Ah + t * 72 + j0) = pa; *(uint4*)(Bh + t * 72 + j0) = pack8(bh); *(uint4*)(Kh + t * 72 + j0) = pack8(kh); *(uint4*)(Rh + t * 72 + j0) = pack8(rh);
    unsigned int paw[4] = {pa.x, pa.y, pa.z, pa.w};
#pragma unroll
    for (int i = 0; i < 8; ++i) {
      AhT[(j0 + i) * 40 + t] = (bfraw)((i & 1) ? (paw[i >> 1] >> 16) : (paw[i >> 1] & 0xffffu));
      Vt[(j0 + i) * 40 + t] = f2bf(v[i]);
    }
  }
  __syncthreads();
  const f32x4 z4 = {0.f, 0.f, 0.f, 0.f};
  {
    const bfraw* Xp = (w & 1) ? Kh : Bh; const bfraw* Yp = (w >> 1) ? Rh : Ah;
    f32x4 acc[2][2] = {{z4, z4}, {z4, z4}};
#pragma unroll
    for (int ks = 0; ks < 2; ++ks) {
      bf16x8 xa[2], yb[2];
#pragma unroll
      for (int mt = 0; mt < 2; ++mt) { xa[mt] = *(const bf16x8*)(Xp + (mt * 16 + fr) * 72 + ks * 32 + fq * 8); yb[mt] = *(const bf16x8*)(Yp + (mt * 16 + fr) * 72 + ks * 32 + fq * 8); }
#pragma unroll
      for (int mt = 0; mt < 2; ++mt)
#pragma unroll
        for (int nt = 0; nt < 2; ++nt) acc[mt][nt] = MFMA16(xa[mt], yb[nt], acc[mt][nt]);
    }
    bfraw* dst = (w == 1) ? NakT : (w == 2 ? MbrT : MkrT);
#pragma unroll
    for (int mt = 0; mt < 2; ++mt)
#pragma unroll
      for (int nt = 0; nt < 2; ++nt)
#pragma unroll
        for (int jj = 0; jj < 4; ++jj) {
          int ta = mt * 16 + fq * 4 + jj, tt = nt * 16 + fr; float val = acc[mt][nt][jj];
          if (w == 0) NabT[tt * 32 + ta] = (ta < tt) ? val : 0.f;
          else { bool keep = (w == 1) ? (ta < tt) : (ta <= tt); dst[tt * 40 + ta] = f2bf(keep ? val : 0.f); }
        }
  }
  __syncthreads();
  const bf16x8 xv = *(const bf16x8*)(Vt + (16 * w + fr) * 40 + fq * 8);
  {
#pragma unroll
    for (int nt = 0; nt < 2; ++nt) {
      bf16x8 yb = *(const bf16x8*)(NakT + (nt * 16 + fr) * 40 + fq * 8);
      f32x4 acc = MFMA16(xv, yb, z4);
#pragma unroll
      for (int jj = 0; jj < 4; ++jj) VN[(16 * w + fq * 4 + jj) * 40 + nt * 16 + fr] = f2bf(acc[jj]);
    }
  }
  if (w == 0 && lane < 32) {
    float Tr[32];
#pragma unroll
    for (int t = 0; t < 32; ++t) {
      float a0 = (lane == t) ? 1.f : 0.f, a1 = 0.f, a2 = 0.f, a3 = 0.f;
#pragma unroll
      for (int q = 0; q < (t + 3) / 4; ++q) {
        float4 nv = *(const float4*)(NabT + t * 32 + q * 4);
        a0 -= Tr[q * 4] * nv.x;
        if (q * 4 + 1 < t) a1 -= Tr[q * 4 + 1] * nv.y;
        if (q * 4 + 2 < t) a2 -= Tr[q * 4 + 2] * nv.z;
        if (q * 4 + 3 < t) a3 -= Tr[q * 4 + 3] * nv.w;
      }
      float acc = (a0 + a1) + (a2 + a3);
      Tr[t] = acc;
      Tt[t * 40 + lane] = f2bf(acc);
    }
  }
  __syncthreads();
  bf16x8 xn, xd;
  {
    bf16x8 xa = *(const bf16x8*)(AhT + (16 * w + fr) * 40 + fq * 8);
    bf16x8 xvn = *(const bf16x8*)(VN + (16 * w + fr) * 40 + fq * 8);
#pragma unroll
    for (int nt = 0; nt < 2; ++nt) {
      bf16x8 yb = *(const bf16x8*)(Tt + (nt * 16 + fr) * 40 + fq * 8);
      f32x4 aA = MFMA16(xa, yb, z4), aD = MFMA16(xvn, yb, z4);
#pragma unroll
      for (int jj = 0; jj < 4; ++jj) {
        nAt[(16 * w + fq * 4 + jj) * 40 + nt * 16 + fr] = f2bf(-aA[jj]);
        nD0[(16 * w + fq * 4 + jj) * 40 + nt * 16 + fr] = f2bf(-aD[jj]);
      }
    }
    __builtin_amdgcn_wave_barrier();
    xn = *(const bf16x8*)(nAt + (16 * w + fr) * 40 + fq * 8);
    xd = *(const bf16x8*)(nD0 + (16 * w + fr) * 40 + fq * 8);
  }
  char* pq = (char*)P.regPQ + (size_t)unit * 12288;
  char* lo = (char*)P.out + (size_t)unit * 12288;
  bfraw* PmT = (bfraw*)pq; bfraw* QT = (bfraw*)(pq + 8192);
  uint2* Lb = (uint2*)lo; uint2* Ob = (uint2*)(lo + 8192);
#pragma unroll
  for (int nt = 0; nt < 2; ++nt) {
    bf16x8 ymb = *(const bf16x8*)(MbrT + (nt * 16 + fr) * 40 + fq * 8), ymk = *(const bf16x8*)(MkrT + (nt * 16 + fr) * 40 + fq * 8);
    f32x4 aQ = MFMA16(xn, ymb, z4);
    f32x4 aO = MFMA16(xv, ymk, z4); aO = MFMA16(xd, ymb, aO);
    int tt = nt * 16 + fr; float q[4];
#pragma unroll
    for (int jj = 0; jj < 4; ++jj) q[jj] = aQ[jj] + bf2f(Rh[tt * 72 + 16 * w + fq * 4 + jj]);
    uint2 o; o.x = pack2(q[0], q[1]); o.y = pack2(q[2], q[3]);
    *(uint2*)(QT + tt * 64 + 16 * w + fq * 4) = o;
    uint2 o2; o2.x = pack2(aO[0], aO[1]); o2.y = pack2(aO[2], aO[3]);
    Ob[(w * 2 + nt) * 64 + lane] = o2;
  }
#pragma unroll
  for (int nt = 0; nt < 4; ++nt) {
    bf16x8 ybB, ybK;
#pragma unroll
    for (int e = 0; e < 8; ++e) { ybB[e] = (short)Bh[(fq * 8 + e) * 72 + nt * 16 + fr]; ybK[e] = (short)Kh[(fq * 8 + e) * 72 + nt * 16 + fr]; }
    f32x4 aP = MFMA16(xn, ybB, z4);
    f32x4 aL = MFMA16(xv, ybK, z4); aL = MFMA16(xd, ybB, aL);
    int jp = nt * 16 + fr; float gc = gC[jp]; float pm[4], l[4];
#pragma unroll
    for (int jj = 0; jj < 4; ++jj) { int j = 16 * w + fq * 4 + jj; pm[jj] = gc * ((j == jp ? 1.f : 0.f) + aP[jj]); l[jj] = gc * aL[jj]; }
    uint2 o; o.x = pack2(pm[0], pm[1]); o.y = pack2(pm[2], pm[3]);
    *(uint2*)(PmT + jp * 64 + 16 * w + fq * 4) = o;
    uint2 o2; o2.x = pack2(l[0], l[1]); o2.y = pack2(l[2], l[3]);
    Lb[(w * 4 + nt) * 64 + lane] = o2;
  }
}

__device__ __forceinline__ f32x4 unpack4(uint2 u) {
  f32x4 r; r[0] = __uint_as_float(u.x << 16); r[1] = __uint_as_float(u.x & 0xffff0000u); r[2] = __uint_as_float(u.y << 16); r[3] = __uint_as_float(u.y & 0xffff0000u); return r;
}
struct SeqOps { bf16x8 pm[4][2]; bf16x8 qt[2][2]; uint2 l[4]; uint2 o0[2]; };
__device__ __forceinline__ void seq_load(const Params& P, int bh, int c, int w, int lane, SeqOps& o) {
  const int fr = lane & 15, fq = lane >> 4;
  const int unit = bh * 64 + (c < 63 ? c : 63);
  const char* pq = (const char*)P.regPQ + (size_t)unit * 12288; const char* lo = (const char*)P.out + (size_t)unit * 12288;
  const bfraw* PmT = (const bfraw*)pq; const bfraw* QT = (const bfraw*)(pq + 8192);
  const uint2* Lb = (const uint2*)lo; const uint2* Ob = (const uint2*)(lo + 8192);
#pragma unroll
  for (int nt = 0; nt < 4; ++nt)
#pragma unroll
    for (int ks = 0; ks < 2; ++ks) o.pm[nt][ks] = *(const bf16x8*)(PmT + (nt * 16 + fr) * 64 + ks * 32 + fq * 8);
#pragma unroll
  for (int nt = 0; nt < 2; ++nt)
#pragma unroll
    for (int ks = 0; ks < 2; ++ks) o.qt[nt][ks] = *(const bf16x8*)(QT + (nt * 16 + fr) * 64 + ks * 32 + fq * 8);
#pragma unroll
  for (int nt = 0; nt < 4; ++nt) o.l[nt] = Lb[(w * 4 + nt) * 64 + lane];
#pragma unroll
  for (int nt = 0; nt < 2; ++nt) o.o0[nt] = Ob[(w * 2 + nt) * 64 + lane];
}
__device__ __forceinline__ void seq_step(const Params& P, int b, int h, int c, int w, int lane, float* strip, f32x4 (&S)[4], const SeqOps& o) {
  const int fr = lane & 15, fq = lane >> 4;
  bfraw* Oraw = (bfraw*)((char*)P.out + 50331648);
  __builtin_amdgcn_wave_barrier();
#pragma unroll
  for (int nt = 0; nt < 4; ++nt)
#pragma unroll
    for (int jj = 0; jj < 4; ++jj) strip[(fq * 4 + jj) * 68 + nt * 16 + fr] = S[nt][jj];
  __builtin_amdgcn_wave_barrier();
  bf16x8 xh[2], xl[2];
#pragma unroll
  for (int ks = 0; ks < 2; ++ks) {
    float4 p0 = *(const float4*)(strip + fr * 68 + ks * 32 + fq * 8), p1 = *(const float4*)(strip + fr * 68 + ks * 32 + fq * 8 + 4);
    float xs[8] = {p0.x, p0.y, p0.z, p0.w, p1.x, p1.y, p1.z, p1.w};
    unsigned int hp[4], lp[4];
#pragma unroll
    for (int e = 0; e < 4; ++e) {
      hp[e] = pack2(xs[2 * e], xs[2 * e + 1]);
      lp[e] = pack2(xs[2 * e] - __uint_as_float(hp[e] << 16), xs[2 * e + 1] - __uint_as_float(hp[e] & 0xffff0000u));
    }
    xh[ks] = __builtin_bit_cast(bf16x8, make_uint4(hp[0], hp[1], hp[2], hp[3]));
    xl[ks] = __builtin_bit_cast(bf16x8, make_uint4(lp[0], lp[1], lp[2], lp[3]));
  }
  f32x4 aO[2];
#pragma unroll
  for (int nt = 0; nt < 2; ++nt) {
    aO[nt] = unpack4(o.o0[nt]);
#pragma unroll
    for (int ks = 0; ks < 2; ++ks) { aO[nt] = MFMA16(xh[ks], o.qt[nt][ks], aO[nt]); aO[nt] = MFMA16(xl[ks], o.qt[nt][ks], aO[nt]); }
  }
#pragma unroll
  for (int nt = 0; nt < 4; ++nt) {
    f32x4 aS = unpack4(o.l[nt]);
#pragma unroll
    for (int ks = 0; ks < 2; ++ks) { aS = MFMA16(xh[ks], o.pm[nt][ks], aS); aS = MFMA16(xl[ks], o.pm[nt][ks], aS); }
    S[nt] = aS;
  }
  const int tok0 = b * 2048 + c * 32;
#pragma unroll
  for (int nt = 0; nt < 2; ++nt) {
    uint2 ov; ov.x = pack2(aO[nt][0], aO[nt][1]); ov.y = pack2(aO[nt][2], aO[nt][3]);
    *(uint2*)(Oraw + (size_t)(tok0 + nt * 16 + fr) * 512 + h * 64 + 16 * w + fq * 4) = ov;
  }
}
__device__ void wkv_seq(const Params& P, int bh, char* smem) {
  const int tid = threadIdx.x, lane = tid & 63, w = tid >> 6, fr = lane & 15, fq = lane >> 4;
  float* strip = (float*)smem + w * 16 * 68;
  const int b = bh >> 3, h = bh & 7;
  f32x4 S[4];
#pragma unroll
  for (int nt = 0; nt < 4; ++nt) S[nt] = f32x4{0.f, 0.f, 0.f, 0.f};
  SeqOps o0, o1, o2;
  seq_load(P, bh, 0, w, lane, o0);
  seq_load(P, bh, 1, w, lane, o1);
#pragma unroll 1
  for (int c = 0; c < 66; c += 3) {
    seq_load(P, bh, c + 2, w, lane, o2);
    seq_step(P, b, h, c, w, lane, strip, S, o0);
    seq_load(P, bh, c + 3, w, lane, o0);
    if (c + 1 < 64) seq_step(P, b, h, c + 1, w, lane, strip, S, o1);
    seq_load(P, bh, c + 4, w, lane, o1);
    if (c + 2 < 64) seq_step(P, b, h, c + 2, w, lane, strip, S, o2);
  }
  float* so = P.out + O_WKP + ((size_t)bh * 64) * 64;
#pragma unroll
  for (int nt = 0; nt < 4; ++nt)
#pragma unroll
    for (int jj = 0; jj < 4; ++jj) so[(16 * w + fq * 4 + jj) * 64 + nt * 16 + fr] = S[nt][jj];
}

__device__ __forceinline__ int next_job(unsigned* ctr, float* sred) {
  __syncthreads();
  if (threadIdx.x == 0) ((int*)sred)[200] = (int)atomicAdd(ctr, 1u);
  __syncthreads();
  return ((int*)sred)[200];
}

__device__ void phase3a(const Params& P, char* smem) {
  for (int unit = blockIdx.x; unit < 4096; unit += gridDim.x) wkv_chunk_pre(P, unit, smem);
}

__device__ void phase3b(const Params& P, char* smem, float* sred) {
  int wid = threadIdx.x >> 6;
  bfraw* sA = (bfraw*)smem; bfraw* sB = sA + 128 * LROW;
  if (blockIdx.x < 64) { wkv_seq(P, blockIdx.x, smem); return; }
  for (;;) { int job = next_job(P.bar + 3648, sred); if (job >= 256) break; wkv_direct(P, 64 + job * 4 + wid, (float*)smem + wid * 320); }
  for (;;) { int job = next_job(P.bar + 3712, sred); if (job >= 512) break; late_prep_job(P, 576 + job, smem); }
  for (;;) {
    int job = next_job(P.bar + 3776, sred); if (job >= 528) break;
    int rt = job >> 2, gi = job & 3; int row0 = rt * 128;
    f32x4 acc[4][4]; ZERO_ACC(acc)
    float* sS = (float*)smem;
    gemm_main(acc, PlainLoad{P.regP + (size_t)row0 * 512 + gi * 128, 512}, PlainLoad{P.Wt_pool + (size_t)gi * 16384, 128}, 128, sA, sB);
    acc_to_lds(acc, sS);
#pragma unroll 4
    for (int i = 0; i < 16; ++i) { SEG_VARS(i) int c = gi * 128 + c4;
      float4 ps = *(const float4*)(P.pool_scale + c);
      uint2 o; o.x = pack2(v.x * ps.x, v.y * ps.y); o.y = pack2(v.z * ps.z, v.w * ps.w);
      *(uint2*)(P.regY + (size_t)(row0 + row) * 1024 + 512 + c) = o; }
  }
  for (;;) { int job = next_job(P.bar + 3840, sred); if (job >= 576) break; late_prep_job(P, job, smem); }
}

__device__ void phase3c(const Params& P) {
  const int lane = threadIdx.x & 63, wid = threadIdx.x >> 6;
  const bfraw* Oraw = (const bfraw*)((const char*)P.out + 50331648);
  const bfraw* Gg = P.regB + (size_t)NT * 512;
  const int c0 = lane * 8, hd = lane >> 3;
  float mu[8], lg[8], lb[8];
  { float4 a = *(const float4*)(P.shift_mu + 1024 + c0), c = *(const float4*)(P.shift_mu + 1024 + c0 + 4);
    mu[0] = a.x; mu[1] = a.y; mu[2] = a.z; mu[3] = a.w; mu[4] = c.x; mu[5] = c.y; mu[6] = c.z; mu[7] = c.w;
    a = *(const float4*)(P.lnx_g + c0); c = *(const float4*)(P.lnx_g + c0 + 4);
    lg[0] = a.x; lg[1] = a.y; lg[2] = a.z; lg[3] = a.w; lg[4] = c.x; lg[5] = c.y; lg[6] = c.z; lg[7] = c.w;
    a = *(const float4*)(P.lnx_b + c0); c = *(const float4*)(P.lnx_b + c0 + 4);
    lb[0] = a.x; lb[1] = a.y; lb[2] = a.z; lb[3] = a.w; lb[4] = c.x; lb[5] = c.y; lb[6] = c.z; lb[7] = c.w; }
#pragma unroll 2
  for (int tau = blockIdx.x * 4 + wid; tau < NPR; tau += gridDim.x * 4) {
    const bool first = (tau & 2047) == 0;
    float o[8], zv[8], pv[8], g[8];
    unpack8(*(const uint4*)(Oraw + (size_t)tau * 512 + c0), o);
    unpack8(*(const uint4*)(P.regZ + (size_t)tau * DIN + 1024 + c0), zv);
    unpack8(*(const uint4*)(P.regZ + (size_t)(first ? tau : tau - 1) * DIN + 1024 + c0), pv);
    unpack8(*(const uint4*)(Gg + (size_t)tau * 512 + c0), g);
    const float bon = P.bonus[(size_t)tau * 8 + hd];
    float sm = 0.f;
#pragma unroll
    for (int i = 0; i < 8; ++i) sm += o[i];
    sm += __shfl_xor(sm, 1, 64); sm += __shfl_xor(sm, 2, 64); sm += __shfl_xor(sm, 4, 64);
    const float mean = sm * (1.f / 64.f);
    float sq = 0.f;
#pragma unroll
    for (int i = 0; i < 8; ++i) { o[i] -= mean; sq += o[i] * o[i]; }
    sq += __shfl_xor(sq, 1, 64); sq += __shfl_xor(sq, 2, 64); sq += __shfl_xor(sq, 4, 64);
    const float rs = rsqrtf(sq * (1.f / 64.f) + 64e-5f);
    float y[8];
#pragma unroll
    for (int i = 0; i < 8; ++i) {
      float p = first ? 0.f : pv[i];
      float v = zv[i] + (p - zv[i]) * mu[i];
      y[i] = (o[i] * rs * lg[i] + lb[i] + bon * v) * g[i];
    }
    *(uint4*)(P.regY + (size_t)tau * 1024 + c0) = pack8(y);
  }
}

__device__ void phase4(const Params& P, char* smem, float* sred) {
  bfraw* sA = (bfraw*)smem; bfraw* sB = sA + 128 * LROW;
  bfraw* hb = P.regA;
  const int NG = 132 * 8, NCONV = 8192;
  for (int it = 0;; ++it) {
    {
      int rt, ct; if (!xcd_job(it, 8, 8, rt, ct)) break; int row0 = rt * 128, col0 = ct * 128;
      f32x4 acc[4][4]; ZERO_ACC(acc)
      gemm_main(acc, PlainLoad{P.regY + (size_t)row0 * 1024, 1024}, PlainLoad{P.Wt_out + (size_t)col0 * 1024, 1024}, 1024, sA, sB);
      float* sS = (float*)smem;
      acc_to_lds(acc, sS);
#pragma unroll 4
      for (int i = 0; i < 16; ++i) { SEG_VARS(i)
        int tau = row0 + row, c = col0 + c4;
        float4 xv = *(const float4*)(xrow(P, tau) + c);
        float4 h; h.x = xv.x + v.x; h.y = xv.y + v.y; h.z = xv.z + v.z; h.w = xv.w + v.w;
        *(float4*)(P.out + (size_t)tau * 1024 + c) = h;
        uint2 o; o.x = pack2(h.x, h.y); o.y = pack2(h.z, h.w);
        *(uint2*)(hb + (size_t)tau * 1024 + c) = o;
        float ss = h.x * h.x + h.y * h.y + h.z * h.z + h.w * h.w;
        ss += __shfl_xor(ss, 1, 64); ss += __shfl_xor(ss, 2, 64); ss += __shfl_xor(ss, 4, 64); ss += __shfl_xor(ss, 8, 64); ss += __shfl_xor(ss, 16, 64);
        if ((etid_ & 31) == 0) P.ssq1[(size_t)ct * NT + tau] = ss; }
    }
  }
  for (;;) {
    int job = NG + next_job(P.bar + 3904, sred) * 4; if (job >= NG + NCONV) break;
    for (int jq = 0; jq < 4; ++jq, ++job) {
      size_t e0 = ((size_t)(job - NG) * 256 + threadIdx.x) * 16;
      const bool isu = e0 < (size_t)16777216;
      const float* src = isu ? P.peer_u + e0 : P.peer_v + (e0 - 16777216);
      const float sc = isu ? 256.f : 32.f;
      unsigned int wv[4];
#pragma unroll
      for (int q = 0; q < 4; ++q) {
        float4 a = *(const float4*)(src + q * 4);
        int wq = __builtin_amdgcn_cvt_pk_fp8_f32(a.x * sc, a.y * sc, 0, false);
        wq = __builtin_amdgcn_cvt_pk_fp8_f32(a.z * sc, a.w * sc, wq, true);
        wv[q] = (unsigned int)wq;
      }
      *(uint4*)((unsigned char*)P.regZ + e0) = make_uint4(wv[0], wv[1], wv[2], wv[3]);
    }
  }
}

struct PLoad {
  const Params* P; int row0;
  __device__ __forceinline__ uint4 operator()(int r, int k) const {
    int tau = row0 + r;
    const float* pr = (tau < NPR ? P->p_prompt + (size_t)tau * 256 : P->p_sample + (size_t)(tau - NPR) * 256) + k;
    float4 a = *(const float4*)pr, c = *(const float4*)(pr + 4);
    uint4 o; o.x = pack2(a.x, a.y); o.y = pack2(a.z, a.w); o.z = pack2(c.x, c.y); o.w = pack2(c.z, c.w); return o;
  }
};
#define TK_INS(x) { _Pragma("unroll") for (int i_ = 15; i_ > 0; --i_) s[i_] = __builtin_amdgcn_fmed3f(s[i_ - 1], s[i_], x); s[0] = fmaxf(s[0], x); }
__device__ void phase5(const Params& P, char* smem, float* sred) {
  bfraw* sA = (bfraw*)smem; bfraw* sB = sA + 128 * LROW;
  const bfraw* hb = P.regA; float* TK = (float*)P.regB;
  float* sS = (float*)smem;
  for (int it = 0;; ++it) {
    int rt, ct; if (!xcd_job(it, 16, 8, rt, ct)) break; int row0 = rt * 128, col0 = ct * 128;
    EPI_VARS
    if (tid < 128) {
      float s = 0.f;
#pragma unroll
      for (int c = 0; c < 8; ++c) s += P.ssq1[(size_t)c * NT + row0 + tid];
      sred[tid] = rsqrtf(s * (1.f / 1024.f) + 1e-6f);
    }
    f32x4 acc[4][4]; ZERO_ACC(acc)
    gemm_main<true>(acc, PlainLoad{hb + (size_t)row0 * 1024, 1024}, PlainLoad{P.Wt_q + (size_t)col0 * 1024, 1024}, 1024, sA, sB);
    EPI_LOOP { EPI_RC
      float v = acc[m][n][j] * sred[row];
      unsigned int bits = (__float_as_uint(v) & ~127u) | (unsigned)col;
      sS[row * 128 + (col ^ (row & 31))] = __uint_as_float(bits); }
    __syncthreads();
    int tk_ = threadIdx.x; asm volatile("" : "+v"(tk_));
    int r = tk_ & 127, q = tk_ >> 7;
    float s[16];
#pragma unroll
    for (int i = 0; i < 16; ++i) s[i] = -3.0e38f;
    for (int i = 0; i < 64; ++i) { float x = sS[r * 128 + ((q * 64 + i) ^ (r & 31))]; TK_INS(x) }
    __syncthreads();
    if (q == 1) {
#pragma unroll
      for (int i = 0; i < 16; ++i) sS[r * 17 + i] = s[i];
    }
    __syncthreads();
    if (q == 0) {
#pragma unroll
      for (int i = 0; i < 16; ++i) { float x = sS[r * 17 + i]; TK_INS(x) }
      float* dst = TK + (size_t)(row0 + r) * 256 + ct * 16;
#pragma unroll
      for (int i = 0; i < 4; ++i) *(float4*)(dst + i * 4) = make_float4(s[i * 4], s[i * 4 + 1], s[i * 4 + 2], s[i * 4 + 3]);
    }
    __syncthreads();
  }
  for (;;) {
    int job = next_job(P.bar + 3968, sred); if (job >= 132 * 8) break;
    int rt = job >> 3, ct = job & 7; int row0 = rt * 128, col0 = ct * 128;
    f32x4 acc[4][4]; ZERO_ACC(acc)
    gemm_main(acc, PLoad{&P, row0}, PlainLoad{P.Wt_ple + (size_t)col0 * 256, 256}, 256, sA, sB);
    acc_to_lds(acc, sS);
#pragma unroll 4
    for (int i = 0; i < 16; ++i) { SEG_VARS(i)
      uint2 o; o.x = pack2(v.x, v.y); o.y = pack2(v.z, v.w);
      *(uint2*)(P.regY + (size_t)(row0 + row) * 1024 + col0 + c4) = o; }
  }
}

typedef float f32x2 __attribute__((ext_vector_type(2)));
__device__ __forceinline__ float gelu_exact(float x) { return 0.5f * x * (1.f + erff(x * 0.70710678118f)); }
__device__ __forceinline__ float dot16_fp8(uint4 r, const f32x2 (&xn2)[8]) {
  f32x2 acc = __builtin_amdgcn_cvt_pk_f32_fp8((int)r.x, false) * xn2[0];
  acc += __builtin_amdgcn_cvt_pk_f32_fp8((int)r.x, true) * xn2[1];
  acc += __builtin_amdgcn_cvt_pk_f32_fp8((int)r.y, false) * xn2[2];
  acc += __builtin_amdgcn_cvt_pk_f32_fp8((int)r.y, true) * xn2[3];
  acc += __builtin_amdgcn_cvt_pk_f32_fp8((int)r.z, false) * xn2[4];
  acc += __builtin_amdgcn_cvt_pk_f32_fp8((int)r.z, true) * xn2[5];
  acc += __builtin_amdgcn_cvt_pk_f32_fp8((int)r.w, false) * xn2[6];
  acc += __builtin_amdgcn_cvt_pk_f32_fp8((int)r.w, true) * xn2[7];
  return acc.x + acc.y;
}
__device__ __forceinline__ void axpy16_fp8(uint4 r, float a, f32x2 (&o2)[8]) {
  f32x2 a2 = {a, a};
  o2[0] += a2 * __builtin_amdgcn_cvt_pk_f32_fp8((int)r.x, false);
  o2[1] += a2 * __builtin_amdgcn_cvt_pk_f32_fp8((int)r.x, true);
  o2[2] += a2 * __builtin_amdgcn_cvt_pk_f32_fp8((int)r.y, false);
  o2[3] += a2 * __builtin_amdgcn_cvt_pk_f32_fp8((int)r.y, true);
  o2[4] += a2 * __builtin_amdgcn_cvt_pk_f32_fp8((int)r.z, false);
  o2[5] += a2 * __builtin_amdgcn_cvt_pk_f32_fp8((int)r.z, true);
  o2[6] += a2 * __builtin_amdgcn_cvt_pk_f32_fp8((int)r.w, false);
  o2[7] += a2 * __builtin_amdgcn_cvt_pk_f32_fp8((int)r.w, true);
}
__device__ __forceinline__ float reduce8(const float (&p)[8], int lane) {
  float q[4], r[2], s;
  const bool b0 = lane & 1, b1 = lane & 2, b2 = lane & 4;
#pragma unroll
  for (int k = 0; k < 4; ++k) { float send = b0 ? p[k] : p[k + 4]; float keep = b0 ? p[k + 4] : p[k]; q[k] = keep + __shfl_xor(send, 1, 64); }
#pragma unroll
  for (int k = 0; k < 2; ++k) { float send = b1 ? q[k] : q[k + 2]; float keep = b1 ? q[k + 2] : q[k]; r[k] = keep + __shfl_xor(send, 2, 64); }
  { float send = b2 ? r[0] : r[1]; float keep = b2 ? r[1] : r[0]; s = keep + __shfl_xor(send, 4, 64); }
  s += __shfl_xor(s, 8, 64); s += __shfl_xor(s, 16, 64); s += __shfl_xor(s, 32, 64);
  return s;
}
#define PEER_LOAD(buf, tab, bt) _Pragma("unroll") for (int k_ = 0; k_ < 8; ++k_) { int e_ = __builtin_amdgcn_readfirstlane(sexp[(bt) * 8 + k_]); buf[k_] = *(const uint4*)(tab + (size_t)e_ * 1024 + lane * 16); }
#define PEER_UCOMP(buf, bt) { float p_[8]; _Pragma("unroll") for (int k_ = 0; k_ < 8; ++k_) p_[k_] = dot16_fp8(buf[k_], xn2); float s_ = reduce8(p_, lane); \
    if ((lane >> 3) == ((bt) & 7)) { if ((bt) < 8) d0 = s_; else d1 = s_; } }
#define PEER_VCOMP(buf, bt) { float asel_ = (bt) < 8 ? act0 : act1; _Pragma("unroll") for (int k_ = 0; k_ < 8; ++k_) { \
    const int br_ = ((k_ & 1) << 2) | (k_ & 2) | ((k_ >> 2) & 1); \
    float a_ = __uint_as_float((unsigned)__builtin_amdgcn_readlane((int)__float_as_uint(asel_), (((bt) & 7) << 3) | br_)); axpy16_fp8(buf[k_], a_, o2); } }

__device__ void peer_token(const Params& P, int tau, float* sw, bool dry = false) {
  const int lane = threadIdx.x & 63;
  float* scand = sw; int* sexp = (int*)(sw + 64); float* sgate = sw + 192;
  const unsigned char* U8 = (const unsigned char*)P.regZ; const unsigned char* V8 = U8 + (size_t)16777216;
  float* hrow = P.out + (size_t)tau * 1024;
  float x[16]; f32x2 xn2[8];
#pragma unroll
  for (int j = 0; j < 4; ++j) { float4 a = *(const float4*)(hrow + lane * 16 + j * 4); x[j * 4] = a.x; x[j * 4 + 1] = a.y; x[j * 4 + 2] = a.z; x[j * 4 + 3] = a.w; }
  float ss = 0.f;
#pragma unroll
  for (int i = 0; i < 16; ++i) ss += x[i] * x[i];
  ss = wsum(ss);
  const float rstd = rsqrtf(ss * (1.f / 1024.f) + 1e-6f) * (1.f / 256.f);
#pragma unroll
  for (int j = 0; j < 4; ++j) {
    float4 g = *(const float4*)(P.norm_ffn_g + lane * 16 + j * 4);
    xn2[j * 2] = f32x2{x[j * 4] * rstd * g.x, x[j * 4 + 1] * rstd * g.y};
    xn2[j * 2 + 1] = f32x2{x[j * 4 + 2] * rstd * g.z, x[j * 4 + 3] * rstd * g.w};
  }
  int ca, cb; { int c = lane;
    if (c < 16) { ca = 0; cb = c; } else if (c < 24) { ca = 1; cb = c - 16; } else if (c < 29) { ca = 2; cb = c - 24; }
    else if (c < 33) { ca = 3; cb = c - 29; } else if (c < 36) { ca = 4; cb = c - 33; } else if (c < 38) { ca = 5; cb = c - 36; }
    else if (c < 40) { ca = 6; cb = c - 38; } else if (c < 42) { ca = 7; cb = c - 40; } else if (c < 50) { ca = c - 34; cb = 0; } else { ca = 0; cb = 0; } }
  const float* tk = (const float*)P.regB + (size_t)tau * 256;
  for (int hh = 0; hh < 8; ++hh) {
    float k1 = tk[(hh * 2) * 16 + ca], k2 = tk[(hh * 2 + 1) * 16 + cb];
    float s = lane < 50 ? k1 + k2 : -3.0e38f;
    __builtin_amdgcn_wave_barrier();
    scand[lane] = s;
    __builtin_amdgcn_wave_barrier();
    int rank = 0;
#pragma unroll
    for (int c4 = 0; c4 < 13; ++c4) {
      float4 q = *(const float4*)(scand + c4 * 4);
      rank += (q.x > s || (q.x == s && c4 * 4 < lane)) ? 1 : 0;
      rank += (q.y > s || (q.y == s && c4 * 4 + 1 < lane)) ? 1 : 0;
      if (c4 < 12) { rank += (q.z > s || (q.z == s && c4 * 4 + 2 < lane)) ? 1 : 0; rank += (q.w > s || (q.w == s && c4 * 4 + 3 < lane)) ? 1 : 0; }
    }
    bool sel = lane < 50 && rank < 16;
    float mx = wmaxf(s);
    float e = sel ? __expf(s - mx) : 0.f;
    float Z = wsum(e);
    if (sel) { sexp[hh * 16 + rank] = (int)((__float_as_uint(k1) & 127u) * 128u + (__float_as_uint(k2) & 127u)); sgate[hh * 16 + rank] = e / Z; }
  }
  __builtin_amdgcn_wave_barrier();
  float d0 = 0.f, d1 = 0.f;
  uint4 A[8], B[8];
  PEER_LOAD(A, U8, 0)
  for (int b2 = 0; b2 < 8; ++b2) {
    PEER_LOAD(B, U8, 2 * b2 + 1)
    PEER_UCOMP(A, 2 * b2)
    if (b2 < 7) { PEER_LOAD(A, U8, 2 * b2 + 2) } else { PEER_LOAD(A, V8, 0) }
    PEER_UCOMP(B, 2 * b2 + 1)
  }
  const int slotA = (lane & ~7) | ((lane & 1) << 2) | (lane & 2) | ((lane >> 2) & 1);
  const float act0 = gelu_exact(d0) * sgate[slotA] * (1.f / 32.f), act1 = gelu_exact(d1) * sgate[64 + slotA] * (1.f / 32.f);
  f32x2 o2[8];
#pragma unroll
  for (int i = 0; i < 8; ++i) o2[i] = f32x2{0.f, 0.f};
  for (int b2 = 0; b2 < 8; ++b2) {
    PEER_LOAD(B, V8, 2 * b2 + 1)
    PEER_VCOMP(A, 2 * b2)
    if (b2 < 7) { PEER_LOAD(A, V8, 2 * b2 + 2) }
    PEER_VCOMP(B, 2 * b2 + 1)
  }
  float o[16]; float s2 = 0.f;
#pragma unroll
  for (int i = 0; i < 8; ++i) { o[2 * i] = x[2 * i] + o2[i].x; o[2 * i + 1] = x[2 * i + 1] + o2[i].y; }
#pragma unroll
  for (int i = 0; i < 16; ++i) s2 += o[i] * o[i];
  s2 = wsum(s2);
  if (dry) { if (s2 == 123.456f) P.rstd2[tau] = s2; return; }
  if (lane == 0) P.rstd2[tau] = rsqrtf(s2 * (1.f / 1024.f) + 1e-6f);
  bfraw* hb = P.regA + (size_t)tau * 1024;
#pragma unroll
  for (int j = 0; j < 4; ++j) *(float4*)(hrow + lane * 16 + j * 4) = make_float4(o[j * 4], o[j * 4 + 1], o[j * 4 + 2], o[j * 4 + 3]);
  *(uint4*)(hb + lane * 16) = pack8(o); *(uint4*)(hb + lane * 16 + 8) = pack8(o + 8);
}

__device__ void phase6(const Params& P, char* smem, bool dry = false) {
  const int wid = threadIdx.x >> 6, lane = threadIdx.x & 63;
  float* sw = (float*)smem + wid * 320;
  unsigned* ctr = P.bar + 3584;
  int t0 = 0; if (lane == 0) t0 = (int)atomicAdd(ctr, 1u);
  int tau = __builtin_amdgcn_readfirstlane(t0);
  while (tau < NT) {
    int tn = 0; if (lane == 0) tn = (int)atomicAdd(ctr, 1u);
    peer_token(P, tau, sw, dry);
    tau = __builtin_amdgcn_readfirstlane(tn);
  }
}

__device__ void phase7(const Params& P, char* smem, float* sred) {
  bfraw* sA = (bfraw*)smem; bfraw* sB = sA + 128 * LROW;
  const bfraw* hb = P.regA;
  for (int it = 0;; ++it) {
    int rt, ct; if (!xcd_job(it, 8, 8, rt, ct)) break; int row0 = rt * 128, col0 = ct * 128;
    f32x4 acc[4][4]; ZERO_ACC(acc)
    float* sS = (float*)smem;
    gemm_main(acc, PlainLoad{hb + (size_t)row0 * 1024, 1024}, PlainLoad{P.Wt_pg + (size_t)col0 * 1024, 1024}, 1024, sA, sB);
    acc_to_lds(acc, sS);
#pragma unroll 2
    for (int i = 0; i < 16; ++i) { SEG_VARS(i)
      int tau = row0 + row, c = col0 + c4;
      float rs = P.rstd2[tau];
      float4 hv = *(float4*)(P.out + (size_t)tau * 1024 + c);
      uint2 ep = *(const uint2*)(P.regY + (size_t)tau * 1024 + c);
      hv.x += __uint_as_float(ep.x << 16) * sigmoidf_(v.x * rs);
      hv.y += __uint_as_float(ep.x & 0xffff0000u) * sigmoidf_(v.y * rs);
      hv.z += __uint_as_float(ep.y << 16) * sigmoidf_(v.z * rs);
      hv.w += __uint_as_float(ep.y & 0xffff0000u) * sigmoidf_(v.w * rs);
      *(float4*)(P.out + (size_t)tau * 1024 + c) = hv;
      float ss = hv.x * hv.x + hv.y * hv.y + hv.z * hv.z + hv.w * hv.w;
      ss += __shfl_xor(ss, 1, 64); ss += __shfl_xor(ss, 2, 64); ss += __shfl_xor(ss, 4, 64); ss += __shfl_xor(ss, 8, 64); ss += __shfl_xor(ss, 16, 64);
      if ((etid_ & 31) == 0) P.ssq3[(size_t)ct * NT + tau] = ss; }
  }
}

__device__ void phase8(const Params& P) {
  for (int job = blockIdx.x; job < NT; job += gridDim.x) {
    int tau = job; int c = threadIdx.x * 4;
    float s = 0.f;
#pragma unroll
    for (int i = 0; i < 8; ++i) s += P.ssq3[(size_t)i * NT + tau];
    float rs = rsqrtf(s * (1.f / 1024.f) + 1e-6f);
    float4 v = *(float4*)(P.out + (size_t)tau * 1024 + c); float4 g = *(const float4*)(P.final_norm_g + c);
    v.x *= rs * g.x; v.y *= rs * g.y; v.z *= rs * g.z; v.w *= rs * g.w;
    *(float4*)(P.out + (size_t)tau * 1024 + c) = v;
  }
}


#define XB_TMO      128
#define XB_XCNT(j)  (256  + 64 * (j))
#define XB_XSUB(j)  (1280 + 64 * (j))
#define XB_XGEN(j)  (2304 + 64 * (j))
#define XB_TOP      3328
#define XB_TOPGEN   3392
#define XCD_BAR_WORDS 3456
#define XB_SPIN_CAP (1u << 18)
#define LAS __attribute__((address_space(3)))
__device__ __forceinline__ unsigned xb_ld(unsigned* p)              { return __hip_atomic_load(p, __ATOMIC_RELAXED, __HIP_MEMORY_SCOPE_AGENT); }
__device__ __forceinline__ unsigned xb_add(unsigned* p, unsigned v) { return __hip_atomic_fetch_add(p, v, __ATOMIC_RELAXED, __HIP_MEMORY_SCOPE_AGENT); }
__device__ __forceinline__ unsigned xb_xcc_id() { return (unsigned)__builtin_amdgcn_s_getreg((3 << 11) | 20) & 0xFu; }
#define XB_SPIN(cond, bar) do { unsigned _sp = 0; while (cond) { __builtin_amdgcn_s_sleep(1); \
    if ((++_sp & 255u) == 0u) { if (xb_ld(&(bar)[XB_TMO])) break; if (_sp > XB_SPIN_CAP) { atomicAdd(&(bar)[XB_TMO], 1u); break; } } } } while (0)
struct XcdBarrier { unsigned* bar; unsigned x; volatile LAS unsigned* st; };
__device__ __forceinline__ XcdBarrier xcd_barrier_post(unsigned* bar, volatile LAS unsigned* st) {
    XcdBarrier b; b.bar = bar; b.x = xb_xcc_id(); b.st = st;
    if (threadIdx.x == 0) (void)xb_add(&bar[XB_XCNT(b.x)], 1u);
    return b;
}
__device__ __forceinline__ void xcd_barrier_complete(unsigned* bar, unsigned x, unsigned& nloc, unsigned& nx) {
    const unsigned G = gridDim.x * gridDim.y * gridDim.z;
    unsigned sum, cnt, mine, sp = 0u;
    for (;;) {
        sum = 0u; cnt = 0u; mine = 0u;
#pragma unroll
        for (unsigned j = 0; j < 16; ++j) { const unsigned c = xb_ld(&bar[XB_XCNT(j)]); sum += c; cnt += (c > 0u) ? 1u : 0u; mine = (j == x) ? c : mine; }
        if (sum == G) break;
        __builtin_amdgcn_s_sleep(1);
        if ((++sp & 255u) == 0u) { if (xb_ld(&bar[XB_TMO])) break; if (sp > XB_SPIN_CAP) { atomicAdd(&bar[XB_TMO], 1u); break; } }
    }
    nloc = mine > 0u ? mine : 1u; nx = cnt > 0u ? cnt : 1u;
}
__device__ __forceinline__ void xcd_barrier(const XcdBarrier& b) {
    asm volatile("s_waitcnt vmcnt(0)" ::: "memory");
    __syncthreads();
    if (threadIdx.x == 0) {
        unsigned* bar = b.bar;
        __builtin_amdgcn_s_waitcnt(0);
        unsigned nloc = b.st[0], nx = b.st[1];
        if (nloc == 0u) { xcd_barrier_complete(bar, b.x, nloc, nx); b.st[0] = nloc; b.st[1] = nx; }
        const unsigned old = xb_add(&bar[XB_XSUB(b.x)], 1u);
        const unsigned gen = old / nloc;
        if (old + 1u == (gen + 1u) * nloc) {
            __builtin_amdgcn_fence(__ATOMIC_RELEASE, "agent");
            asm volatile("s_waitcnt vmcnt(0)" ::: "memory");
            const unsigned og = xb_add(&bar[XB_TOP], 1u);
            const unsigned tg = og / nx;
            if (og + 1u == (tg + 1u) * nx) xb_add(&bar[XB_TOPGEN], 1u);
            else XB_SPIN(xb_ld(&bar[XB_TOPGEN]) == tg, bar);
            __builtin_amdgcn_fence(__ATOMIC_ACQUIRE, "agent");
            xb_add(&bar[XB_XGEN(b.x)], 1u);
            asm volatile("s_waitcnt vmcnt(0)" ::: "memory");
        } else {
            XB_SPIN(xb_ld(&bar[XB_XGEN(b.x)]) == gen, bar);
            __builtin_amdgcn_fence(__ATOMIC_ACQUIRE, "agent");
            asm volatile("s_waitcnt vmcnt(0)" ::: "memory");
        }
    }
    __syncthreads();
}

__global__ void __launch_bounds__(256, 2) mega(Params P) {
  __shared__ __attribute__((aligned(16))) char smem[65536];
  __shared__ float sred[256];
  cg::grid_group grid = cg::this_grid();
  __shared__ uint4 xb_words;
  if (threadIdx.x == 0) xb_words = make_uint4(0u, 0u, 0u, 0u);
  __syncthreads();
  XcdBarrier xb = xcd_barrier_post(P.bar, (volatile LAS unsigned*)&xb_words);
  if (P.phase_hi > 1000) grid.sync();
#ifndef REPMASK
#define REPMASK 0
#endif
#define RUNPH(n, call) if (P.phase_lo <= n && n < P.phase_hi) { call; if ((REPMASK >> n) & 1) { call; } if (n + 1 < P.phase_hi) grid.sync(); }
  RUNPH(0, phase0(P, smem))
  RUNPH(1, phase1(P, smem))
  RUNPH(2, phase2(P, smem))
  RUNPH(3, phase3a(P, smem))
  RUNPH(4, phase3b(P, smem, sred))
  RUNPH(5, phase3c(P))
  RUNPH(6, phase4(P, smem, sred))
  RUNPH(7, phase5(P, smem, sred))
#ifdef DRYPEER
  phase6(P, smem, P.phase_hi < 100);
#endif
  RUNPH(8, phase6(P, smem))
  RUNPH(9, phase7(P, smem, sred))
  RUNPH(10, phase8(P))
}

extern "C" void kernel_launch(void* const* d_in, const int* in_sizes, int n_in, void* d_out, int out_size, void* d_ws, size_t ws_size,
                              hipStream_t stream) {
  static int grid_blocks = 0;
  if (!grid_blocks) {
    int dev = 0, cus = 0, per_cu = 0;
    hipGetDevice(&dev);
    hipDeviceGetAttribute(&cus, hipDeviceAttributeMultiprocessorCount, dev);
    hipOccupancyMaxActiveBlocksPerMultiprocessor(&per_cu, mega, 256, 0);
    if (per_cu > 2) per_cu = 2;
    grid_blocks = cus * per_cu;
  }
  Params P{};
  const float** pf = (const float**)&P;
  for (int i = 0; i < 32; ++i) pf[i] = (const float*)d_in[i];
  P.out = (float*)d_out;
  char* w = (char*)d_ws; size_t off = 0;
  auto take = [&](size_t bytes) { char* p = w + off; off += (bytes + 255) & ~(size_t)255; return p; };
  P.Wt_in = (bfraw*)take((size_t)2304 * LDP * 2);
  P.Wt_out = (bfraw*)take((size_t)1024 * 1024 * 2);
  P.Wt_q = (bfraw*)take((size_t)2048 * 1024 * 2);
  P.Wt_pg = (bfraw*)take((size_t)1024 * 1024 * 2);
  P.Wt_ple = (bfraw*)take((size_t)1024 * 256 * 2);
  P.Wt_dec = (bfraw*)take((size_t)512 * 64 * 2);
  P.Wt_a = (bfraw*)take((size_t)512 * 64 * 2);
  P.Wt_g = (bfraw*)take((size_t)512 * 128 * 2);
  P.Wt_pool = (bfraw*)take((size_t)4 * 128 * 128 * 2);
  P.ssq1 = (float*)take((size_t)8 * NT * 4);
  P.rstd2 = (float*)take((size_t)NT * 4);
  P.ssq3 = (float*)take((size_t)8 * NT * 4);
  P.regA = (bfraw*)take((size_t)NT * LDP * 2);
  P.regB = (bfraw*)take((size_t)NT * 1024 * 2);
  P.regY = (bfraw*)take((size_t)NT * 1024 * 2);
  P.bar = (unsigned*)take((size_t)4096 * 4);
  P.bonus = (float*)take((size_t)NPR * 8 * 4);
  P.regPQ = (bfraw*)take((size_t)4096 * 12288);
  P.regP = (bfraw*)take((size_t)NT * 512 * 2);
  P.regZ = (bfraw*)take((size_t)NT * 2304 * 2);
  P.phase_lo = 0; P.phase_hi = 11;
  hipMemsetAsync(P.bar, 0, 4096 * 4, stream);
  void* args[] = {&P};
  hipError_t e = hipLaunchCooperativeKernel((void*)mega, dim3(grid_blocks), dim3(256), args, 0, stream);
  if (e != hipSuccess) fprintf(stderr, "cooperative launch failed: %s (grid %d)\n", hipGetErrorString(e), grid_blocks);
}
```

```cpp
#include <hip/hip_runtime.h>
#include <hip/hip_bf16.h>
#include <hip/hip_cooperative_groups.h>
#include <stdint.h>
#include <cstdio>
namespace cg = cooperative_groups;

typedef __attribute__((ext_vector_type(8))) short bf16x8;
typedef __attribute__((ext_vector_type(4))) float f32x4;
typedef unsigned short bfraw;

#define NT 16896
#define NPR 16384
#define DM 1024
#define DIN 2304
#define DSH 1792
#define LDP 1088

struct Params {
  const float *x_prompt, *x_sample, *state_shift, *state_wkv, *state_pool, *p_prompt, *p_sample;
  const float *norm_mix_g, *w_in, *shift_mu, *decay_w0, *decay_b, *a_0, *a_b, *g_b, *k_k, *k_a, *r_k;
  const float *lnx_g, *lnx_b, *pool_w, *pool_scale, *w_out, *norm_ffn_g, *peer_wq, *peer_keys;
  const float *peer_u, *peer_v, *norm_ple_g, *ple_w, *ple_gate_w, *final_norm_g;
  float* out;
  bfraw *Wt_in, *Wt_out, *Wt_q, *Wt_pg, *Wt_ple, *Wt_dec, *Wt_a, *Wt_g, *Wt_pool;
  float *ssq1, *rstd2, *ssq3, *bonus;
  unsigned* bar;
  bfraw *regPQ;
  bfraw *regA;
  bfraw *regB;
  bfraw *regY;
  bfraw *regP;
  bfraw *regZ;
  int phase_lo, phase_hi;
};

#define O_Y 0
#define O_SHP 17301504
#define O_WKP 17315840
#define O_POP 17577984
#define O_SHS 17639424
#define O_WKS 17868800
#define O_POS 22063104

typedef float f32x2_ __attribute__((ext_vector_type(2)));
typedef __bf16 bf16x2_t __attribute__((ext_vector_type(2)));
__device__ __forceinline__ unsigned int pack2(float a, float b) {
  f32x2_ v = {a, b};
  bf16x2_t r = __builtin_convertvector(v, bf16x2_t);
  return __builtin_bit_cast(unsigned int, r);
}
__device__ __forceinline__ unsigned short f2bf(float f) { return (unsigned short)(pack2(f, 0.f) & 0xffffu); }
__device__ __forceinline__ float bf2f(unsigned short h) { return __uint_as_float(((unsigned int)h) << 16); }
__device__ __forceinline__ void unpack8(uint4 v, float* f) {
  f[0] = __uint_as_float(v.x << 16); f[1] = __uint_as_float(v.x & 0xffff0000u);
  f[2] = __uint_as_float(v.y << 16); f[3] = __uint_as_float(v.y & 0xffff0000u);
  f[4] = __uint_as_float(v.z << 16); f[5] = __uint_as_float(v.z & 0xffff0000u);
  f[6] = __uint_as_float(v.w << 16); f[7] = __uint_as_float(v.w & 0xffff0000u);
}
__device__ __forceinline__ uint4 pack8(const float* f) {
  uint4 v; v.x = pack2(f[0], f[1]); v.y = pack2(f[2], f[3]); v.z = pack2(f[4], f[5]); v.w = pack2(f[6], f[7]); return v;
}
__device__ __forceinline__ float wsum(float v) {
#pragma unroll
  for (int o = 32; o > 0; o >>= 1) v += __shfl_xor(v, o, 64);
  return v;
}
__device__ __forceinline__ float wmaxf(float v) {
#pragma unroll
  for (int o = 32; o > 0; o >>= 1) v = fmaxf(v, __shfl_xor(v, o, 64));
  return v;
}
__device__ __forceinline__ float sigmoidf_(float x) { return 1.f / (1.f + __expf(-x)); }

#define LROW 80
template <bool SEQ = false, class AL, class BL>
__device__ __forceinline__ void gemm_main(f32x4 (&acc)[4][4], AL aload, BL bload, int K, bfraw* sA, bfraw* sB) {
  int tid0_ = threadIdx.x; asm volatile("" : "+v"(tid0_));
  const int tid = tid0_, lane = tid & 63, wid = tid >> 6, wr = wid >> 1, wc = wid & 1, fr = lane & 15, fq = lane >> 4;
  uint4 ra0[4], rb0[4], ra1[4], rb1[4];
#define G_LOAD(ra_, rb_, kk_) _Pragma("unroll") for (int i = 0; i < 4; ++i) { int ch = tid + 256 * i; ra_[i] = aload(ch >> 3, (kk_) + (ch & 7) * 8); rb_[i] = bload(ch >> 3, (kk_) + (ch & 7) * 8); if (SEQ) __builtin_amdgcn_sched_barrier(0); }
#define G_STORE(ra_, rb_) _Pragma("unroll") for (int i = 0; i < 4; ++i) { int ch = tid + 256 * i; int r = ch >> 3, c = (ch & 7) * 8; *(uint4*)(sA + r * LROW + c) = ra_[i]; *(uint4*)(sB + r * LROW + c) = rb_[i]; }
#define G_COMPUTE _Pragma("unroll") for (int kk = 0; kk < 2; ++kk) { bf16x8 af[4], bfr[4]; \
        _Pragma("unroll") for (int m = 0; m < 4; ++m) af[m] = *(const bf16x8*)(sA + (wr * 64 + m * 16 + fr) * LROW + kk * 32 + fq * 8); \
        _Pragma("unroll") for (int n = 0; n < 4; ++n) bfr[n] = *(const bf16x8*)(sB + (wc * 64 + n * 16 + fr) * LROW + kk * 32 + fq * 8); \
      __builtin_amdgcn_s_setprio(1); \
      _Pragma("unroll") for (int m = 0; m < 4; ++m) _Pragma("unroll") for (int n = 0; n < 4; ++n) \
        acc[m][n] = __builtin_amdgcn_mfma_f32_16x16x32_bf16(af[m], bfr[n], acc[m][n], 0, 0, 0); \
      __builtin_amdgcn_s_setprio(0); }
  G_LOAD(ra0, rb0, 0)
  if (SEQ) {
#pragma unroll 1
    for (int k0 = 0; k0 < K; k0 += 64) {
      __syncthreads();
      G_STORE(ra0, rb0)
      __syncthreads();
      if (k0 + 64 < K) { G_LOAD(ra0, rb0, k0 + 64) }
      G_COMPUTE
    }
    __syncthreads();
    return;
  }
  if (K > 64) { G_LOAD(ra1, rb1, 64) }
#pragma unroll 1
  for (int k0 = 0; k0 < K; k0 += 128) {
    __syncthreads();
    G_STORE(ra0, rb0)
    __syncthreads();
    if (k0 + 128 < K) { G_LOAD(ra0, rb0, k0 + 128) }
    G_COMPUTE
    if (k0 + 64 < K) {
      __syncthreads();
      G_STORE(ra1, rb1)
      __syncthreads();
      if (k0 + 192 < K) { G_LOAD(ra1, rb1, k0 + 192) }
      G_COMPUTE
    }
  }
  __syncthreads();
}
#define ZERO_ACC(acc) _Pragma("unroll") for (int m_ = 0; m_ < 4; ++m_) _Pragma("unroll") for (int n_ = 0; n_ < 4; ++n_) acc[m_][n_] = f32x4{0.f, 0.f, 0.f, 0.f};
#define EPI_VARS const int tid = threadIdx.x, lane = tid & 63, wid = tid >> 6, wr = wid >> 1, wc = wid & 1, fr = lane & 15, fq = lane >> 4; (void)tid;
#define EPI_LOOP _Pragma("unroll") for (int m = 0; m < 4; ++m) _Pragma("unroll") for (int n = 0; n < 4; ++n) _Pragma("unroll") for (int j = 0; j < 4; ++j)
#define EPI_RC const int row = wr * 64 + m * 16 + fq * 4 + j, col = wc * 64 + n * 16 + fr;

__device__ __forceinline__ int swz(int row, int col) { return row * 128 + (col ^ (((row >> 2) & 1) << 4)); }
__device__ __forceinline__ int acc_to_lds_(const f32x4 (&acc)[4][4], float* sS) {
  EPI_VARS
  EPI_LOOP { EPI_RC sS[swz(row, col)] = acc[m][n][j]; }
  __syncthreads();
  int t_ = threadIdx.x; asm volatile("" : "+v"(t_));
  return t_;
}
#define acc_to_lds(acc, sS) const int etid_ = acc_to_lds_(acc, sS);
#define SEG_VARS(i_) const int idx_ = etid_ + 256 * (i_); const int row = idx_ >> 5, c4 = (idx_ & 31) * 4; const float4 v = *(const float4*)(sS + swz(row, c4));

__device__ __forceinline__ bool xcd_job(int it, int nct, int G, int& rt, int& ct) {
  const int x = blockIdx.x & 7, lr = blockIdx.x >> 3, nl = gridDim.x >> 3;
  const int j = lr + it * nl;
  const int nrt = (132 - x + 7) >> 3;
  if (j >= nrt * nct) return false;
  const int per = nrt * G; const int grp = j / per, rem = j - grp * per;
  rt = (rem / G) * 8 + x; ct = grp * G + rem % G;
  return true;
}

struct PlainLoad {
  const bfraw* base; int ld;
  __device__ __forceinline__ uint4 operator()(int r, int k) const { return *(const uint4*)(base + (size_t)r * ld + k); }
};

__device__ __forceinline__ void row_ssq_store(float (&ps)[4][4], float* sred, float* dst  ) {
  EPI_VARS
#pragma unroll
  for (int m = 0; m < 4; ++m)
#pragma unroll
    for (int j = 0; j < 4; ++j) {
      float v = ps[m][j];
      v += __shfl_xor(v, 1, 64); v += __shfl_xor(v, 2, 64); v += __shfl_xor(v, 4, 64); v += __shfl_xor(v, 8, 64);
      if (fr == 0) sred[wc * 128 + wr * 64 + m * 16 + fq * 4 + j] = v;
    }
  __syncthreads();
  if (tid < 128) dst[tid] = sred[tid] + sred[128 + tid];
  __syncthreads();
}

__device__ void transpose_tile(const float* src, int R, int C, bfraw* dst, const float* scale, int tile, float* sT, int dld = 0) {
  if (dld == 0) dld = R;
  int tc = C / 64; int tk = tile / tc, tn = tile % tc; int k0 = tk * 64, n0 = tn * 64;
  int tid = threadIdx.x, c = tid & 63, r0 = tid >> 6;
  __syncthreads();
  for (int i = 0; i < 16; ++i) { int r = r0 + 4 * i; sT[r * 65 + c] = src[(size_t)(k0 + r) * C + n0 + c]; }
  __syncthreads();
  float sc = scale ? scale[k0 + c] : 1.f;
  for (int i = 0; i < 16; ++i) { int r = r0 + 4 * i; dst[(size_t)(n0 + r) * dld + k0 + c] = f2bf(sT[c * 65 + r] * sc); }
}

__device__ void fold_job(const Params& P, int job, float* sm) {
  int hp = job >> 5, rem = job & 31, kt = rem >> 1, keyt = rem & 1;
  int p = hp & 1;
  float* sK = sm; float* sW = sm + 64 * 65;
  int tid = threadIdx.x, tx = tid & 15, ty = tid >> 4;
  float acc[4][4];
#pragma unroll
  for (int i = 0; i < 4; ++i)
#pragma unroll
    for (int j = 0; j < 4; ++j) acc[i][j] = 0.f;
  for (int ch = 0; ch < 2; ++ch) {
    __syncthreads();
    int c = tid & 63, r0 = tid >> 6;
    for (int i = 0; i < 16; ++i) {
      int r = r0 + 4 * i;
      sK[r * 65 + c] = P.peer_keys[((size_t)p * 128 + keyt * 64 + r) * 128 + ch * 64 + c];
      sW[r * 65 + c] = P.peer_wq[(size_t)(kt * 64 + r) * 2048 + hp * 128 + ch * 64 + c];
    }
    __syncthreads();
    for (int cc = 0; cc < 64; ++cc) {
      float kv[4], wv[4];
#pragma unroll
      for (int i = 0; i < 4; ++i) { kv[i] = sK[(ty * 4 + i) * 65 + cc]; wv[i] = sW[(tx * 4 + i) * 65 + cc]; }
#pragma unroll
      for (int i = 0; i < 4; ++i)
#pragma unroll
        for (int j = 0; j < 4; ++j) acc[i][j] += kv[i] * wv[j];
    }
  }
#pragma unroll
  for (int i = 0; i < 4; ++i) {
    int key = keyt * 64 + ty * 4 + i; int k = kt * 64 + tx * 4;
    float g0 = P.norm_ffn_g[k], g1 = P.norm_ffn_g[k + 1], g2 = P.norm_ffn_g[k + 2], g3 = P.norm_ffn_g[k + 3];
    uint2 v; v.x = pack2(acc[i][0] * g0, acc[i][1] * g1); v.y = pack2(acc[i][2] * g2, acc[i][3] * g3);
    *(uint2*)(P.Wt_q + (size_t)(hp * 128 + key) * 1024 + k) = v;
  }
}

__device__ __forceinline__ const float* xrow(const Params& P, int tau) {
  return tau < NPR ? P.x_prompt + (size_t)tau * 1024 : P.x_sample + (size_t)(tau - NPR) * 1024;
}

__device__ void prep_transpose(const Params& P, int t, float* sT) {
  if (t < 576) transpose_tile(P.w_in, 1024, 2304, P.Wt_in, nullptr, t, sT, LDP);
  else if (t < 832) transpose_tile(P.w_out, 1024, 1024, P.Wt_out, nullptr, t - 576, sT);
  else if (t < 1088) transpose_tile(P.ple_gate_w, 1024, 1024, P.Wt_pg, P.norm_ple_g, t - 832, sT);
  else if (t < 1152) transpose_tile(P.ple_w, 256, 1024, P.Wt_ple, nullptr, t - 1088, sT);
  else if (t < 1160) transpose_tile(P.decay_b, 64, 512, P.Wt_dec, nullptr, t - 1152, sT);
  else if (t < 1168) transpose_tile(P.a_b, 64, 512, P.Wt_a, nullptr, t - 1160, sT);
  else if (t < 1184) transpose_tile(P.g_b, 128, 512, P.Wt_g, nullptr, t - 1168, sT);
  else { int u = t - 1184; int gi = u >> 2; transpose_tile(P.pool_w + gi * 16384, 128, 128, P.Wt_pool + gi * 16384, nullptr, u & 3, sT); }
}
__device__ void late_prep_job(const Params& P, int job, char* smem) {
  if (job < 576) prep_transpose(P, 576 + job, (float*)smem);
  else fold_job(P, job - 576, (float*)smem);
}
#define N_LATE_PREP 1088

__device__ void phase0(const Params& P, char* smem) {
  const int NJ_RMS = NT / 4, NJ_TR = 576 + 48, NJ_POOLCP = 704;
  const int total = NJ_RMS + NJ_TR + NJ_POOLCP;
  int tid = threadIdx.x, lane = tid & 63, wid = tid >> 6;
  for (int job = blockIdx.x; job < total; job += gridDim.x) {
    if (job < NJ_RMS) {
      int tau = job * 4 + wid;
      const float* xr = xrow(P, tau);
      float4 v[4]; float ss = 0.f;
#pragma unroll
      for (int j = 0; j < 4; ++j) { v[j] = *(const float4*)(xr + lane * 4 + 256 * j); ss += v[j].x * v[j].x + v[j].y * v[j].y + v[j].z * v[j].z + v[j].w * v[j].w; }
      ss = wsum(ss);
      float rs = rsqrtf(ss * (1.f / 1024.f) + 1e-6f);
#pragma unroll
      for (int j = 0; j < 4; ++j) {
        float4 g = *(const float4*)(P.norm_mix_g + lane * 4 + 256 * j);
        uint2 o; o.x = pack2(v[j].x * rs * g.x, v[j].y * rs * g.y); o.y = pack2(v[j].z * rs * g.z, v[j].w * rs * g.w);
        *(uint2*)(P.regA + (size_t)tau * LDP + lane * 4 + 256 * j) = o;
      }
    } else if (job < NJ_RMS + NJ_TR) {
      int t = job - NJ_RMS;
      prep_transpose(P, t < 576 ? t : 1152 + (t - 576), (float*)smem);
    } else {
      int e0 = (job - NJ_RMS - NJ_TR) * 1024 + tid * 4;
      if (e0 < 128 * 11 * 512) {
        int b = e0 / (11 * 512), rem = e0 % (11 * 512), j = rem / 512, c = rem % 512;
        float4 v = *(const float4*)(P.state_pool + ((size_t)b * 15 + j + 4) * 512 + c);
        *(float4*)(P.out + O_POS + ((size_t)b * 15 + j) * 512 + c) = v;
      }
    }
  }
}

__device__ void phase1(const Params& P, char* smem) {
  bfraw* sA = (bfraw*)smem; bfraw* sB = sA + 128 * LROW;
  const int nct = DIN / 128;
  for (int it = 0;; ++it) {
    int rt, ct; if (!xcd_job(it, nct, 9, rt, ct)) break; int row0 = rt * 128, col0 = ct * 128;
    f32x4 acc[4][4]; ZERO_ACC(acc)
    gemm_main(acc, PlainLoad{P.regA + (size_t)row0 * LDP, LDP}, PlainLoad{P.Wt_in + (size_t)col0 * LDP, LDP}, 1024, sA, sB);
    float* sS = (float*)smem;
    acc_to_lds(acc, sS);
#pragma unroll 4
    for (int i = 0; i < 16; ++i) {
      SEG_VARS(i)
      int tau = row0 + row, c = col0 + c4;
      uint2 o; o.x = pack2(v.x, v.y); o.y = pack2(v.z, v.w);
      *(uint2*)(P.regZ + (size_t)tau * DIN + c) = o;
      if (tau < NPR) {
        int t = tau & 2047, b = tau >> 11;
        if (c < DSH) { if (t == 2047) *(float4*)(P.out + O_SHP + b * DSH + c) = v; }
        else if (t >= 2033) *(float4*)(P.out + O_POP + ((size_t)b * 15 + (t - 2033)) * 512 + (c - DSH)) = v;
      } else {
        int s = tau - NPR, b = s >> 2, t = s & 3;
        if (c < DSH) { if (t == 3) *(float4*)(P.out + O_SHS + b * DSH + c) = v; }
        else *(float4*)(P.out + O_POS + ((size_t)b * 15 + 11 + t) * 512 + (c - DSH)) = v;
      }
    }
  }
}

struct LoraLoad {
  const Params* P; int row0; int cb; int mode;
  __device__ __forceinline__ uint4 operator()(int r, int k) const {
    int tau = row0 + r; int zc = cb + k;
    float z[8], zp[8];
    unpack8(*(const uint4*)(P->regZ + (size_t)tau * DIN + zc), z);
    bool first; int b;
    if (tau < NPR) { first = (tau & 2047) == 0; b = 0; } else { int s = tau - NPR; first = (s & 3) == 0; b = s >> 2; }
    if (!first) unpack8(*(const uint4*)(P->regZ + (size_t)(tau - 1) * DIN + zc), zp);
    else if (tau < NPR) { for (int i = 0; i < 8; ++i) zp[i] = 0.f; }
    else {
      float4 a = *(const float4*)(P->state_shift + (size_t)b * DSH + zc), c = *(const float4*)(P->state_shift + (size_t)b * DSH + zc + 4);
      zp[0] = a.x; zp[1] = a.y; zp[2] = a.z; zp[3] = a.w; zp[4] = c.x; zp[5] = c.y; zp[6] = c.z; zp[7] = c.w;
    }
    float4 m0 = *(const float4*)(P->shift_mu + zc), m1 = *(const float4*)(P->shift_mu + zc + 4);
    float mu[8] = {m0.x, m0.y, m0.z, m0.w, m1.x, m1.y, m1.z, m1.w};
    float o[8];
#pragma unroll
    for (int i = 0; i < 8; ++i) {
      float zs = z[i] + (zp[i] - z[i]) * mu[i];
      o[i] = mode == 0 ? (1.f - 2.f / (1.f + __expf(2.f * zs))) : (mode == 1 ? zs : sigmoidf_(zs));
    }
    return pack8(o);
  }
};

struct PoolLoad {
  const Params* P; int row0; int gi;
  __device__ __forceinline__ uint4 operator()(int r, int k) const {
    int tau = row0 + r; int pc = gi * 128 + k; int zc = DSH + pc; int w = 2 << gi;
    float u[8], s[8], t8[8];
    unpack8(*(const uint4*)(P->regZ + (size_t)tau * DIN + zc), u);
#pragma unroll
    for (int i = 0; i < 8; ++i) s[i] = u[i];
    float cnt;
    if (tau < NPR) {
      int t = tau & 2047; int nv = min(t + 1, w); cnt = (float)nv;
      for (int d = 1; d < nv; ++d) {
        unpack8(*(const uint4*)(P->regZ + (size_t)(tau - d) * DIN + zc), t8);
#pragma unroll
        for (int i = 0; i < 8; ++i) s[i] += t8[i];
      }
    } else {
      int sidx = tau - NPR, b = sidx >> 2, t = sidx & 3; cnt = (float)w;
      for (int d = 1; d < w; ++d) {
        if (t - d >= 0) unpack8(*(const uint4*)(P->regZ + (size_t)(tau - d) * DIN + zc), t8);
        else {
          const float* sp = P->state_pool + ((size_t)b * 15 + (15 + t - d)) * 512 + pc;
          float4 a = *(const float4*)sp, c = *(const float4*)(sp + 4);
          t8[0] = a.x; t8[1] = a.y; t8[2] = a.z; t8[3] = a.w; t8[4] = c.x; t8[5] = c.y; t8[6] = c.z; t8[7] = c.w;
        }
#pragma unroll
        for (int i = 0; i < 8; ++i) s[i] += t8[i];
      }
    }
    float inv = 1.f / cnt; float o[8];
#pragma unroll
    for (int i = 0; i < 8; ++i) o[i] = s[i] * inv - u[i];
    return pack8(o);
  }
};

__device__ void phase2(const Params& P, char* smem) {
  bfraw* sA = (bfraw*)smem; bfraw* sB = sA + 128 * LROW;
  float* Wd = (float*)P.regA; bfraw* Aa = P.regB; bfraw* Gg = P.regB + (size_t)NT * 512;
  for (int job = blockIdx.x; job < 4224; job += gridDim.x) {
    int item = job * 256 + threadIdx.x; int tau = item >> 6, chunk = item & 63;
    PoolLoad pl{&P, 0, chunk >> 4};
    *(uint4*)(P.regP + (size_t)tau * 512 + chunk * 8) = pl(tau, (chunk & 15) * 8);
  }
  for (int job = blockIdx.x; job < 1584; job += gridDim.x) {
    int kind = job / 528, jj = job % 528, rt = jj >> 2, ct = jj & 3; int row0 = rt * 128;
    f32x4 acc[4][4]; ZERO_ACC(acc)
    float* sS = (float*)smem;
    if (kind == 0) {
      gemm_main<true>(acc, LoraLoad{&P, row0, 1536, 0}, PlainLoad{P.Wt_dec + (size_t)ct * 128 * 64, 64}, 64, sA, sB);
      acc_to_lds(acc, sS);
#pragma unroll 4
      for (int i = 0; i < 16; ++i) { SEG_VARS(i) int c = ct * 128 + c4;
        float4 w0 = *(const float4*)(P.decay_w0 + c); float4 o;
        o.x = __expf(-0.6065306597f * sigmoidf_(w0.x + v.x)); o.y = __expf(-0.6065306597f * sigmoidf_(w0.y + v.y));
        o.z = __expf(-0.6065306597f * sigmoidf_(w0.z + v.z)); o.w = __expf(-0.6065306597f * sigmoidf_(w0.w + v.w));
        *(float4*)(Wd + (size_t)(row0 + row) * 512 + c) = o; }
    } else if (kind == 1) {
      gemm_main<true>(acc, LoraLoad{&P, row0, 1600, 1}, PlainLoad{P.Wt_a + (size_t)ct * 128 * 64, 64}, 64, sA, sB);
      acc_to_lds(acc, sS);
#pragma unroll 4
      for (int i = 0; i < 16; ++i) { SEG_VARS(i) int c = ct * 128 + c4;
        float4 a0 = *(const float4*)(P.a_0 + c); uint2 o;
        o.x = pack2(sigmoidf_(a0.x + v.x), sigmoidf_(a0.y + v.y)); o.y = pack2(sigmoidf_(a0.z + v.z), sigmoidf_(a0.w + v.w));
        *(uint2*)(Aa + (size_t)(row0 + row) * 512 + c) = o; }
    } else if (kind == 2) {
      gemm_main<true>(acc, LoraLoad{&P, row0, 1664, 2}, PlainLoad{P.Wt_g + (size_t)ct * 128 * 128, 128}, 128, sA, sB);
      acc_to_lds(acc, sS);
#pragma unroll 4
      for (int i = 0; i < 16; ++i) { SEG_VARS(i) int c = ct * 128 + c4;
        uint2 o; o.x = pack2(v.x, v.y); o.y = pack2(v.z, v.w);
        *(uint2*)(Gg + (size_t)(row0 + row) * 512 + c) = o; }
    }
  }
}

__device__ void wkv_direct(const Params& P, int unit, float* sw) {
  const int lane = threadIdx.x & 63;
  const float* Wd = (const float*)P.regA; const bfraw* Aa = P.regB; const bfraw* Gg = P.regB + (size_t)NT * 512;
  bool prompt = unit < 64; int b, h, T, tok0;
  if (prompt) { b = unit >> 3; h = unit & 7; T = 2048; tok0 = b * 2048; }
  else { int u = unit - 64; b = u >> 3; h = u & 7; T = 4; tok0 = NPR + 4 * b; }
  float S[64];
  if (prompt) {
#pragma unroll
    for (int j = 0; j < 64; ++j) S[j] = 0.f;
  } else {
    const float* sp = P.state_wkv + (((size_t)b * 8 + h) * 64 + lane) * 64;
#pragma unroll
    for (int j = 0; j < 16; ++j) { float4 v = *(const float4*)(sp + j * 4); S[j * 4] = v.x; S[j * 4 + 1] = v.y; S[j * 4 + 2] = v.z; S[j * 4 + 3] = v.w; }
  }
  const int hc = h * 64 + lane;
  const float mu_r = P.shift_mu[hc], mu_k = P.shift_mu[512 + hc], mu_v = P.shift_mu[1024 + hc];
  const float kkw = P.k_k[hc], kaw = P.k_a[hc], rkw = P.r_k[hc], lg = P.lnx_g[hc], lb = P.lnx_b[hc];
  float pr, pk, pv;
  if (prompt) { pr = pk = pv = 0.f; }
  else { const float* ss = P.state_shift + (size_t)b * DSH; pr = ss[hc]; pk = ss[512 + hc]; pv = ss[1024 + hc]; }
  float* s_kk = sw; float* s_w = sw + 64; float* s_ka = sw + 128; float* s_k = sw + 192; float* s_r = sw + 256;
  for (int t = 0; t < T; ++t) {
    int tau = tok0 + t;
    const bfraw* zr = P.regZ + (size_t)tau * DIN;
    float zr_ = bf2f(zr[hc]), zk_ = bf2f(zr[512 + hc]), zv_ = bf2f(zr[1024 + hc]);
    float r = zr_ + (pr - zr_) * mu_r, k = zk_ + (pk - zk_) * mu_k, v = zv_ + (pv - zv_) * mu_v;
    pr = zr_; pk = zk_; pv = zv_;
    float a = bf2f(Aa[(size_t)tau * 512 + hc]), w = Wd[(size_t)tau * 512 + hc], g = bf2f(Gg[(size_t)tau * 512 + hc]);
    float kkf = k * kkw; float nrm = sqrtf(wsum(kkf * kkf)); float kk = kkf / fmaxf(nrm, 1e-12f);
    float k2 = k * (1.f + (a - 1.f) * kaw);
    float ka = kk * a;
    float bsum = wsum(r * k2 * rkw);
    __builtin_amdgcn_wave_barrier();
    s_kk[lane] = kk; s_w[lane] = w; s_ka[lane] = ka; s_k[lane] = k2; s_r[lane] = r;
    __builtin_amdgcn_wave_barrier();
    float skk = 0.f;
#pragma unroll
    for (int j = 0; j < 16; ++j) { float4 q = *(const float4*)(s_kk + j * 4); skk += S[j * 4] * q.x + S[j * 4 + 1] * q.y + S[j * 4 + 2] * q.z + S[j * 4 + 3] * q.w; }
    skk = -skk;
    float o = 0.f;
#pragma unroll
    for (int j = 0; j < 16; ++j) {
      float4 qw = *(const float4*)(s_w + j * 4), qa = *(const float4*)(s_ka + j * 4), qk = *(const float4*)(s_k + j * 4), qr = *(const float4*)(s_r + j * 4);
      S[j * 4] = S[j * 4] * qw.x + skk * qa.x + v * qk.x; o += S[j * 4] * qr.x;
      S[j * 4 + 1] = S[j * 4 + 1] * qw.y + skk * qa.y + v * qk.y; o += S[j * 4 + 1] * qr.y;
      S[j * 4 + 2] = S[j * 4 + 2] * qw.z + skk * qa.z + v * qk.z; o += S[j * 4 + 2] * qr.z;
      S[j * 4 + 3] = S[j * 4 + 3] * qw.w + skk * qa.w + v * qk.w; o += S[j * 4 + 3] * qr.w;
    }
    float mean = wsum(o) * (1.f / 64.f); float dd = o - mean; float var = wsum(dd * dd) * (1.f / 64.f);
    float y = (dd * rsqrtf(var + 64e-5f) * lg + lb + bsum * v) * g;
    P.regY[(size_t)tau * 1024 + hc] = f2bf(y);
  }
  float* so = P.out + (prompt ? O_WKP : O_WKS) + (((size_t)b * 8 + h) * 64 + lane) * 64;
#pragma unroll
  for (int j = 0; j < 16; ++j) *(float4*)(so + j * 4) = make_float4(S[j * 4], S[j * 4 + 1], S[j * 4 + 2], S[j * 4 + 3]);
}

#define MFMA16(a, b, c) __builtin_amdgcn_mfma_f32_16x16x32_bf16(a, b, c, 0, 0, 0)
__device__ void wkv_chunk_pre(const Params& P, int unit, char* smem) {
  const int tid = threadIdx.x, lane = tid & 63, w = tid >> 6, fr = lane & 15, fq = lane >> 4;
  bfraw* Ah = (bfraw*)smem; bfraw* Bh = Ah + 2304; bfraw* Kh = Bh + 2304; bfraw* Rh = Kh + 2304;
  bfraw* AhT = Rh + 2304;
  bfraw* Vt = AhT + 2560; bfraw* NakT = Vt + 2560; bfraw* MbrT = NakT + 1280; bfraw* MkrT = MbrT + 1280; bfraw* Tt = MkrT + 1280;
  bfraw* VN = Tt + 1280; bfraw* nAt = VN + 2560; bfraw* nD0 = nAt + 2560;
  float* G = (float*)(nD0 + 2560);
  float* gC = G + 2048;
  float* NabT = G;
  const float* Wd = (const float*)P.regA; const bfraw* Aa = P.regB;
  const int b = unit >> 9, h = (unit >> 6) & 7, c = unit & 63;
  const int tok0 = b * 2048 + c * 32;
  __syncthreads();
  {
    const int t = tid >> 3, jg = tid & 7, j0 = jg * 8, hc = h * 64 + j0;
    const int tau = tok0 + t;
    const bool first = (c == 0 && t == 0);
    const bfraw* zr = P.regZ + (size_t)tau * DIN;
    float zr_[8], zk_[8], zv_[8], pr[8], pk[8], pv[8];
    unpack8(*(const uint4*)(zr + hc), zr_); unpack8(*(const uint4*)(zr + 512 + hc), zk_); unpack8(*(const uint4*)(zr + 1024 + hc), zv_);
    if (!first) { unpack8(*(const uint4*)(zr - DIN + hc), pr); unpack8(*(const uint4*)(zr - DIN + 512 + hc), pk); unpack8(*(const uint4*)(zr - DIN + 1024 + hc), pv); }
    else {
#pragma unroll
      for (int i = 0; i < 8; ++i) { pr[i] = 0.f; pk[i] = 0.f; pv[i] = 0.f; }
    }
    float a[8], wd[8], r[8], k[8], v[8], kk[8], k2[8];
    unpack8(*(const uint4*)(Aa + (size_t)tau * 512 + hc), a);
    { float4 x = *(const float4*)(Wd + (size_t)tau * 512 + hc), y = *(const float4*)(Wd + (size_t)tau * 512 + hc + 4);
      wd[0] = x.x; wd[1] = x.y; wd[2] = x.z; wd[3] = x.w; wd[4] = y.x; wd[5] = y.y; wd[6] = y.z; wd[7] = y.w; }
    float ss = 0.f, bs = 0.f;
#pragma unroll
    for (int i = 0; i < 8; ++i) {
      float mr = P.shift_mu[hc + i], mk = P.shift_mu[512 + hc + i], mv = P.shift_mu[1024 + hc + i];
      r[i] = zr_[i] + (pr[i] - zr_[i]) * mr; k[i] = zk_[i] + (pk[i] - zk_[i]) * mk; v[i] = zv_[i] + (pv[i] - zv_[i]) * mv;
      float kkf = k[i] * P.k_k[hc + i]; kk[i] = kkf; ss += kkf * kkf;
      k2[i] = k[i] * (1.f + (a[i] - 1.f) * P.k_a[hc + i]);
      bs += r[i] * k2[i] * P.r_k[hc + i];
    }
    ss += __shfl_xor(ss, 1, 64); ss += __shfl_xor(ss, 2, 64); ss += __shfl_xor(ss, 4, 64);
    bs += __shfl_xor(bs, 1, 64); bs += __shfl_xor(bs, 2, 64); bs += __shfl_xor(bs, 4, 64);
    if (jg == 0) P.bonus[(size_t)tau * 8 + h] = bs;
    float inv = 1.f / fmaxf(sqrtf(ss), 1e-12f);
    *(float4*)(G + t * 64 + j0) = make_float4(wd[0], wd[1], wd[2], wd[3]);
    *(float4*)(G + t * 64 + j0 + 4) = make_float4(wd[4], wd[5], wd[6], wd[7]);
    __syncthreads();
    if (tid < 64) {
      float g = 1.f;
      for (int t2 = 0; t2 < 32; ++t2) { g *= G[t2 * 64 + tid]; G[t2 * 64 + tid] = g; }
      gC[tid] = g;
    }
    __syncthreads();
    float ah[8], bh[8], kh[8], rh[8];
#pragma unroll
    for (int i = 0; i < 8; ++i) {
      float gt = G[t * 64 + j0 + i]; float gp = t > 0 ? G[(t - 1) * 64 + j0 + i] : 1.f; float ig = 1.f / gt;
      float kkn = kk[i] * inv;
      ah[i] = kkn * gp; bh[i] = kkn * a[i] * ig; kh[i] = k2[i] * ig; rh[i] = r[i] * gt;
    }
    uint4 pa = pack8(ah);
    *(uint4*)(Ah + t * 72 + j0) = pa; *(uint4*)(Bh + t * 72 + j0) = pack8(bh); *(uint4*)(Kh + t * 72 + j0) = pack8(kh); *(uint4*)(Rh + t * 72 + j0) = pack8(rh);
    unsigned int paw[4] = {pa.x, pa.y, pa.z, pa.w};
#pragma unroll
    for (int i = 0; i < 8; ++i) {
      AhT[(j0 + i) * 40 + t] = (bfraw)((i & 1) ? (paw[i >> 1] >> 16) : (paw[i >> 1] & 0xffffu));
      Vt[(j0 + i) * 40 + t] = f2bf(v[i]);
    }
  }
  __syncthreads();
  const f32x4 z4 = {0.f, 0.f, 0.f, 0.f};
  {
    const bfraw* Xp = (w & 1) ? Kh : Bh; const bfraw* Yp = (w >> 1) ? Rh : Ah;
    f32x4 acc[2][2] = {{z4, z4}, {z4, z4}};
#pragma unroll
    for (int ks = 0; ks < 2; ++ks) {
      bf16x8 xa[2], yb[2];
#pragma unroll
      for (int mt = 0; mt < 2; ++mt) { xa[mt] = *(const bf16x8*)(Xp + (mt * 16 + fr) * 72 + ks * 32 + fq * 8); yb[mt] = *(const bf16x8*)(Yp + (mt * 16 + fr) * 72 + ks * 32 + fq * 8); }
#pragma unroll
      for (int mt = 0; mt < 2; ++mt)
#pragma unroll
        for (int nt = 0; nt < 2; ++nt) acc[mt][nt] = MFMA16(xa[mt], yb[nt], acc[mt][nt]);
    }
    bfraw* dst = (w == 1) ? NakT : (w == 2 ? MbrT : MkrT);
#pragma unroll
    for (int mt = 0; mt < 2; ++mt)
#pragma unroll
      for (int nt = 0; nt < 2; ++nt)
#pragma unroll
        for (int jj = 0; jj < 4; ++jj) {
          int ta = mt * 16 + fq * 4 + jj, tt = nt * 16 + fr; float val = acc[mt][nt][jj];
          if (w == 0) NabT[tt * 32 + ta] = (ta < tt) ? val : 0.f;
          else { bool keep = (w == 1) ? (ta < tt) : (ta <= tt); dst[tt * 40 + ta] = f2bf(keep ? val : 0.f); }
        }
  }
  __syncthreads();
  const bf16x8 xv = *(const bf16x8*)(Vt + (16 * w + fr) * 40 + fq * 8);
  {
#pragma unroll
    for (int nt = 0; nt < 2; ++nt) {
      bf16x8 yb = *(const bf16x8*)(NakT + (nt * 16 + fr) * 40 + fq * 8);
      f32x4 acc = MFMA16(xv, yb, z4);
#pragma unroll
      for (int jj = 0; jj < 4; ++jj) VN[(16 * w + fq * 4 + jj) * 40 + nt * 16 + fr] = f2bf(acc[jj]);
    }
  }
  if (w == 0 && lane < 32) {
    float Tr[32];
#pragma unroll
    for (int t = 0; t < 32; ++t) {
      float a0 = (lane == t) ? 1.f : 0.f, a1 = 0.f, a2 = 0.f, a3 = 0.f;
#pragma unroll
      for (int q = 0; q < (t + 3) / 4; ++q) {
        float4 nv = *(const float4*)(NabT + t * 32 + q * 4);
        a0 -= Tr[q * 4] * nv.x;
        if (q * 4 + 1 < t) a1 -= Tr[q * 4 + 1] * nv.y;
        if (q * 4 + 2 < t) a2 -= Tr[q * 4 + 2] * nv.z;
        if (q * 4 + 3 < t) a3 -= Tr[q * 4 + 3] * nv.w;
      }
      float acc = (a0 + a1) + (a2 + a3);
      Tr[t] = acc;
      Tt[t * 40 + lane] = f2bf(acc);
    }
  }
  __syncthreads();
  bf16x8 xn, xd;
  {
    bf16x8 xa = *(const bf16x8*)(AhT + (16 * w + fr) * 40 + fq * 8);
    bf16x8 xvn = *(const bf16x8*)(VN + (16 * w + fr) * 40 + fq * 8);
#pragma unroll
    for (int nt = 0; nt < 2; ++nt) {
      bf16x8 yb = *(const bf16x8*)(Tt + (nt * 16 + fr) * 40 + fq * 8);
      f32x4 aA = MFMA16(xa, yb, z4), aD = MFMA16(xvn, yb, z4);
#pragma unroll
      for (int jj = 0; jj < 4; ++jj) {
        nAt[(16 * w + fq * 4 + jj) * 40 + nt * 16 + fr] = f2bf(-aA[jj]);
        nD0[(16 * w + fq * 4 + jj) * 40 + nt * 16 + fr] = f2bf(-aD[jj]);
      }
    }
    __builtin_amdgcn_wave_barrier();
    xn = *(const bf16x8*)(nAt + (16 * w + fr) * 40 + fq * 8);
    xd = *(const bf16x8*)(nD0 + (16 * w + fr) * 40 + fq * 8);
  }
  char* pq = (char*)P.regPQ + (size_t)unit * 12288;
  char* lo = (char*)P.out + (size_t)unit * 12288;
  bfraw* PmT = (bfraw*)pq; bfraw* QT = (bfraw*)(pq + 8192);
  uint2* Lb = (uint2*)lo; uint2* Ob = (uint2*)(lo + 8192);
#pragma unroll
  for (int nt = 0; nt < 2; ++nt) {
    bf16x8 ymb = *(const bf16x8*)(MbrT + (nt * 16 + fr) * 40 + fq * 8), ymk = *(const bf16x8*)(MkrT + (nt * 16 + fr) * 40 + fq * 8);
    f32x4 aQ = MFMA16(xn, ymb, z4);
    f32x4 aO = MFMA16(xv, ymk, z4); aO = MFMA16(xd, ymb, aO);
    int tt = nt * 16 + fr; float q[4];
#pragma unroll
    for (int jj = 0; jj < 4; ++jj) q[jj] = aQ[jj] + bf2f(Rh[tt * 72 + 16 * w + fq * 4 + jj]);
    uint2 o; o.x = pack2(q[0], q[1]); o.y = pack2(q[2], q[3]);
    *(uint2*)(QT + tt * 64 + 16 * w + fq * 4) = o;
    uint2 o2; o2.x = pack2(aO[0], aO[1]); o2.y = pack2(aO[2], aO[3]);
    Ob[(w * 2 + nt) * 64 + lane] = o2;
  }
#pragma unroll
  for (int nt = 0; nt < 4; ++nt) {
    bf16x8 ybB, ybK;
#pragma unroll
    for (int e = 0; e < 8; ++e) { ybB[e] = (short)Bh[(fq * 8 + e) * 72 + nt * 16 + fr]; ybK[e] = (short)Kh[(fq * 8 + e) * 72 + nt * 16 + fr]; }
    f32x4 aP = MFMA16(xn, ybB, z4);
    f32x4 aL = MFMA16(xv, ybK, z4); aL = MFMA16(xd, ybB, aL);
    int jp = nt * 16 + fr; float gc = gC[jp]; float pm[4], l[4];
#pragma unroll
    for (int jj = 0; jj < 4; ++jj) { int j = 16 * w + fq * 4 + jj; pm[jj] = gc * ((j == jp ? 1.f : 0.f) + aP[jj]); l[jj] = gc * aL[jj]; }
    uint2 o; o.x = pack2(pm[0], pm[1]); o.y = pack2(pm[2], pm[3]);
    *(uint2*)(PmT + jp * 64 + 16 * w + fq * 4) = o;
    uint2 o2; o2.x = pack2(l[0], l[1]); o2.y = pack2(l[2], l[3]);
    Lb[(w * 4 + nt) * 64 + lane] = o2;
  }
}

__device__ __forceinline__ f32x4 unpack4(uint2 u) {
  f32x4 r; r[0] = __uint_as_float(u.x << 16); r[1] = __uint_as_float(u.x & 0xffff0000u); r[2] = __uint_as_float(u.y << 16); r[3] = __uint_as_float(u.y & 0xffff0000u); return r;
}
struct SeqOps { bf16x8 pm[4][2]; bf16x8 qt[2][2]; uint2 l[4]; uint2 o0[2]; };
__device__ __forceinline__ void seq_load(const Params& P, int bh, int c, int w, int lane, SeqOps& o) {
  const int fr = lane & 15, fq = lane >> 4;
  const int unit = bh * 64 + (c < 63 ? c : 63);
  const char* pq = (const char*)P.regPQ + (size_t)unit * 12288; const char* lo = (const char*)P.out + (size_t)unit * 12288;
  const bfraw* PmT = (const bfraw*)pq; const bfraw* QT = (const bfraw*)(pq + 8192);
  const uint2* Lb = (const uint2*)lo; const uint2* Ob = (const uint2*)(lo + 8192);
#pragma unroll
  for (int nt = 0; nt < 4; ++nt)
#pragma unroll
    for (int ks = 0; ks < 2; ++ks) o.pm[nt][ks] = *(const bf16x8*)(PmT + (nt * 16 + fr) * 64 + ks * 32 + fq * 8);
#pragma unroll
  for (int nt = 0; nt < 2; ++nt)
#pragma unroll
    for (int ks = 0; ks < 2; ++ks) o.qt[nt][ks] = *(const bf16x8*)(QT + (nt * 16 + fr) * 64 + ks * 32 + fq * 8);
#pragma unroll
  for (int nt = 0; nt < 4; ++nt) o.l[nt] = Lb[(w * 4 + nt) * 64 + lane];
#pragma unroll
  for (int nt = 0; nt < 2; ++nt) o.o0[nt] = Ob[(w * 2 + nt) * 64 + lane];
}
__device__ __forceinline__ void seq_step(const Params& P, int b, int h, int c, int w, int lane, float* strip, f32x4 (&S)[4], const SeqOps& o) {
  const int fr = lane & 15, fq = lane >> 4;
  bfraw* Oraw = (bfraw*)((char*)P.out + 50331648);
  __builtin_amdgcn_wave_barrier();
#pragma unroll
  for (int nt = 0; nt < 4; ++nt)
#pragma unroll
    for (int jj = 0; jj < 4; ++jj) strip[(fq * 4 + jj) * 68 + nt * 16 + fr] = S[nt][jj];
  __builtin_amdgcn_wave_barrier();
  bf16x8 xh[2], xl[2];
#pragma unroll
  for (int ks = 0; ks < 2; ++ks) {
    float4 p0 = *(const float4*)(strip + fr * 68 + ks * 32 + fq * 8), p1 = *(const float4*)(strip + fr * 68 + ks * 32 + fq * 8 + 4);
    float xs[8] = {p0.x, p0.y, p0.z, p0.w, p1.x, p1.y, p1.z, p1.w};
    unsigned int hp[4], lp[4];
#pragma unroll
    for (int e = 0; e < 4; ++e) {
      hp[e] = pack2(xs[2 * e], xs[2 * e + 1]);
      lp[e] = pack2(xs[2 * e] - __uint_as_float(hp[e] << 16), xs[2 * e + 1] - __uint_as_float(hp[e] & 0xffff0000u));
    }
    xh[ks] = __builtin_bit_cast(bf16x8, make_uint4(hp[0], hp[1], hp[2], hp[3]));
    xl[ks] = __builtin_bit_cast(bf16x8, make_uint4(lp[0], lp[1], lp[2], lp[3]));
  }
  f32x4 aO[2];
#pragma unroll
  for (int nt = 0; nt < 2; ++nt) {
    aO[nt] = unpack4(o.o0[nt]);
#pragma unroll
    for (int ks = 0; ks < 2; ++ks) { aO[nt] = MFMA16(xh[ks], o.qt[nt][ks], aO[nt]); aO[nt] = MFMA16(xl[ks], o.qt[nt][ks], aO[nt]); }
  }
#pragma unroll
  for (int nt = 0; nt < 4; ++nt) {
    f32x4 aS = unpack4(o.l[nt]);
#pragma unroll
    for (int ks = 0; ks < 2; ++ks) { aS = MFMA16(xh[ks], o.pm[nt][ks], aS); aS = MFMA16(xl[ks], o.pm[nt][ks], aS); }
    S[nt] = aS;
  }
  const int tok0 = b * 2048 + c * 32;
#pragma unroll
  for (int nt = 0; nt < 2; ++nt) {
    uint2 ov; ov.x = pack2(aO[nt][0], aO[nt][1]); ov.y = pack2(aO[nt][2], aO[nt][3]);
    *(uint2*)(Oraw + (size_t)(tok0 + nt * 16 + fr) * 512 + h * 64 + 16 * w + fq * 4) = ov;
  }
}
__device__ void wkv_seq(const Params& P, int bh, char* smem) {
  const int tid = threadIdx.x, lane = tid & 63, w = tid >> 6, fr = lane & 15, fq = lane >> 4;
  float* strip = (float*)smem + w * 16 * 68;
  const int b = bh >> 3, h = bh & 7;
  f32x4 S[4];
#pragma unroll
  for (int nt = 0; nt < 4; ++nt) S[nt] = f32x4{0.f, 0.f, 0.f, 0.f};
  SeqOps o0, o1, o2;
  seq_load(P, bh, 0, w, lane, o0);
  seq_load(P, bh, 1, w, lane, o1);
#pragma unroll 1
  for (int c = 0; c < 66; c += 3) {
    seq_load(P, bh, c + 2, w, lane, o2);
    seq_step(P, b, h, c, w, lane, strip, S, o0);
    seq_load(P, bh, c + 3, w, lane, o0);
    if (c + 1 < 64) seq_step(P, b, h, c + 1, w, lane, strip, S, o1);
    seq_load(P, bh, c + 4, w, lane, o1);
    if (c + 2 < 64) seq_step(P, b, h, c + 2, w, lane, strip, S, o2);
  }
  float* so = P.out + O_WKP + ((size_t)bh * 64) * 64;
#pragma unroll
  for (int nt = 0; nt < 4; ++nt)
#pragma unroll
    for (int jj = 0; jj < 4; ++jj) so[(16 * w + fq * 4 + jj) * 64 + nt * 16 + fr] = S[nt][jj];
}

__device__ __forceinline__ int next_job(unsigned* ctr, float* sred) {
  __syncthreads();
  if (threadIdx.x == 0) ((int*)sred)[200] = (int)atomicAdd(ctr, 1u);
  __syncthreads();
  return ((int*)sred)[200];
}

__device__ void phase3a(const Params& P, char* smem) {
  for (int unit = blockIdx.x; unit < 4096; unit += gridDim.x) wkv_chunk_pre(P, unit, smem);
}

__device__ void phase3b(const Params& P, char* smem, float* sred) {
  int wid = threadIdx.x >> 6;
  bfraw* sA = (bfraw*)smem; bfraw* sB = sA + 128 * LROW;
  if (blockIdx.x < 64) { wkv_seq(P, blockIdx.x, smem); return; }
  const int nb = gridDim.x - 64;
  for (int job = blockIdx.x - 64; job < 256; job += nb) wkv_direct(P, 64 + job * 4 + wid, (float*)smem + wid * 320);
  __syncthreads();
  for (int job = (blockIdx.x - 64 + nb - (256 % nb)) % nb; job < 528; job += nb) {
    int rt = job >> 2, gi = job & 3; int row0 = rt * 128;
    f32x4 acc[4][4]; ZERO_ACC(acc)
    float* sS = (float*)smem;
    gemm_main(acc, PlainLoad{P.regP + (size_t)row0 * 512 + gi * 128, 512}, PlainLoad{P.Wt_pool + (size_t)gi * 16384, 128}, 128, sA, sB);
    acc_to_lds(acc, sS);
#pragma unroll 4
    for (int i = 0; i < 16; ++i) { SEG_VARS(i) int c = gi * 128 + c4;
      float4 ps = *(const float4*)(P.pool_scale + c);
      uint2 o; o.x = pack2(v.x * ps.x, v.y * ps.y); o.y = pack2(v.z * ps.z, v.w * ps.w);
      *(uint2*)(P.regY + (size_t)(row0 + row) * 1024 + 512 + c) = o; }
  }
  __syncthreads();
  for (int job = (blockIdx.x - 64 + 2 * nb - ((256 + 528) % nb)) % nb; job < N_LATE_PREP; job += nb) { __syncthreads(); late_prep_job(P, job < 512 ? 576 + job : job - 512, smem); }
}

__device__ void phase3c(const Params& P) {
  const int lane = threadIdx.x & 63, wid = threadIdx.x >> 6;
  const bfraw* Oraw = (const bfraw*)((const char*)P.out + 50331648);
  const bfraw* Gg = P.regB + (size_t)NT * 512;
  const int c0 = lane * 8, hd = lane >> 3;
  float mu[8], lg[8], lb[8];
  { float4 a = *(const float4*)(P.shift_mu + 1024 + c0), c = *(const float4*)(P.shift_mu + 1024 + c0 + 4);
    mu[0] = a.x; mu[1] = a.y; mu[2] = a.z; mu[3] = a.w; mu[4] = c.x; mu[5] = c.y; mu[6] = c.z; mu[7] = c.w;
    a = *(const float4*)(P.lnx_g + c0); c = *(const float4*)(P.lnx_g + c0 + 4);
    lg[0] = a.x; lg[1] = a.y; lg[2] = a.z; lg[3] = a.w; lg[4] = c.x; lg[5] = c.y; lg[6] = c.z; lg[7] = c.w;
    a = *(const float4*)(P.lnx_b + c0); c = *(const float4*)(P.lnx_b + c0 + 4);
    lb[0] = a.x; lb[1] = a.y; lb[2] = a.z; lb[3] = a.w; lb[4] = c.x; lb[5] = c.y; lb[6] = c.z; lb[7] = c.w; }
#pragma unroll 2
  for (int tau = blockIdx.x * 4 + wid; tau < NPR; tau += gridDim.x * 4) {
    const bool first = (tau & 2047) == 0;
    float o[8], zv[8], pv[8], g[8];
    unpack8(*(const uint4*)(Oraw + (size_t)tau * 512 + c0), o);
    unpack8(*(const uint4*)(P.regZ + (size_t)tau * DIN + 1024 + c0), zv);
    unpack8(*(const uint4*)(P.regZ + (size_t)(first ? tau : tau - 1) * DIN + 1024 + c0), pv);
    unpack8(*(const uint4*)(Gg + (size_t)tau * 512 + c0), g);
    const float bon = P.bonus[(size_t)tau * 8 + hd];
    float sm = 0.f;
#pragma unroll
    for (int i = 0; i < 8; ++i) sm += o[i];
    sm += __shfl_xor(sm, 1, 64); sm += __shfl_xor(sm, 2, 64); sm += __shfl_xor(sm, 4, 64);
    const float mean = sm * (1.f / 64.f);
    float sq = 0.f;
#pragma unroll
    for (int i = 0; i < 8; ++i) { o[i] -= mean; sq += o[i] * o[i]; }
    sq += __shfl_xor(sq, 1, 64); sq += __shfl_xor(sq, 2, 64); sq += __shfl_xor(sq, 4, 64);
    const float rs = rsqrtf(sq * (1.f / 64.f) + 64e-5f);
    float y[8];
#pragma unroll
    for (int i = 0; i < 8; ++i) {
      float p = first ? 0.f : pv[i];
      float v = zv[i] + (p - zv[i]) * mu[i];
      y[i] = (o[i] * rs * lg[i] + lb[i] + bon * v) * g[i];
    }
    *(uint4*)(P.regY + (size_t)tau * 1024 + c0) = pack8(y);
  }
}

__device__ void phase4(const Params& P, char* smem, float* sred) {
  bfraw* sA = (bfraw*)smem; bfraw* sB = sA + 128 * LROW;
  bfraw* hb = P.regA;
  const int NG = 132 * 8, NCONV = 8192;
  for (int it = 0;; ++it) {
    {
      int rt, ct; if (!xcd_job(it, 8, 8, rt, ct)) break; int row0 = rt * 128, col0 = ct * 128;
      f32x4 acc[4][4]; ZERO_ACC(acc)
      gemm_main(acc, PlainLoad{P.regY + (size_t)row0 * 1024, 1024}, PlainLoad{P.Wt_out + (size_t)col0 * 1024, 1024}, 1024, sA, sB);
      float* sS = (float*)smem;
      acc_to_lds(acc, sS);
#pragma unroll 4
      for (int i = 0; i < 16; ++i) { SEG_VARS(i)
        int tau = row0 + row, c = col0 + c4;
        float4 xv = *(const float4*)(xrow(P, tau) + c);
        float4 h; h.x = xv.x + v.x; h.y = xv.y + v.y; h.z = xv.z + v.z; h.w = xv.w + v.w;
        *(float4*)(P.out + (size_t)tau * 1024 + c) = h;
        uint2 o; o.x = pack2(h.x, h.y); o.y = pack2(h.z, h.w);
        *(uint2*)(hb + (size_t)tau * 1024 + c) = o;
        float ss = h.x * h.x + h.y * h.y + h.z * h.z + h.w * h.w;
        ss += __shfl_xor(ss, 1, 64); ss += __shfl_xor(ss, 2, 64); ss += __shfl_xor(ss, 4, 64); ss += __shfl_xor(ss, 8, 64); ss += __shfl_xor(ss, 16, 64);
        if ((etid_ & 31) == 0) P.ssq1[(size_t)ct * NT + tau] = ss; }
    }
  }
  for (int job0 = NG + blockIdx.x * 4; job0 < NG + NCONV; job0 += gridDim.x * 4) {
    int job = job0;
    for (int jq = 0; jq < 4; ++jq, ++job) {
      size_t e0 = ((size_t)(job - NG) * 256 + threadIdx.x) * 16;
      const bool isu = e0 < (size_t)16777216;
      const float* src = isu ? P.peer_u + e0 : P.peer_v + (e0 - 16777216);
      const float sc = isu ? 256.f : 32.f;
      unsigned int wv[4];
#pragma unroll
      for (int q = 0; q < 4; ++q) {
        float4 a = *(const float4*)(src + q * 4);
        int wq = __builtin_amdgcn_cvt_pk_fp8_f32(a.x * sc, a.y * sc, 0, false);
        wq = __builtin_amdgcn_cvt_pk_fp8_f32(a.z * sc, a.w * sc, wq, true);
        wv[q] = (unsigned int)wq;
      }
      *(uint4*)((unsigned char*)P.regZ + e0) = make_uint4(wv[0], wv[1], wv[2], wv[3]);
    }
  }
}

struct PLoad {
  const Params* P; int row0;
  __device__ __forceinline__ uint4 operator()(int r, int k) const {
    int tau = row0 + r;
    const float* pr = (tau < NPR ? P->p_prompt + (size_t)tau * 256 : P->p_sample + (size_t)(tau - NPR) * 256) + k;
    float4 a = *(const float4*)pr, c = *(const float4*)(pr + 4);
    uint4 o; o.x = pack2(a.x, a.y); o.y = pack2(a.z, a.w); o.z = pack2(c.x, c.y); o.w = pack2(c.z, c.w); return o;
  }
};
#define TK_INS(x) { _Pragma("unroll") for (int i_ = 15; i_ > 0; --i_) s[i_] = __builtin_amdgcn_fmed3f(s[i_ - 1], s[i_], x); s[0] = fmaxf(s[0], x); }
__device__ void phase5(const Params& P, char* smem, float* sred) {
  bfraw* sA = (bfraw*)smem; bfraw* sB = sA + 128 * LROW;
  const bfraw* hb = P.regA; float* TK = (float*)P.regB;
  float* sS = (float*)smem;
  for (int it = 0;; ++it) {
    int rt, ct; if (!xcd_job(it, 16, 8, rt, ct)) break; int row0 = rt * 128, col0 = ct * 128;
    EPI_VARS
    if (tid < 128) {
      float s = 0.f;
#pragma unroll
      for (int c = 0; c < 8; ++c) s += P.ssq1[(size_t)c * NT + row0 + tid];
      sred[tid] = rsqrtf(s * (1.f / 1024.f) + 1e-6f);
    }
    f32x4 acc[4][4]; ZERO_ACC(acc)
    gemm_main<true>(acc, PlainLoad{hb + (size_t)row0 * 1024, 1024}, PlainLoad{P.Wt_q + (size_t)col0 * 1024, 1024}, 1024, sA, sB);
    EPI_LOOP { EPI_RC
      float v = acc[m][n][j] * sred[row];
      unsigned int bits = (__float_as_uint(v) & ~127u) | (unsigned)col;
      sS[row * 128 + (col ^ (row & 31))] = __uint_as_float(bits); }
    __syncthreads();
    int tk_ = threadIdx.x; asm volatile("" : "+v"(tk_));
    int r = tk_ & 127, q = tk_ >> 7;
    float s[16];
#pragma unroll
    for (int i = 0; i < 16; ++i) s[i] = -3.0e38f;
    for (int i = 0; i < 64; ++i) { float x = sS[r * 128 + ((q * 64 + i) ^ (r & 31))]; TK_INS(x) }
    __syncthreads();
    if (q == 1) {
#pragma unroll
      for (int i = 0; i < 16; ++i) sS[r * 17 + i] = s[i];
    }
    __syncthreads();
    if (q == 0) {
#pragma unroll
      for (int i = 0; i < 16; ++i) { float x = sS[r * 17 + i]; TK_INS(x) }
      float* dst = TK + (size_t)(row0 + r) * 256 + ct * 16;
#pragma unroll
      for (int i = 0; i < 4; ++i) *(float4*)(dst + i * 4) = make_float4(s[i * 4], s[i * 4 + 1], s[i * 4 + 2], s[i * 4 + 3]);
    }
    __syncthreads();
  }
  for (int job = (int)((blockIdx.x * 37u) % gridDim.x); job < 132 * 8; job += gridDim.x) {
    __syncthreads();
    int rt = job >> 3, ct = job & 7; int row0 = rt * 128, col0 = ct * 128;
    f32x4 acc[4][4]; ZERO_ACC(acc)
    gemm_main(acc, PLoad{&P, row0}, PlainLoad{P.Wt_ple + (size_t)col0 * 256, 256}, 256, sA, sB);
    acc_to_lds(acc, sS);
#pragma unroll 4
    for (int i = 0; i < 16; ++i) { SEG_VARS(i)
      uint2 o; o.x = pack2(v.x, v.y); o.y = pack2(v.z, v.w);
      *(uint2*)(P.regY + (size_t)(row0 + row) * 1024 + col0 + c4) = o; }
  }
}

typedef float f32x2 __attribute__((ext_vector_type(2)));
__device__ __forceinline__ float gelu_exact(float x) { return 0.5f * x * (1.f + erff(x * 0.70710678118f)); }
__device__ __forceinline__ float dot16_fp8(uint4 r, const f32x2 (&xn2)[8]) {
  f32x2 acc = __builtin_amdgcn_cvt_pk_f32_fp8((int)r.x, false) * xn2[0];
  acc += __builtin_amdgcn_cvt_pk_f32_fp8((int)r.x, true) * xn2[1];
  acc += __builtin_amdgcn_cvt_pk_f32_fp8((int)r.y, false) * xn2[2];
  acc += __builtin_amdgcn_cvt_pk_f32_fp8((int)r.y, true) * xn2[3];
  acc += __builtin_amdgcn_cvt_pk_f32_fp8((int)r.z, false) * xn2[4];
  acc += __builtin_amdgcn_cvt_pk_f32_fp8((int)r.z, true) * xn2[5];
  acc += __builtin_amdgcn_cvt_pk_f32_fp8((int)r.w, false) * xn2[6];
  acc += __builtin_amdgcn_cvt_pk_f32_fp8((int)r.w, true) * xn2[7];
  return acc.x + acc.y;
}
__device__ __forceinline__ void axpy16_fp8(uint4 r, float a, f32x2 (&o2)[8]) {
  f32x2 a2 = {a, a};
  o2[0] += a2 * __builtin_amdgcn_cvt_pk_f32_fp8((int)r.x, false);
  o2[1] += a2 * __builtin_amdgcn_cvt_pk_f32_fp8((int)r.x, true);
  o2[2] += a2 * __builtin_amdgcn_cvt_pk_f32_fp8((int)r.y, false);
  o2[3] += a2 * __builtin_amdgcn_cvt_pk_f32_fp8((int)r.y, true);
  o2[4] += a2 * __builtin_amdgcn_cvt_pk_f32_fp8((int)r.z, false);
  o2[5] += a2 * __builtin_amdgcn_cvt_pk_f32_fp8((int)r.z, true);
  o2[6] += a2 * __builtin_amdgcn_cvt_pk_f32_fp8((int)r.w, false);
  o2[7] += a2 * __builtin_amdgcn_cvt_pk_f32_fp8((int)r.w, true);
}
__device__ __forceinline__ float reduce8(const float (&p)[8], int lane) {
  float q[4], r[2], s;
  const bool b0 = lane & 1, b1 = lane & 2, b2 = lane & 4;
#pragma unroll
  for (int k = 0; k < 4; ++k) { float send = b0 ? p[k] : p[k + 4]; float keep = b0 ? p[k + 4] : p[k]; q[k] = keep + __shfl_xor(send, 1, 64); }
#pragma unroll
  for (int k = 0; k < 2; ++k) { float send = b1 ? q[k] : q[k + 2]; float keep = b1 ? q[k + 2] : q[k]; r[k] = keep + __shfl_xor(send, 2, 64); }
  { float send = b2 ? r[0] : r[1]; float keep = b2 ? r[1] : r[0]; s = keep + __shfl_xor(send, 4, 64); }
  s += __shfl_xor(s, 8, 64); s += __shfl_xor(s, 16, 64); s += __shfl_xor(s, 32, 64);
  return s;
}
#define PEER_LOAD(buf, tab, bt) _Pragma("unroll") for (int k_ = 0; k_ < 8; ++k_) { int e_ = __builtin_amdgcn_readfirstlane(sexp[(bt) * 8 + k_]); buf[k_] = *(const uint4*)(tab + (size_t)e_ * 1024 + lane * 16); }
#define PEER_UCOMP(buf, bt) { float p_[8]; _Pragma("unroll") for (int k_ = 0; k_ < 8; ++k_) p_[k_] = dot16_fp8(buf[k_], xn2); float s_ = reduce8(p_, lane); \
    if ((lane >> 3) == ((bt) & 7)) { if ((bt) < 8) d0 = s_; else d1 = s_; } }
#define PEER_VCOMP(buf, bt) { float asel_ = (bt) < 8 ? act0 : act1; _Pragma("unroll") for (int k_ = 0; k_ < 8; ++k_) { \
    const int br_ = ((k_ & 1) << 2) | (k_ & 2) | ((k_ >> 2) & 1); \
    float a_ = __uint_as_float((unsigned)__builtin_amdgcn_readlane((int)__float_as_uint(asel_), (((bt) & 7) << 3) | br_)); axpy16_fp8(buf[k_], a_, o2); } }

__device__ void peer_token(const Params& P, int tau, float* sw, bool dry = false) {
  const int lane = threadIdx.x & 63;
  float* scand = sw; int* sexp = (int*)(sw + 64); float* sgate = sw + 192;
  const unsigned char* U8 = (const unsigned char*)P.regZ; const unsigned char* V8 = U8 + (size_t)16777216;
  float* hrow = P.out + (size_t)tau * 1024;
  float x[16]; f32x2 xn2[8];
#pragma unroll
  for (int j = 0; j < 4; ++j) { float4 a = *(const float4*)(hrow + lane * 16 + j * 4); x[j * 4] = a.x; x[j * 4 + 1] = a.y; x[j * 4 + 2] = a.z; x[j * 4 + 3] = a.w; }
  float ss = 0.f;
#pragma unroll
  for (int i = 0; i < 16; ++i) ss += x[i] * x[i];
  ss = wsum(ss);
  const float rstd = rsqrtf(ss * (1.f / 1024.f) + 1e-6f) * (1.f / 256.f);
#pragma unroll
  for (int j = 0; j < 4; ++j) {
    float4 g = *(const float4*)(P.norm_ffn_g + lane * 16 + j * 4);
    xn2[j * 2] = f32x2{x[j * 4] * rstd * g.x, x[j * 4 + 1] * rstd * g.y};
    xn2[j * 2 + 1] = f32x2{x[j * 4 + 2] * rstd * g.z, x[j * 4 + 3] * rstd * g.w};
  }
  int ca, cb; { int c = lane;
    if (c < 16) { ca = 0; cb = c; } else if (c < 24) { ca = 1; cb = c - 16; } else if (c < 29) { ca = 2; cb = c - 24; }
    else if (c < 33) { ca = 3; cb = c - 29; } else if (c < 36) { ca = 4; cb = c - 33; } else if (c < 38) { ca = 5; cb = c - 36; }
    else if (c < 40) { ca = 6; cb = c - 38; } else if (c < 42) { ca = 7; cb = c - 40; } else if (c < 50) { ca = c - 34; cb = 0; } else { ca = 0; cb = 0; } }
  const float* tk = (const float*)P.regB + (size_t)tau * 256;
  for (int hh = 0; hh < 8; ++hh) {
    float k1 = tk[(hh * 2) * 16 + ca], k2 = tk[(hh * 2 + 1) * 16 + cb];
    float s = lane < 50 ? k1 + k2 : -3.0e38f;
    __builtin_amdgcn_wave_barrier();
    scand[lane] = s;
    __builtin_amdgcn_wave_barrier();
    int rank = 0;
#pragma unroll
    for (int c4 = 0; c4 < 13; ++c4) {
      float4 q = *(const float4*)(scand + c4 * 4);
      rank += (q.x > s || (q.x == s && c4 * 4 < lane)) ? 1 : 0;
      rank += (q.y > s || (q.y == s && c4 * 4 + 1 < lane)) ? 1 : 0;
      if (c4 < 12) { rank += (q.z > s || (q.z == s && c4 * 4 + 2 < lane)) ? 1 : 0; rank += (q.w > s || (q.w == s && c4 * 4 + 3 < lane)) ? 1 : 0; }
    }
    bool sel = lane < 50 && rank < 16;
    float mx = wmaxf(s);
    float e = sel ? __expf(s - mx) : 0.f;
    float Z = wsum(e);
    if (sel) { sexp[hh * 16 + rank] = (int)((__float_as_uint(k1) & 127u) * 128u + (__float_as_uint(k2) & 127u)); sgate[hh * 16 + rank] = e / Z; }
  }
  __builtin_amdgcn_wave_barrier();
  float d0 = 0.f, d1 = 0.f;
  uint4 A[8], B[8];
  PEER_LOAD(A, U8, 0)
  for (int b2 = 0; b2 < 8; ++b2) {
    PEER_LOAD(B, U8, 2 * b2 + 1)
    PEER_UCOMP(A, 2 * b2)
    if (b2 < 7) { PEER_LOAD(A, U8, 2 * b2 + 2) } else { PEER_LOAD(A, V8, 0) }
    PEER_UCOMP(B, 2 * b2 + 1)
  }
  const int slotA = (lane & ~7) | ((lane & 1) << 2) | (lane & 2) | ((lane >> 2) & 1);
  const float act0 = gelu_exact(d0) * sgate[slotA] * (1.f / 32.f), act1 = gelu_exact(d1) * sgate[64 + slotA] * (1.f / 32.f);
  f32x2 o2[8];
#pragma unroll
  for (int i = 0; i < 8; ++i) o2[i] = f32x2{0.f, 0.f};
  for (int b2 = 0; b2 < 8; ++b2) {
    PEER_LOAD(B, V8, 2 * b2 + 1)
    PEER_VCOMP(A, 2 * b2)
    if (b2 < 7) { PEER_LOAD(A, V8, 2 * b2 + 2) }
    PEER_VCOMP(B, 2 * b2 + 1)
  }
  float o[16]; float s2 = 0.f;
#pragma unroll
  for (int i = 0; i < 8; ++i) { o[2 * i] = x[2 * i] + o2[i].x; o[2 * i + 1] = x[2 * i + 1] + o2[i].y; }
#pragma unroll
  for (int i = 0; i < 16; ++i) s2 += o[i] * o[i];
  s2 = wsum(s2);
  if (dry) { if (s2 == 123.456f) P.rstd2[tau] = s2; return; }
  if (lane == 0) P.rstd2[tau] = rsqrtf(s2 * (1.f / 1024.f) + 1e-6f);
  bfraw* hb = P.regA + (size_t)tau * 1024;
#pragma unroll
  for (int j = 0; j < 4; ++j) *(float4*)(hrow + lane * 16 + j * 4) = make_float4(o[j * 4], o[j * 4 + 1], o[j * 4 + 2], o[j * 4 + 3]);
  *(uint4*)(hb + lane * 16) = pack8(o); *(uint4*)(hb + lane * 16 + 8) = pack8(o + 8);
}

__device__ void phase6(const Params& P, char* smem, bool dry = false) {
  const int wid = threadIdx.x >> 6;
  float* sw = (float*)smem + wid * 320;
  for (int tau = blockIdx.x * 4 + wid; tau < NT; tau += gridDim.x * 4) peer_token(P, tau, sw, dry);
}

__device__ void phase7(const Params& P, char* smem, float* sred) {
  bfraw* sA = (bfraw*)smem; bfraw* sB = sA + 128 * LROW;
  const bfraw* hb = P.regA;
  for (int it = 0;; ++it) {
    int rt, ct; if (!xcd_job(it, 8, 8, rt, ct)) break; int row0 = rt * 128, col0 = ct * 128;
    f32x4 acc[4][4]; ZERO_ACC(acc)
    float* sS = (float*)smem;
    gemm_main(acc, PlainLoad{hb + (size_t)row0 * 1024, 1024}, PlainLoad{P.Wt_pg + (size_t)col0 * 1024, 1024}, 1024, sA, sB);
    acc_to_lds(acc, sS);
#pragma unroll 2
    for (int i = 0; i < 16; ++i) { SEG_VARS(i)
      int tau = row0 + row, c = col0 + c4;
      float rs = P.rstd2[tau];
      float4 hv = *(float4*)(P.out + (size_t)tau * 1024 + c);
      uint2 ep = *(const uint2*)(P.regY + (size_t)tau * 1024 + c);
      hv.x += __uint_as_float(ep.x << 16) * sigmoidf_(v.x * rs);
      hv.y += __uint_as_float(ep.x & 0xffff0000u) * sigmoidf_(v.y * rs);
      hv.z += __uint_as_float(ep.y << 16) * sigmoidf_(v.z * rs);
      hv.w += __uint_as_float(ep.y & 0xffff0000u) * sigmoidf_(v.w * rs);
      *(float4*)(P.out + (size_t)tau * 1024 + c) = hv;
      float ss = hv.x * hv.x + hv.y * hv.y + hv.z * hv.z + hv.w * hv.w;
      ss += __shfl_xor(ss, 1, 64); ss += __shfl_xor(ss, 2, 64); ss += __shfl_xor(ss, 4, 64); ss += __shfl_xor(ss, 8, 64); ss += __shfl_xor(ss, 16, 64);
      if ((etid_ & 31) == 0) P.ssq3[(size_t)ct * NT + tau] = ss; }
  }
}

__device__ void phase8(const Params& P) {
  for (int job = blockIdx.x; job < NT; job += gridDim.x) {
    int tau = job; int c = threadIdx.x * 4;
    float s = 0.f;
#pragma unroll
    for (int i = 0; i < 8; ++i) s += P.ssq3[(size_t)i * NT + tau];
    float rs = rsqrtf(s * (1.f / 1024.f) + 1e-6f);
    float4 v = *(float4*)(P.out + (size_t)tau * 1024 + c); float4 g = *(const float4*)(P.final_norm_g + c);
    v.x *= rs * g.x; v.y *= rs * g.y; v.z *= rs * g.z; v.w *= rs * g.w;
    *(float4*)(P.out + (size_t)tau * 1024 + c) = v;
  }
}


#define XB_TMO      128
#define XB_XCNT(j)  (256  + 64 * (j))
#define XB_XSUB(j)  (1280 + 64 * (j))
#define XB_XGEN(j)  (2304 + 64 * (j))
#define XB_TOP      3328
#define XB_TOPGEN   3392
#define XCD_BAR_WORDS 3456
#define XB_SPIN_CAP (1u << 18)
#define LAS __attribute__((address_space(3)))
__device__ __forceinline__ unsigned xb_ld(unsigned* p)              { return __hip_atomic_load(p, __ATOMIC_RELAXED, __HIP_MEMORY_SCOPE_AGENT); }
__device__ __forceinline__ unsigned xb_add(unsigned* p, unsigned v) { return __hip_atomic_fetch_add(p, v, __ATOMIC_RELAXED, __HIP_MEMORY_SCOPE_AGENT); }
__device__ __forceinline__ unsigned xb_xcc_id() { return (unsigned)__builtin_amdgcn_s_getreg((3 << 11) | 20) & 0xFu; }
#define XB_SPIN(cond, bar) do { unsigned _sp = 0; while (cond) { __builtin_amdgcn_s_sleep(1); \
    if ((++_sp & 255u) == 0u) { if (xb_ld(&(bar)[XB_TMO])) break; if (_sp > XB_SPIN_CAP) { atomicAdd(&(bar)[XB_TMO], 1u); break; } } } } while (0)
struct XcdBarrier { unsigned* bar; unsigned x; volatile LAS unsigned* st; };
__device__ __forceinline__ XcdBarrier xcd_barrier_post(unsigned* bar, volatile LAS unsigned* st) {
    XcdBarrier b; b.bar = bar; b.x = xb_xcc_id(); b.st = st;
    if (threadIdx.x == 0) (void)xb_add(&bar[XB_XCNT(b.x)], 1u);
    return b;
}
__device__ __forceinline__ void xcd_barrier_complete(unsigned* bar, unsigned x, unsigned& nloc, unsigned& nx) {
    const unsigned G = gridDim.x * gridDim.y * gridDim.z;
    unsigned sum, cnt, mine, sp = 0u;
    for (;;) {
        sum = 0u; cnt = 0u; mine = 0u;
#pragma unroll
        for (unsigned j = 0; j < 16; ++j) { const unsigned c = xb_ld(&bar[XB_XCNT(j)]); sum += c; cnt += (c > 0u) ? 1u : 0u; mine = (j == x) ? c : mine; }
        if (sum == G) break;
        __builtin_amdgcn_s_sleep(1);
        if ((++sp & 255u) == 0u) { if (xb_ld(&bar[XB_TMO])) break; if (sp > XB_SPIN_CAP) { atomicAdd(&bar[XB_TMO], 1u); break; } }
    }
    nloc = mine > 0u ? mine : 1u; nx = cnt > 0u ? cnt : 1u;
}
__device__ __forceinline__ void xcd_barrier(const XcdBarrier& b) {
    asm volatile("s_waitcnt vmcnt(0)" ::: "memory");
    __syncthreads();
    if (threadIdx.x == 0) {
        unsigned* bar = b.bar;
        __builtin_amdgcn_s_waitcnt(0);
        unsigned nloc = b.st[0], nx = b.st[1];
        if (nloc == 0u) { xcd_barrier_complete(bar, b.x, nloc, nx); b.st[0] = nloc; b.st[1] = nx; }
        const unsigned old = xb_add(&bar[XB_XSUB(b.x)], 1u);
        const unsigned gen = old / nloc;
        if (old + 1u == (gen + 1u) * nloc) {
            __builtin_amdgcn_fence(__ATOMIC_RELEASE, "agent");
            asm volatile("s_waitcnt vmcnt(0)" ::: "memory");
            const unsigned og = xb_add(&bar[XB_TOP], 1u);
            const unsigned tg = og / nx;
            if (og + 1u == (tg + 1u) * nx) xb_add(&bar[XB_TOPGEN], 1u);
            else XB_SPIN(xb_ld(&bar[XB_TOPGEN]) == tg, bar);
            __builtin_amdgcn_fence(__ATOMIC_ACQUIRE, "agent");
            xb_add(&bar[XB_XGEN(b.x)], 1u);
            asm volatile("s_waitcnt vmcnt(0)" ::: "memory");
        } else {
            XB_SPIN(xb_ld(&bar[XB_XGEN(b.x)]) == gen, bar);
            __builtin_amdgcn_fence(__ATOMIC_ACQUIRE, "agent");
            asm volatile("s_waitcnt vmcnt(0)" ::: "memory");
        }
    }
    __syncthreads();
}

__global__ void __launch_bounds__(256, 2) mega(Params P) {
  __shared__ __attribute__((aligned(16))) char smem[65536];
  __shared__ float sred[256];
  cg::grid_group grid = cg::this_grid();
  __shared__ uint4 xb_words;
  if (threadIdx.x == 0) xb_words = make_uint4(0u, 0u, 0u, 0u);
  __syncthreads();
  XcdBarrier xb = xcd_barrier_post(P.bar, (volatile LAS unsigned*)&xb_words);
  if (P.phase_hi > 1000) grid.sync();
#ifndef REPMASK
#define REPMASK 0
#endif
#define RUNPH(n, call) if (P.phase_lo <= n && n < P.phase_hi) { call; if ((REPMASK >> n) & 1) { call; } if (n + 1 < P.phase_hi) xcd_barrier(xb); }
  RUNPH(0, phase0(P, smem))
  RUNPH(1, phase1(P, smem))
  RUNPH(2, phase2(P, smem))
  RUNPH(3, phase3a(P, smem))
  RUNPH(4, phase3b(P, smem, sred))
  RUNPH(5, phase3c(P))
  RUNPH(6, phase4(P, smem, sred))
  RUNPH(7, phase5(P, smem, sred))
#ifdef DRYPEER
  phase6(P, smem, P.phase_hi < 100);
#endif
  RUNPH(8, phase6(P, smem))
  RUNPH(9, phase7(P, smem, sred))
  RUNPH(10, phase8(P))
}

extern "C" void kernel_launch(void* const* d_in, const int* in_sizes, int n_in, void* d_out, int out_size, void* d_ws, size_t ws_size,
                              hipStream_t stream) {
  static int grid_blocks = 0;
  if (!grid_blocks) {
    int dev = 0, cus = 0, per_cu = 0;
    hipGetDevice(&dev);
    hipDeviceGetAttribute(&cus, hipDeviceAttributeMultiprocessorCount, dev);
    hipOccupancyMaxActiveBlocksPerMultiprocessor(&per_cu, mega, 256, 0);
    if (per_cu > 2) per_cu = 2;
    grid_blocks = cus * per_cu;
  }
  Params P{};
  const float** pf = (const float**)&P;
  for (int i = 0; i < 32; ++i) pf[i] = (const float*)d_in[i];
  P.out = (float*)d_out;
  char* w = (char*)d_ws; size_t off = 0;
  auto take = [&](size_t bytes) { char* p = w + off; off += (bytes + 255) & ~(size_t)255; return p; };
  P.Wt_in = (bfraw*)take((size_t)2304 * LDP * 2);
  P.Wt_out = (bfraw*)take((size_t)1024 * 1024 * 2);
  P.Wt_q = (bfraw*)take((size_t)2048 * 1024 * 2);
  P.Wt_pg = (bfraw*)take((size_t)1024 * 1024 * 2);
  P.Wt_ple = (bfraw*)take((size_t)1024 * 256 * 2);
  P.Wt_dec = (bfraw*)take((size_t)512 * 64 * 2);
  P.Wt_a = (bfraw*)take((size_t)512 * 64 * 2);
  P.Wt_g = (bfraw*)take((size_t)512 * 128 * 2);
  P.Wt_pool = (bfraw*)take((size_t)4 * 128 * 128 * 2);
  P.ssq1 = (float*)take((size_t)8 * NT * 4);
  P.rstd2 = (float*)take((size_t)NT * 4);
  P.ssq3 = (float*)take((size_t)8 * NT * 4);
  P.regA = (bfraw*)take((size_t)NT * LDP * 2);
  P.regB = (bfraw*)take((size_t)NT * 1024 * 2);
  P.regY = (bfraw*)take((size_t)NT * 1024 * 2);
  P.bar = (unsigned*)take((size_t)4096 * 4);
  P.bonus = (float*)take((size_t)NPR * 8 * 4);
  P.regPQ = (bfraw*)take((size_t)4096 * 12288);
  P.regP = (bfraw*)take((size_t)NT * 512 * 2);
  P.regZ = (bfraw*)take((size_t)NT * 2304 * 2);
  P.phase_lo = 0; P.phase_hi = 11;
  hipMemsetAsync(P.bar, 0, 4096 * 4, stream);
  void* args[] = {&P};
  hipError_t e = hipLaunchCooperativeKernel((void*)mega, dim3(grid_blocks), dim3(256), args, 0, stream);
  if (e != hipSuccess) fprintf(stderr, "cooperative launch failed: %s (grid %d)\n", hipGetErrorString(e), grid_blocks);
}
```

```cpp
#include <hip/hip_runtime.h>
#include <hip/hip_bf16.h>
#include <hip/hip_cooperative_groups.h>
#include <stdint.h>
#include <cstdio>
namespace cg = cooperative_groups;

typedef __attribute__((ext_vector_type(8))) short bf16x8;
typedef __attribute__((ext_vector_type(4))) float f32x4;
typedef unsigned short bfraw;

#define NT 16896
#define NPR 16384
#define DM 1024
#define DIN 2304
#define DSH 1792
#define LDP 1088

struct Params {
  const float *x_prompt, *x_sample, *state_shift, *state_wkv, *state_pool, *p_prompt, *p_sample;
  const float *norm_mix_g, *w_in, *shift_mu, *decay_w0, *decay_b, *a_0, *a_b, *g_b, *k_k, *k_a, *r_k;
  const float *lnx_g, *lnx_b, *pool_w, *pool_scale, *w_out, *norm_ffn_g, *peer_wq, *peer_keys;
  const float *peer_u, *peer_v, *norm_ple_g, *ple_w, *ple_gate_w, *final_norm_g;
  float* out;
  bfraw *Wt_in, *Wt_out, *Wt_q, *Wt_pg, *Wt_ple, *Wt_dec, *Wt_a, *Wt_g, *Wt_pool;
  float *ssq1, *rstd2, *ssq3, *bonus;
  unsigned* bar;
  bfraw *regPQ;
  bfraw *regA;
  bfraw *regB;
  bfraw *regY;
  bfraw *regP;
  bfraw *regZ;
  int phase_lo, phase_hi;
};

#define O_Y 0
#define O_SHP 17301504
#define O_WKP 17315840
#define O_POP 17577984
#define O_SHS 17639424
#define O_WKS 17868800
#define O_POS 22063104

typedef float f32x2_ __attribute__((ext_vector_type(2)));
typedef __bf16 bf16x2_t __attribute__((ext_vector_type(2)));
__device__ __forceinline__ unsigned int pack2(float a, float b) {
  f32x2_ v = {a, b};
  bf16x2_t r = __builtin_convertvector(v, bf16x2_t);
  return __builtin_bit_cast(unsigned int, r);
}
__device__ __forceinline__ unsigned short f2bf(float f) { return (unsigned short)(pack2(f, 0.f) & 0xffffu); }
__device__ __forceinline__ float bf2f(unsigned short h) { return __uint_as_float(((unsigned int)h) << 16); }
__device__ __forceinline__ void unpack8(uint4 v, float* f) {
  f[0] = __uint_as_float(v.x << 16); f[1] = __uint_as_float(v.x & 0xffff0000u);
  f[2] = __uint_as_float(v.y << 16); f[3] = __uint_as_float(v.y & 0xffff0000u);
  f[4] = __uint_as_float(v.z << 16); f[5] = __uint_as_float(v.z & 0xffff0000u);
  f[6] = __uint_as_float(v.w << 16); f[7] = __uint_as_float(v.w & 0xffff0000u);
}
__device__ __forceinline__ uint4 pack8(const float* f) {
  uint4 v; v.x = pack2(f[0], f[1]); v.y = pack2(f[2], f[3]); v.z = pack2(f[4], f[5]); v.w = pack2(f[6], f[7]); return v;
}
__device__ __forceinline__ float wsum(float v) {
#pragma unroll
  for (int o = 32; o > 0; o >>= 1) v += __shfl_xor(v, o, 64);
  return v;
}
__device__ __forceinline__ float wmaxf(float v) {
#pragma unroll
  for (int o = 32; o > 0; o >>= 1) v = fmaxf(v, __shfl_xor(v, o, 64));
  return v;
}
__device__ __forceinline__ float sigmoidf_(float x) { return 1.f / (1.f + __expf(-x)); }

#define LROW 80
template <bool SEQ = false, class AL, class BL>
__device__ __forceinline__ void gemm_main(f32x4 (&acc)[4][4], AL aload, BL bload, int K, bfraw* sA, bfraw* sB) {
  int tid0_ = threadIdx.x; asm volatile("" : "+v"(tid0_));
  const int tid = tid0_, lane = tid & 63, wid = tid >> 6, wr = wid >> 1, wc = wid & 1, fr = lane & 15, fq = lane >> 4;
  uint4 ra0[4], rb0[4], ra1[4], rb1[4];
#define G_LOAD(ra_, rb_, kk_) _Pragma("unroll") for (int i = 0; i < 4; ++i) { int ch = tid + 256 * i; ra_[i] = aload(ch >> 3, (kk_) + (ch & 7) * 8); rb_[i] = bload(ch >> 3, (kk_) + (ch & 7) * 8); if (SEQ) __builtin_amdgcn_sched_barrier(0); }
#define G_STORE(ra_, rb_) _Pragma("unroll") for (int i = 0; i < 4; ++i) { int ch = tid + 256 * i; int r = ch >> 3, c = (ch & 7) * 8; *(uint4*)(sA + r * LROW + c) = ra_[i]; *(uint4*)(sB + r * LROW + c) = rb_[i]; }
#define G_COMPUTE _Pragma("unroll") for (int kk = 0; kk < 2; ++kk) { bf16x8 af[4], bfr[4]; \
        _Pragma("unroll") for (int m = 0; m < 4; ++m) af[m] = *(const bf16x8*)(sA + (wr * 64 + m * 16 + fr) * LROW + kk * 32 + fq * 8); \
        _Pragma("unroll") for (int n = 0; n < 4; ++n) bfr[n] = *(const bf16x8*)(sB + (wc * 64 + n * 16 + fr) * LROW + kk * 32 + fq * 8); \
      __builtin_amdgcn_s_setprio(1); \
      _Pragma("unroll") for (int m = 0; m < 4; ++m) _Pragma("unroll") for (int n = 0; n < 4; ++n) \
        acc[m][n] = __builtin_amdgcn_mfma_f32_16x16x32_bf16(af[m], bfr[n], acc[m][n], 0, 0, 0); \
      __builtin_amdgcn_s_setprio(0); }
  G_LOAD(ra0, rb0, 0)
  if (SEQ) {
#pragma unroll 1
    for (int k0 = 0; k0 < K; k0 += 64) {
      __syncthreads();
      G_STORE(ra0, rb0)
      __syncthreads();
      if (k0 + 64 < K) { G_LOAD(ra0, rb0, k0 + 64) }
      G_COMPUTE
    }
    __syncthreads();
    return;
  }
  if (K > 64) { G_LOAD(ra1, rb1, 64) }
#pragma unroll 1
  for (int k0 = 0; k0 < K; k0 += 128) {
    __syncthreads();
    G_STORE(ra0, rb0)
    __syncthreads();
    if (k0 + 128 < K) { G_LOAD(ra0, rb0, k0 + 128) }
    G_COMPUTE
    if (k0 + 64 < K) {
      __syncthreads();
      G_STORE(ra1, rb1)
      __syncthreads();
      if (k0 + 192 < K) { G_LOAD(ra1, rb1, k0 + 192) }
      G_COMPUTE
    }
  }
  __syncthreads();
}
#define ZERO_ACC(acc) _Pragma("unroll") for (int m_ = 0; m_ < 4; ++m_) _Pragma("unroll") for (int n_ = 0; n_ < 4; ++n_) acc[m_][n_] = f32x4{0.f, 0.f, 0.f, 0.f};
#define EPI_VARS const int tid = threadIdx.x, lane = tid & 63, wid = tid >> 6, wr = wid >> 1, wc = wid & 1, fr = lane & 15, fq = lane >> 4; (void)tid;
#define EPI_LOOP _Pragma("unroll") for (int m = 0; m < 4; ++m) _Pragma("unroll") for (int n = 0; n < 4; ++n) _Pragma("unroll") for (int j = 0; j < 4; ++j)
#define EPI_RC const int row = wr * 64 + m * 16 + fq * 4 + j, col = wc * 64 + n * 16 + fr;

__device__ __forceinline__ int swz(int row, int col) { return row * 128 + (col ^ (((row >> 2) & 1) << 4)); }
__device__ __forceinline__ int acc_to_lds_(const f32x4 (&acc)[4][4], float* sS) {
  EPI_VARS
  EPI_LOOP { EPI_RC sS[swz(row, col)] = acc[m][n][j]; }
  __syncthreads();
  int t_ = threadIdx.x; asm volatile("" : "+v"(t_));
  return t_;
}
#define acc_to_lds(acc, sS) const int etid_ = acc_to_lds_(acc, sS);
#define SEG_VARS(i_) const int idx_ = etid_ + 256 * (i_); const int row = idx_ >> 5, c4 = (idx_ & 31) * 4; const float4 v = *(const float4*)(sS + swz(row, c4));

__device__ __forceinline__ bool xcd_job(int it, int nct, int G, int& rt, int& ct) {
  const int x = blockIdx.x & 7, lr = blockIdx.x >> 3, nl = gridDim.x >> 3;
  const int j = lr + it * nl;
  const int nrt = (132 - x + 7) >> 3;
  if (j >= nrt * nct) return false;
  const int per = nrt * G; const int grp = j / per, rem = j - grp * per;
  rt = (rem / G) * 8 + x; ct = grp * G + rem % G;
  return true;
}

struct PlainLoad {
  const bfraw* base; int ld;
  __device__ __forceinline__ uint4 operator()(int r, int k) const { return *(const uint4*)(base + (size_t)r * ld + k); }
};

__device__ __forceinline__ void row_ssq_store(float (&ps)[4][4], float* sred, float* dst  ) {
  EPI_VARS
#pragma unroll
  for (int m = 0; m < 4; ++m)
#pragma unroll
    for (int j = 0; j < 4; ++j) {
      float v = ps[m][j];
      v += __shfl_xor(v, 1, 64); v += __shfl_xor(v, 2, 64); v += __shfl_xor(v, 4, 64); v += __shfl_xor(v, 8, 64);
      if (fr == 0) sred[wc * 128 + wr * 64 + m * 16 + fq * 4 + j] = v;
    }
  __syncthreads();
  if (tid < 128) dst[tid] = sred[tid] + sred[128 + tid];
  __syncthreads();
}

__device__ void transpose_tile(const float* src, int R, int C, bfraw* dst, const float* scale, int tile, float* sT, int dld = 0) {
  if (dld == 0) dld = R;
  int tc = C / 64; int tk = tile / tc, tn = tile % tc; int k0 = tk * 64, n0 = tn * 64;
  int tid = threadIdx.x, c = tid & 63, r0 = tid >> 6;
  __syncthreads();
  for (int i = 0; i < 16; ++i) { int r = r0 + 4 * i; sT[r * 65 + c] = src[(size_t)(k0 + r) * C + n0 + c]; }
  __syncthreads();
  float sc = scale ? scale[k0 + c] : 1.f;
  for (int i = 0; i < 16; ++i) { int r = r0 + 4 * i; dst[(size_t)(n0 + r) * dld + k0 + c] = f2bf(sT[c * 65 + r] * sc); }
}

__device__ void fold_job(const Params& P, int job, float* sm) {
  int hp = job >> 5, rem = job & 31, kt = rem >> 1, keyt = rem & 1;
  int p = hp & 1;
  float* sK = sm; float* sW = sm + 64 * 65;
  int tid = threadIdx.x, tx = tid & 15, ty = tid >> 4;
  float acc[4][4];
#pragma unroll
  for (int i = 0; i < 4; ++i)
#pragma unroll
    for (int j = 0; j < 4; ++j) acc[i][j] = 0.f;
  for (int ch = 0; ch < 2; ++ch) {
    __syncthreads();
    int c = tid & 63, r0 = tid >> 6;
    for (int i = 0; i < 16; ++i) {
      int r = r0 + 4 * i;
      sK[r * 65 + c] = P.peer_keys[((size_t)p * 128 + keyt * 64 + r) * 128 + ch * 64 + c];
      sW[r * 65 + c] = P.peer_wq[(size_t)(kt * 64 + r) * 2048 + hp * 128 + ch * 64 + c];
    }
    __syncthreads();
    for (int cc = 0; cc < 64; ++cc) {
      float kv[4], wv[4];
#pragma unroll
      for (int i = 0; i < 4; ++i) { kv[i] = sK[(ty * 4 + i) * 65 + cc]; wv[i] = sW[(tx * 4 + i) * 65 + cc]; }
#pragma unroll
      for (int i = 0; i < 4; ++i)
#pragma unroll
        for (int j = 0; j < 4; ++j) acc[i][j] += kv[i] * wv[j];
    }
  }
#pragma unroll
  for (int i = 0; i < 4; ++i) {
    int key = keyt * 64 + ty * 4 + i; int k = kt * 64 + tx * 4;
    float g0 = P.norm_ffn_g[k], g1 = P.norm_ffn_g[k + 1], g2 = P.norm_ffn_g[k + 2], g3 = P.norm_ffn_g[k + 3];
    uint2 v; v.x = pack2(acc[i][0] * g0, acc[i][1] * g1); v.y = pack2(acc[i][2] * g2, acc[i][3] * g3);
    *(uint2*)(P.Wt_q + (size_t)(hp * 128 + key) * 1024 + k) = v;
  }
}

__device__ __forceinline__ const float* xrow(const Params& P, int tau) {
  return tau < NPR ? P.x_prompt + (size_t)tau * 1024 : P.x_sample + (size_t)(tau - NPR) * 1024;
}

__device__ void prep_transpose(const Params& P, int t, float* sT) {
  if (t < 576) transpose_tile(P.w_in, 1024, 2304, P.Wt_in, nullptr, t, sT, LDP);
  else if (t < 832) transpose_tile(P.w_out, 1024, 1024, P.Wt_out, nullptr, t - 576, sT);
  else if (t < 1088) transpose_tile(P.ple_gate_w, 1024, 1024, P.Wt_pg, P.norm_ple_g, t - 832, sT);
  else if (t < 1152) transpose_tile(P.ple_w, 256, 1024, P.Wt_ple, nullptr, t - 1088, sT);
  else if (t < 1160) transpose_tile(P.decay_b, 64, 512, P.Wt_dec, nullptr, t - 1152, sT);
  else if (t < 1168) transpose_tile(P.a_b, 64, 512, P.Wt_a, nullptr, t - 1160, sT);
  else if (t < 1184) transpose_tile(P.g_b, 128, 512, P.Wt_g, nullptr, t - 1168, sT);
  else { int u = t - 1184; int gi = u >> 2; transpose_tile(P.pool_w + gi * 16384, 128, 128, P.Wt_pool + gi * 16384, nullptr, u & 3, sT); }
}
__device__ void late_prep_job(const Params& P, int job, char* smem) {
  if (job < 576) prep_transpose(P, 576 + job, (float*)smem);
  else fold_job(P, job - 576, (float*)smem);
}
#define N_LATE_PREP 1088

__device__ void phase0(const Params& P, char* smem) {
  const int NJ_RMS = NT / 4, NJ_TR = 576 + 48, NJ_POOLCP = 704;
  const int total = NJ_RMS + NJ_TR + NJ_POOLCP;
  int tid = threadIdx.x, lane = tid & 63, wid = tid >> 6;
  for (int job = blockIdx.x; job < total; job += gridDim.x) {
    if (job < NJ_RMS) {
      int tau = job * 4 + wid;
      const float* xr = xrow(P, tau);
      float4 v[4]; float ss = 0.f;
#pragma unroll
      for (int j = 0; j < 4; ++j) { v[j] = *(const float4*)(xr + lane * 4 + 256 * j); ss += v[j].x * v[j].x + v[j].y * v[j].y + v[j].z * v[j].z + v[j].w * v[j].w; }
      ss = wsum(ss);
      float rs = rsqrtf(ss * (1.f / 1024.f) + 1e-6f);
#pragma unroll
      for (int j = 0; j < 4; ++j) {
        float4 g = *(const float4*)(P.norm_mix_g + lane * 4 + 256 * j);
        uint2 o; o.x = pack2(v[j].x * rs * g.x, v[j].y * rs * g.y); o.y = pack2(v[j].z * rs * g.z, v[j].w * rs * g.w);
        *(uint2*)(P.regA + (size_t)tau * LDP + lane * 4 + 256 * j) = o;
      }
    } else if (job < NJ_RMS + NJ_TR) {
      int t = job - NJ_RMS;
      prep_transpose(P, t < 576 ? t : 1152 + (t - 576), (float*)smem);
    } else {
      int e0 = (job - NJ_RMS - NJ_TR) * 1024 + tid * 4;
      if (e0 < 128 * 11 * 512) {
        int b = e0 / (11 * 512), rem = e0 % (11 * 512), j = rem / 512, c = rem % 512;
        float4 v = *(const float4*)(P.state_pool + ((size_t)b * 15 + j + 4) * 512 + c);
        *(float4*)(P.out + O_POS + ((size_t)b * 15 + j) * 512 + c) = v;
      }
    }
  }
}

__device__ void phase1(const Params& P, char* smem) {
  bfraw* sA = (bfraw*)smem; bfraw* sB = sA + 128 * LROW;
  const int nct = DIN / 128;
  for (int it = 0;; ++it) {
    int rt, ct; if (!xcd_job(it, nct, 9, rt, ct)) break; int row0 = rt * 128, col0 = ct * 128;
    f32x4 acc[4][4]; ZERO_ACC(acc)
    gemm_main(acc, PlainLoad{P.regA + (size_t)row0 * LDP, LDP}, PlainLoad{P.Wt_in + (size_t)col0 * LDP, LDP}, 1024, sA, sB);
    float* sS = (float*)smem;
    acc_to_lds(acc, sS);
#pragma unroll 4
    for (int i = 0; i < 16; ++i) {
      SEG_VARS(i)
      int tau = row0 + row, c = col0 + c4;
      uint2 o; o.x = pack2(v.x, v.y); o.y = pack2(v.z, v.w);
      *(uint2*)(P.regZ + (size_t)tau * DIN + c) = o;
      if (tau < NPR) {
        int t = tau & 2047, b = tau >> 11;
        if (c < DSH) { if (t == 2047) *(float4*)(P.out + O_SHP + b * DSH + c) = v; }
        else if (t >= 2033) *(float4*)(P.out + O_POP + ((size_t)b * 15 + (t - 2033)) * 512 + (c - DSH)) = v;
      } else {
        int s = tau - NPR, b = s >> 2, t = s & 3;
        if (c < DSH) { if (t == 3) *(float4*)(P.out + O_SHS + b * DSH + c) = v; }
        else *(float4*)(P.out + O_POS + ((size_t)b * 15 + 11 + t) * 512 + (c - DSH)) = v;
      }
    }
  }
}

struct LoraLoad {
  const Params* P; int row0; int cb; int mode;
  __device__ __forceinline__ uint4 operator()(int r, int k) const {
    int tau = row0 + r; int zc = cb + k;
    float z[8], zp[8];
    unpack8(*(const uint4*)(P->regZ + (size_t)tau * DIN + zc), z);
    bool first; int b;
    if (tau < NPR) { first = (tau & 2047) == 0; b = 0; } else { int s = tau - NPR; first = (s & 3) == 0; b = s >> 2; }
    if (!first) unpack8(*(const uint4*)(P->regZ + (size_t)(tau - 1) * DIN + zc), zp);
    else if (tau < NPR) { for (int i = 0; i < 8; ++i) zp[i] = 0.f; }
    else {
      float4 a = *(const float4*)(P->state_shift + (size_t)b * DSH + zc), c = *(const float4*)(P->state_shift + (size_t)b * DSH + zc + 4);
      zp[0] = a.x; zp[1] = a.y; zp[2] = a.z; zp[3] = a.w; zp[4] = c.x; zp[5] = c.y; zp[6] = c.z; zp[7] = c.w;
    }
    float4 m0 = *(const float4*)(P->shift_mu + zc), m1 = *(const float4*)(P->shift_mu + zc + 4);
    float mu[8] = {m0.x, m0.y, m0.z, m0.w, m1.x, m1.y, m1.z, m1.w};
    float o[8];
#pragma unroll
    for (int i = 0; i < 8; ++i) {
      float zs = z[i] + (zp[i] - z[i]) * mu[i];
      o[i] = mode == 0 ? (1.f - 2.f / (1.f + __expf(2.f * zs))) : (mode == 1 ? zs : sigmoidf_(zs));
    }
    return pack8(o);
  }
};

struct PoolLoad {
  const Params* P; int row0; int gi;
  __device__ __forceinline__ uint4 operator()(int r, int k) const {
    int tau = row0 + r; int pc = gi * 128 + k; int zc = DSH + pc; int w = 2 << gi;
    float u[8], s[8], t8[8];
    unpack8(*(const uint4*)(P->regZ + (size_t)tau * DIN + zc), u);
#pragma unroll
    for (int i = 0; i < 8; ++i) s[i] = u[i];
    float cnt;
    if (tau < NPR) {
      int t = tau & 2047; int nv = min(t + 1, w); cnt = (float)nv;
      for (int d = 1; d < nv; ++d) {
        unpack8(*(const uint4*)(P->regZ + (size_t)(tau - d) * DIN + zc), t8);
#pragma unroll
        for (int i = 0; i < 8; ++i) s[i] += t8[i];
      }
    } else {
      int sidx = tau - NPR, b = sidx >> 2, t = sidx & 3; cnt = (float)w;
      for (int d = 1; d < w; ++d) {
        if (t - d >= 0) unpack8(*(const uint4*)(P->regZ + (size_t)(tau - d) * DIN + zc), t8);
        else {
          const float* sp = P->state_pool + ((size_t)b * 15 + (15 + t - d)) * 512 + pc;
          float4 a = *(const float4*)sp, c = *(const float4*)(sp + 4);
          t8[0] = a.x; t8[1] = a.y; t8[2] = a.z; t8[3] = a.w; t8[4] = c.x; t8[5] = c.y; t8[6] = c.z; t8[7] = c.w;
        }
#pragma unroll
        for (int i = 0; i < 8; ++i) s[i] += t8[i];
      }
    }
    float inv = 1.f / cnt; float o[8];
#pragma unroll
    for (int i = 0; i < 8; ++i) o[i] = s[i] * inv - u[i];
    return pack8(o);
  }
};

__device__ void phase2(const Params& P, char* smem) {
  bfraw* sA = (bfraw*)smem; bfraw* sB = sA + 128 * LROW;
  float* Wd = (float*)P.regA; bfraw* Aa = P.regB; bfraw* Gg = P.regB + (size_t)NT * 512;
  for (int job = blockIdx.x; job < 4224; job += gridDim.x) {
    int item = job * 256 + threadIdx.x; int tau = item >> 6, chunk = item & 63;
    PoolLoad pl{&P, 0, chunk >> 4};
    *(uint4*)(P.regP + (size_t)tau * 512 + chunk * 8) = pl(tau, (chunk & 15) * 8);
  }
  for (int job = blockIdx.x; job < 1584; job += gridDim.x) {
    int kind = job / 528, jj = job % 528, rt = jj >> 2, ct = jj & 3; int row0 = rt * 128;
    f32x4 acc[4][4]; ZERO_ACC(acc)
    float* sS = (float*)smem;
    if (kind == 0) {
      gemm_main<true>(acc, LoraLoad{&P, row0, 1536, 0}, PlainLoad{P.Wt_dec + (size_t)ct * 128 * 64, 64}, 64, sA, sB);
      acc_to_lds(acc, sS);
#pragma unroll 4
      for (int i = 0; i < 16; ++i) { SEG_VARS(i) int c = ct * 128 + c4;
        float4 w0 = *(const float4*)(P.decay_w0 + c); float4 o;
        o.x = __expf(-0.6065306597f * sigmoidf_(w0.x + v.x)); o.y = __expf(-0.6065306597f * sigmoidf_(w0.y + v.y));
        o.z = __expf(-0.6065306597f * sigmoidf_(w0.z + v.z)); o.w = __expf(-0.6065306597f * sigmoidf_(w0.w + v.w));
        *(float4*)(Wd + (size_t)(row0 + row) * 512 + c) = o; }
    } else if (kind == 1) {
      gemm_main<true>(acc, LoraLoad{&P, row0, 1600, 1}, PlainLoad{P.Wt_a + (size_t)ct * 128 * 64, 64}, 64, sA, sB);
      acc_to_lds(acc, sS);
#pragma unroll 4
      for (int i = 0; i < 16; ++i) { SEG_VARS(i) int c = ct * 128 + c4;
        float4 a0 = *(const float4*)(P.a_0 + c); uint2 o;
        o.x = pack2(sigmoidf_(a0.x + v.x), sigmoidf_(a0.y + v.y)); o.y = pack2(sigmoidf_(a0.z + v.z), sigmoidf_(a0.w + v.w));
        *(uint2*)(Aa + (size_t)(row0 + row) * 512 + c) = o; }
    } else if (kind == 2) {
      gemm_main<true>(acc, LoraLoad{&P, row0, 1664, 2}, PlainLoad{P.Wt_g + (size_t)ct * 128 * 128, 128}, 128, sA, sB);
      acc_to_lds(acc, sS);
#pragma unroll 4
      for (int i = 0; i < 16; ++i) { SEG_VARS(i) int c = ct * 128 + c4;
        uint2 o; o.x = pack2(v.x, v.y); o.y = pack2(v.z, v.w);
        *(uint2*)(Gg + (size_t)(row0 + row) * 512 + c) = o; }
    }
  }
}

__device__ void wkv_direct(const Params& P, int unit, float* sw) {
  const int lane = threadIdx.x & 63;
  const float* Wd = (const float*)P.regA; const bfraw* Aa = P.regB; const bfraw* Gg = P.regB + (size_t)NT * 512;
  bool prompt = unit < 64; int b, h, T, tok0;
  if (prompt) { b = unit >> 3; h = unit & 7; T = 2048; tok0 = b * 2048; }
  else { int u = unit - 64; b = u >> 3; h = u & 7; T = 4; tok0 = NPR + 4 * b; }
  float S[64];
  if (prompt) {
#pragma unroll
    for (int j = 0; j < 64; ++j) S[j] = 0.f;
  } else {
    const float* sp = P.state_wkv + (((size_t)b * 8 + h) * 64 + lane) * 64;
#pragma unroll
    for (int j = 0; j < 16; ++j) { float4 v = *(const float4*)(sp + j * 4); S[j * 4] = v.x; S[j * 4 + 1] = v.y; S[j * 4 + 2] = v.z; S[j * 4 + 3] = v.w; }
  }
  const int hc = h * 64 + lane;
  const float mu_r = P.shift_mu[hc], mu_k = P.shift_mu[512 + hc], mu_v = P.shift_mu[1024 + hc];
  const float kkw = P.k_k[hc], kaw = P.k_a[hc], rkw = P.r_k[hc], lg = P.lnx_g[hc], lb = P.lnx_b[hc];
  float pr, pk, pv;
  if (prompt) { pr = pk = pv = 0.f; }
  else { const float* ss = P.state_shift + (size_t)b * DSH; pr = ss[hc]; pk = ss[512 + hc]; pv = ss[1024 + hc]; }
  float* s_kk = sw; float* s_w = sw + 64; float* s_ka = sw + 128; float* s_k = sw + 192; float* s_r = sw + 256;
  for (int t = 0; t < T; ++t) {
    int tau = tok0 + t;
    const bfraw* zr = P.regZ + (size_t)tau * DIN;
    float zr_ = bf2f(zr[hc]), zk_ = bf2f(zr[512 + hc]), zv_ = bf2f(zr[1024 + hc]);
    float r = zr_ + (pr - zr_) * mu_r, k = zk_ + (pk - zk_) * mu_k, v = zv_ + (pv - zv_) * mu_v;
    pr = zr_; pk = zk_; pv = zv_;
    float a = bf2f(Aa[(size_t)tau * 512 + hc]), w = Wd[(size_t)tau * 512 + hc], g = bf2f(Gg[(size_t)tau * 512 + hc]);
    float kkf = k * kkw; float nrm = sqrtf(wsum(kkf * kkf)); float kk = kkf / fmaxf(nrm, 1e-12f);
    float k2 = k * (1.f + (a - 1.f) * kaw);
    float ka = kk * a;
    float bsum = wsum(r * k2 * rkw);
    __builtin_amdgcn_wave_barrier();
    s_kk[lane] = kk; s_w[lane] = w; s_ka[lane] = ka; s_k[lane] = k2; s_r[lane] = r;
    __builtin_amdgcn_wave_barrier();
    float skk = 0.f;
#pragma unroll
    for (int j = 0; j < 16; ++j) { float4 q = *(const float4*)(s_kk + j * 4); skk += S[j * 4] * q.x + S[j * 4 + 1] * q.y + S[j * 4 + 2] * q.z + S[j * 4 + 3] * q.w; }
    skk = -skk;
    float o = 0.f;
#pragma unroll
    for (int j = 0; j < 16; ++j) {
      float4 qw = *(const float4*)(s_w + j * 4), qa = *(const float4*)(s_ka + j * 4), qk = *(const float4*)(s_k + j * 4), qr = *(const float4*)(s_r + j * 4);
      S[j * 4] = S[j * 4] * qw.x + skk * qa.x + v * qk.x; o += S[j * 4] * qr.x;
      S[j * 4 + 1] = S[j * 4 + 1] * qw.y + skk * qa.y + v * qk.y; o += S[j * 4 + 1] * qr.y;
      S[j * 4 + 2] = S[j * 4 + 2] * qw.z + skk * qa.z + v * qk.z; o += S[j * 4 + 2] * qr.z;
      S[j * 4 + 3] = S[j * 4 + 3] * qw.w + skk * qa.w + v * qk.w; o += S[j * 4 + 3] * qr.w;
    }
    float mean = wsum(o) * (1.f / 64.f); float dd = o - mean; float var = wsum(dd * dd) * (1.f / 64.f);
    float y = (dd * rsqrtf(var + 64e-5f) * lg + lb + bsum * v) * g;
    P.regY[(size_t)tau * 1024 + hc] = f2bf(y);
  }
  float* so = P.out + (prompt ? O_WKP : O_WKS) + (((size_t)b * 8 + h) * 64 + lane) * 64;
#pragma unroll
  for (int j = 0; j < 16; ++j) *(float4*)(so + j * 4) = make_float4(S[j * 4], S[j * 4 + 1], S[j * 4 + 2], S[j * 4 + 3]);
}

#define MFMA16(a, b, c) __builtin_amdgcn_mfma_f32_16x16x32_bf16(a, b, c, 0, 0, 0)
__device__ void wkv_chunk_pre(const Params& P, int unit, char* smem) {
  const int tid = threadIdx.x, lane = tid & 63, w = tid >> 6, fr = lane & 15, fq = lane >> 4;
  bfraw* Ah = (bfraw*)smem; bfraw* Bh = Ah + 2304; bfraw* Kh = Bh + 2304; bfraw* Rh = Kh + 2304;
  bfraw* AhT = Rh + 2304;
  bfraw* Vt = AhT + 2560; bfraw* NakT = Vt + 2560; bfraw* MbrT = NakT + 1280; bfraw* MkrT = MbrT + 1280; bfraw* Tt = MkrT + 1280;
  bfraw* VN = Tt + 1280; bfraw* nAt = VN + 2560; bfraw* nD0 = nAt + 2560;
  float* G = (float*)(nD0 + 2560);
  float* gC = G + 2048;
  float* NabT = G;
  const float* Wd = (const float*)P.regA; const bfraw* Aa = P.regB;
  const int b = unit >> 9, h = (unit >> 6) & 7, c = unit & 63;
  const int tok0 = b * 2048 + c * 32;
  __syncthreads();
  {
    const int t = tid >> 3, jg = tid & 7, j0 = jg * 8, hc = h * 64 + j0;
    const int tau = tok0 + t;
    const bool first = (c == 0 && t == 0);
    const bfraw* zr = P.regZ + (size_t)tau * DIN;
    float zr_[8], zk_[8], zv_[8], pr[8], pk[8], pv[8];
    unpack8(*(const uint4*)(zr + hc), zr_); unpack8(*(const uint4*)(zr + 512 + hc), zk_); unpack8(*(const uint4*)(zr + 1024 + hc), zv_);
    if (!first) { unpack8(*(const uint4*)(zr - DIN + hc), pr); unpack8(*(const uint4*)(zr - DIN + 512 + hc), pk); unpack8(*(const uint4*)(zr - DIN + 1024 + hc), pv); }
    else {
#pragma unroll
      for (int i = 0; i < 8; ++i) { pr[i] = 0.f; pk[i] = 0.f; pv[i] = 0.f; }
    }
    float a[8], wd[8], r[8], k[8], v[8], kk[8], k2[8];
    unpack8(*(const uint4*)(Aa + (size_t)tau * 512 + hc), a);
    { float4 x = *(const float4*)(Wd + (size_t)tau * 512 + hc), y = *(const float4*)(Wd + (size_t)tau * 512 + hc + 4);
      wd[0] = x.x; wd[1] = x.y; wd[2] = x.z; wd[3] = x.w; wd[4] = y.x; wd[5] = y.y; wd[6] = y.z; wd[7] = y.w; }
    float ss = 0.f, bs = 0.f;
#pragma unroll
    for (int i = 0; i < 8; ++i) {
      float mr = P.shift_mu[hc + i], mk = P.shift_mu[512 + hc + i], mv = P.shift_mu[1024 + hc + i];
      r[i] = zr_[i] + (pr[i] - zr_[i]) * mr; k[i] = zk_[i] + (pk[i] - zk_[i]) * mk; v[i] = zv_[i] + (pv[i] - zv_[i]) * mv;
      float kkf = k[i] * P.k_k[hc + i]; kk[i] = kkf; ss += kkf * kkf;
      k2[i] = k[i] * (1.f + (a[i] - 1.f) * P.k_a[hc + i]);
      bs += r[i] * k2[i] * P.r_k[hc + i];
    }
    ss += __shfl_xor(ss, 1, 64); ss += __shfl_xor(ss, 2, 64); ss += __shfl_xor(ss, 4, 64);
    bs += __shfl_xor(bs, 1, 64); bs += __shfl_xor(bs, 2, 64); bs += __shfl_xor(bs, 4, 64);
    if (jg == 0) P.bonus[(size_t)tau * 8 + h] = bs;
    float inv = 1.f / fmaxf(sqrtf(ss), 1e-12f);
    *(float4*)(G + t * 64 + j0) = make_float4(wd[0], wd[1], wd[2], wd[3]);
    *(float4*)(G + t * 64 + j0 + 4) = make_float4(wd[4], wd[5], wd[6], wd[7]);
    __syncthreads();
    if (tid < 64) {
      float g = 1.f;
      for (int t2 = 0; t2 < 32; ++t2) { g *= G[t2 * 64 + tid]; G[t2 * 64 + tid] = g; }
      gC[tid] = g;
    }
    __syncthreads();
    float ah[8], bh[8], kh[8], rh[8];
#pragma unroll
    for (int i = 0; i < 8; ++i) {
      float gt = G[t * 64 + j0 + i]; float gp = t > 0 ? G[(t - 1) * 64 + j0 + i] : 1.f; float ig = 1.f / gt;
      float kkn = kk[i] * inv;
      ah[i] = kkn * gp; bh[i] = kkn * a[i] * ig; kh[i] = k2[i] * ig; rh[i] = r[i] * gt;
    }
    uint4 pa = pack8(ah);
    *(uint4*)(Ah + t * 72 + j0) = pa; *(uint4*)(Bh + t * 72 + j0) = pack8(bh); *(uint4*)(Kh + t * 72 + j0) = pack8(kh); *(uint4*)(Rh + t * 72 + j0) = pack8(rh);
    unsigned int paw[4] = {pa.x, pa.y, pa.z, pa.w};
#pragma unroll
    for (int i = 0; i < 8; ++i) {
      AhT[(j0 + i) * 40 + t] = (bfraw)((i & 1) ? (paw[i >> 1] >> 16) : (paw[i >> 1] & 0xffffu));
      Vt[(j0 + i) * 40 + t] = f2bf(v[i]);
    }
  }
  __syncthreads();
  const f32x4 z4 = {0.f, 0.f, 0.f, 0.f};
  {
    const bfraw* Xp = (w & 1) ? Kh : Bh; const bfraw* Yp = (w >> 1) ? Rh : Ah;
    f32x4 acc[2][2] = {{z4, z4}, {z4, z4}};
#pragma unroll
    for (int ks = 0; ks < 2; ++ks) {
      bf16x8 xa[2], yb[2];
#pragma unroll
      for (int mt = 0; mt < 2; ++mt) { xa[mt] = *(const bf16x8*)(Xp + (mt * 16 + fr) * 72 + ks * 32 + fq * 8); yb[mt] = *(const bf16x8*)(Yp + (mt * 16 + fr) * 72 + ks * 32 + fq * 8); }
#pragma unroll
      for (int mt = 0; mt < 2; ++mt)
#pragma unroll
        for (int nt = 0; nt < 2; ++nt) acc[mt][nt] = MFMA16(xa[mt], yb[nt], acc[mt][nt]);
    }
    bfraw* dst = (w == 1) ? NakT : (w == 2 ? MbrT : MkrT);
#pragma unroll
    for (int mt = 0; mt < 2; ++mt)
#pragma unroll
      for (int nt = 0; nt < 2; ++nt)
#pragma unroll
        for (int jj = 0; jj < 4; ++jj) {
          int ta = mt * 16 + fq * 4 + jj, tt = nt * 16 + fr; float val = acc[mt][nt][jj];
          if (w == 0) NabT[tt * 32 + ta] = (ta < tt) ? val : 0.f;
          else { bool keep = (w == 1) ? (ta < tt) : (ta <= tt); dst[tt * 40 + ta] = f2bf(keep ? val : 0.f); }
        }
  }
  __syncthreads();
  const bf16x8 xv = *(const bf16x8*)(Vt + (16 * w + fr) * 40 + fq * 8);
  {
#pragma unroll
    for (int nt = 0; nt < 2; ++nt) {
      bf16x8 yb = *(const bf16x8*)(NakT + (nt * 16 + fr) * 40 + fq * 8);
      f32x4 acc = MFMA16(xv, yb, z4);
#pragma unroll
      for (int jj = 0; jj < 4; ++jj) VN[(16 * w + fq * 4 + jj) * 40 + nt * 16 + fr] = f2bf(acc[jj]);
    }
  }
  if (w == 0 && lane < 32) {
    float Tr[32];
#pragma unroll
    for (int t = 0; t < 32; ++t) {
      float a0 = (lane == t) ? 1.f : 0.f, a1 = 0.f, a2 = 0.f, a3 = 0.f;
#pragma unroll
      for (int q = 0; q < (t + 3) / 4; ++q) {
        float4 nv = *(const float4*)(NabT + t * 32 + q * 4);
        a0 -= Tr[q * 4] * nv.x;
        if (q * 4 + 1 < t) a1 -= Tr[q * 4 + 1] * nv.y;
        if (q * 4 + 2 < t) a2 -= Tr[q * 4 + 2] * nv.z;
        if (q * 4 + 3 < t) a3 -= Tr[q * 4 + 3] * nv.w;
      }
      float acc = (a0 + a1) + (a2 + a3);
      Tr[t] = acc;
      Tt[t * 40 + lane] = f2bf(acc);
    }
  }
  __syncthreads();
  bf16x8 xn, xd;
  {
    bf16x8 xa = *(const bf16x8*)(AhT + (16 * w + fr) * 40 + fq * 8);
    bf16x8 xvn = *(const bf16x8*)(VN + (16 * w + fr) * 40 + fq * 8);
#pragma unroll
    for (int nt = 0; nt < 2; ++nt) {
      bf16x8 yb = *(const bf16x8*)(Tt + (nt * 16 + fr) * 40 + fq * 8);
      f32x4 aA = MFMA16(xa, yb, z4), aD = MFMA16(xvn, yb, z4);
#pragma unroll
      for (int jj = 0; jj < 4; ++jj) {
        nAt[(16 * w + fq * 4 + jj) * 40 + nt * 16 + fr] = f2bf(-aA[jj]);
        nD0[(16 * w + fq * 4 + jj) * 40 + nt * 16 + fr] = f2bf(-aD[jj]);
      }
    }
    __builtin_amdgcn_wave_barrier();
    xn = *(const bf16x8*)(nAt + (16 * w + fr) * 40 + fq * 8);
    xd = *(const bf16x8*)(nD0 + (16 * w + fr) * 40 + fq * 8);
  }
  char* pq = (char*)P.regPQ + (size_t)unit * 12288;
  char* lo = (char*)P.out + (size_t)unit * 12288;
  bfraw* PmT = (bfraw*)pq; bfraw* QT = (bfraw*)(pq + 8192);
  uint2* Lb = (uint2*)lo; uint2* Ob = (uint2*)(lo + 8192);
#pragma unroll
  for (int nt = 0; nt < 2; ++nt) {
    bf16x8 ymb = *(const bf16x8*)(MbrT + (nt * 16 + fr) * 40 + fq * 8), ymk = *(const bf16x8*)(MkrT + (nt * 16 + fr) * 40 + fq * 8);
    f32x4 aQ = MFMA16(xn, ymb, z4);
    f32x4 aO = MFMA16(xv, ymk, z4); aO = MFMA16(xd, ymb, aO);
    int tt = nt * 16 + fr; float q[4];
#pragma unroll
    for (int jj = 0; jj < 4; ++jj) q[jj] = aQ[jj] + bf2f(Rh[tt * 72 + 16 * w + fq * 4 + jj]);
    uint2 o; o.x = pack2(q[0], q[1]); o.y = pack2(q[2], q[3]);
    *(uint2*)(QT + tt * 64 + 16 * w + fq * 4) = o;
    uint2 o2; o2.x = pack2(aO[0], aO[1]); o2.y = pack2(aO[2], aO[3]);
    Ob[(w * 2 + nt) * 64 + lane] = o2;
  }
#pragma unroll
  for (int nt = 0; nt < 4; ++nt) {
    bf16x8 ybB, ybK;
#pragma unroll
    for (int e = 0; e < 8; ++e) { ybB[e] = (short)Bh[(fq * 8 + e) * 72 + nt * 16 + fr]; ybK[e] = (short)Kh[(fq * 8 + e) * 72 + nt * 16 + fr]; }
    f32x4 aP = MFMA16(xn, ybB, z4);
    f32x4 aL = MFMA16(xv, ybK, z4); aL = MFMA16(xd, ybB, aL);
    int jp = nt * 16 + fr; float gc = gC[jp]; float pm[4], l[4];
#pragma unroll
    for (int jj = 0; jj < 4; ++jj) { int j = 16 * w + fq * 4 + jj; pm[jj] = gc * ((j == jp ? 1.f : 0.f) + aP[jj]); l[jj] = gc * aL[jj]; }
    uint2 o; o.x = pack2(pm[0], pm[1]); o.y = pack2(pm[2], pm[3]);
    *(uint2*)(PmT + jp * 64 + 16 * w + fq * 4) = o;
    uint2 o2; o2.x = pack2(l[0], l[1]); o2.y = pack2(l[2], l[3]);
    Lb[(w * 4 + nt) * 64 + lane] = o2;
  }
}

__device__ __forceinline__ f32x4 unpack4(uint2 u) {
  f32x4 r; r[0] = __uint_as_float(u.x << 16); r[1] = __uint_as_float(u.x & 0xffff0000u); r[2] = __uint_as_float(u.y << 16); r[3] = __uint_as_float(u.y & 0xffff0000u); return r;
}
struct SeqOps { bf16x8 pm[4][2]; bf16x8 qt[2][2]; uint2 l[4]; uint2 o0[2]; };
__device__ __forceinline__ void seq_load(const Params& P, int bh, int c, int w, int lane, SeqOps& o) {
  const int fr = lane & 15, fq = lane >> 4;
  const int unit = bh * 64 + (c < 63 ? c : 63);
  const char* pq = (const char*)P.regPQ + (size_t)unit * 12288; const char* lo = (const char*)P.out + (size_t)unit * 12288;
  const bfraw* PmT = (const bfraw*)pq; const bfraw* QT = (const bfraw*)(pq + 8192);
  const uint2* Lb = (const uint2*)lo; const uint2* Ob = (const uint2*)(lo + 8192);
#pragma unroll
  for (int nt = 0; nt < 4; ++nt)
#pragma unroll
    for (int ks = 0; ks < 2; ++ks) o.pm[nt][ks] = *(const bf16x8*)(PmT + (nt * 16 + fr) * 64 + ks * 32 + fq * 8);
#pragma unroll
  for (int nt = 0; nt < 2; ++nt)
#pragma unroll
    for (int ks = 0; ks < 2; ++ks) o.qt[nt][ks] = *(const bf16x8*)(QT + (nt * 16 + fr) * 64 + ks * 32 + fq * 8);
#pragma unroll
  for (int nt = 0; nt < 4; ++nt) o.l[nt] = Lb[(w * 4 + nt) * 64 + lane];
#pragma unroll
  for (int nt = 0; nt < 2; ++nt) o.o0[nt] = Ob[(w * 2 + nt) * 64 + lane];
}
__device__ __forceinline__ void seq_step(const Params& P, int b, int h, int c, int w, int lane, float* strip, f32x4 (&S)[4], const SeqOps& o) {
  const int fr = lane & 15, fq = lane >> 4;
  bfraw* Oraw = (bfraw*)((char*)P.out + 50331648);
  __builtin_amdgcn_wave_barrier();
#pragma unroll
  for (int nt = 0; nt < 4; ++nt)
#pragma unroll
    for (int jj = 0; jj < 4; ++jj) strip[(fq * 4 + jj) * 68 + nt * 16 + fr] = S[nt][jj];
  __builtin_amdgcn_wave_barrier();
  bf16x8 xh[2], xl[2];
#pragma unroll
  for (int ks = 0; ks < 2; ++ks) {
    float4 p0 = *(const float4*)(strip + fr * 68 + ks * 32 + fq * 8), p1 = *(const float4*)(strip + fr * 68 + ks * 32 + fq * 8 + 4);
    float xs[8] = {p0.x, p0.y, p0.z, p0.w, p1.x, p1.y, p1.z, p1.w};
    unsigned int hp[4], lp[4];
#pragma unroll
    for (int e = 0; e < 4; ++e) {
      hp[e] = pack2(xs[2 * e], xs[2 * e + 1]);
      lp[e] = pack2(xs[2 * e] - __uint_as_float(hp[e] << 16), xs[2 * e + 1] - __uint_as_float(hp[e] & 0xffff0000u));
    }
    xh[ks] = __builtin_bit_cast(bf16x8, make_uint4(hp[0], hp[1], hp[2], hp[3]));
    xl[ks] = __builtin_bit_cast(bf16x8, make_uint4(lp[0], lp[1], lp[2], lp[3]));
  }
  f32x4 aO[2];
#pragma unroll
  for (int nt = 0; nt < 2; ++nt) {
    aO[nt] = unpack4(o.o0[nt]);
#pragma unroll
    for (int ks = 0; ks < 2; ++ks) { aO[nt] = MFMA16(xh[ks], o.qt[nt][ks], aO[nt]); aO[nt] = MFMA16(xl[ks], o.qt[nt][ks], aO[nt]); }
  }
#pragma unroll
  for (int nt = 0; nt < 4; ++nt) {
    f32x4 aS = unpack4(o.l[nt]);
#pragma unroll
    for (int ks = 0; ks < 2; ++ks) { aS = MFMA16(xh[ks], o.pm[nt][ks], aS); aS = MFMA16(xl[ks], o.pm[nt][ks], aS); }
    S[nt] = aS;
  }
  const int tok0 = b * 2048 + c * 32;
#pragma unroll
  for (int nt = 0; nt < 2; ++nt) {
    uint2 ov; ov.x = pack2(aO[nt][0], aO[nt][1]); ov.y = pack2(aO[nt][2], aO[nt][3]);
    *(uint2*)(Oraw + (size_t)(tok0 + nt * 16 + fr) * 512 + h * 64 + 16 * w + fq * 4) = ov;
  }
}
__device__ void wkv_seq(const Params& P, int bh, char* smem) {
  const int tid = threadIdx.x, lane = tid & 63, w = tid >> 6, fr = lane & 15, fq = lane >> 4;
  float* strip = (float*)smem + w * 16 * 68;
  const int b = bh >> 3, h = bh & 7;
  f32x4 S[4];
#pragma unroll
  for (int nt = 0; nt < 4; ++nt) S[nt] = f32x4{0.f, 0.f, 0.f, 0.f};
  SeqOps o0, o1, o2;
  seq_load(P, bh, 0, w, lane, o0);
  seq_load(P, bh, 1, w, lane, o1);
#pragma unroll 1
  for (int c = 0; c < 66; c += 3) {
    seq_load(P, bh, c + 2, w, lane, o2);
    seq_step(P, b, h, c, w, lane, strip, S, o0);
    seq_load(P, bh, c + 3, w, lane, o0);
    if (c + 1 < 64) seq_step(P, b, h, c + 1, w, lane, strip, S, o1);
    seq_load(P, bh, c + 4, w, lane, o1);
    if (c + 2 < 64) seq_step(P, b, h, c + 2, w, lane, strip, S, o2);
  }
  float* so = P.out + O_WKP + ((size_t)bh * 64) * 64;
#pragma unroll
  for (int nt = 0; nt < 4; ++nt)
#pragma unroll
    for (int jj = 0; jj < 4; ++jj) so[(16 * w + fq * 4 + jj) * 64 + nt * 16 + fr] = S[nt][jj];
}

__device__ __forceinline__ int next_job(unsigned* ctr, float* sred) {
  __syncthreads();
  if (threadIdx.x == 0) ((int*)sred)[200] = (int)atomicAdd(ctr, 1u);
  __syncthreads();
  return ((int*)sred)[200];
}

__device__ void phase3a(const Params& P, char* smem) {
  for (int unit = blockIdx.x; unit < 4096; unit += gridDim.x) wkv_chunk_pre(P, unit, smem);
}

__device__ void phase3b(const Params& P, char* smem, float* sred) {
  int wid = threadIdx.x >> 6;
  bfraw* sA = (bfraw*)smem; bfraw* sB = sA + 128 * LROW;
  if (blockIdx.x < 64) { wkv_seq(P, blockIdx.x, smem); return; }
  const int nb = gridDim.x - 64;
  for (int job = blockIdx.x - 64; job < 256; job += nb) wkv_direct(P, 64 + job * 4 + wid, (float*)smem + wid * 320);
  __syncthreads();
  for (int job = (blockIdx.x - 64 + nb - (256 % nb)) % nb; job < 528; job += nb) {
    int rt = job >> 2, gi = job & 3; int row0 = rt * 128;
    f32x4 acc[4][4]; ZERO_ACC(acc)
    float* sS = (float*)smem;
    gemm_main(acc, PlainLoad{P.regP + (size_t)row0 * 512 + gi * 128, 512}, PlainLoad{P.Wt_pool + (size_t)gi * 16384, 128}, 128, sA, sB);
    acc_to_lds(acc, sS);
#pragma unroll 4
    for (int i = 0; i < 16; ++i) { SEG_VARS(i) int c = gi * 128 + c4;
      float4 ps = *(const float4*)(P.pool_scale + c);
      uint2 o; o.x = pack2(v.x * ps.x, v.y * ps.y); o.y = pack2(v.z * ps.z, v.w * ps.w);
      *(uint2*)(P.regY + (size_t)(row0 + row) * 1024 + 512 + c) = o; }
  }
  __syncthreads();
  for (int job = (blockIdx.x - 64 + 2 * nb - ((256 + 528) % nb)) % nb; job < N_LATE_PREP; job += nb) { __syncthreads(); late_prep_job(P, job < 512 ? 576 + job : job - 512, smem); }
}

__device__ void phase3c(const Params& P) {
  const int lane = threadIdx.x & 63, wid = threadIdx.x >> 6;
  const bfraw* Oraw = (const bfraw*)((const char*)P.out + 50331648);
  const bfraw* Gg = P.regB + (size_t)NT * 512;
  const int c0 = lane * 8, hd = lane >> 3;
  float mu[8], lg[8], lb[8];
  { float4 a = *(const float4*)(P.shift_mu + 1024 + c0), c = *(const float4*)(P.shift_mu + 1024 + c0 + 4);
    mu[0] = a.x; mu[1] = a.y; mu[2] = a.z; mu[3] = a.w; mu[4] = c.x; mu[5] = c.y; mu[6] = c.z; mu[7] = c.w;
    a = *(const float4*)(P.lnx_g + c0); c = *(const float4*)(P.lnx_g + c0 + 4);
    lg[0] = a.x; lg[1] = a.y; lg[2] = a.z; lg[3] = a.w; lg[4] = c.x; lg[5] = c.y; lg[6] = c.z; lg[7] = c.w;
    a = *(const float4*)(P.lnx_b + c0); c = *(const float4*)(P.lnx_b + c0 + 4);
    lb[0] = a.x; lb[1] = a.y; lb[2] = a.z; lb[3] = a.w; lb[4] = c.x; lb[5] = c.y; lb[6] = c.z; lb[7] = c.w; }
#pragma unroll 2
  for (int tau = blockIdx.x * 4 + wid; tau < NPR; tau += gridDim.x * 4) {
    const bool first = (tau & 2047) == 0;
    float o[8], zv[8], pv[8], g[8];
    unpack8(*(const uint4*)(Oraw + (size_t)tau * 512 + c0), o);
    unpack8(*(const uint4*)(P.regZ + (size_t)tau * DIN + 1024 + c0), zv);
    unpack8(*(const uint4*)(P.regZ + (size_t)(first ? tau : tau - 1) * DIN + 1024 + c0), pv);
    unpack8(*(const uint4*)(Gg + (size_t)tau * 512 + c0), g);
    const float bon = P.bonus[(size_t)tau * 8 + hd];
    float sm = 0.f;
#pragma unroll
    for (int i = 0; i < 8; ++i) sm += o[i];
    sm += __shfl_xor(sm, 1, 64); sm += __shfl_xor(sm, 2, 64); sm += __shfl_xor(sm, 4, 64);
    const float mean = sm * (1.f / 64.f);
    float sq = 0.f;
#pragma unroll
    for (int i = 0; i < 8; ++i) { o[i] -= mean; sq += o[i] * o[i]; }
    sq += __shfl_xor(sq, 1, 64); sq += __shfl_xor(sq, 2, 64); sq += __shfl_xor(sq, 4, 64);
    const float rs = rsqrtf(sq * (1.f / 64.f) + 64e-5f);
    float y[8];
#pragma unroll
    for (int i = 0; i < 8; ++i) {
      float p = first ? 0.f : pv[i];
      float v = zv[i] + (p - zv[i]) * mu[i];
      y[i] = (o[i] * rs * lg[i] + lb[i] + bon * v) * g[i];
    }
    *(uint4*)(P.regY + (size_t)tau * 1024 + c0) = pack8(y);
  }
}

__device__ __forceinline__ int filler_rank(int nbusy_lr, int& nfill) {
  const int b = blockIdx.x;
  if (gridDim.x != 512) { nfill = gridDim.x; return b; }
  const int x = b & 7, lr = b >> 3;
  nfill = 512 - 4 * nbusy_lr;
  if (x < 4 && lr < nbusy_lr) return -1;
  const int busy_before = lr < nbusy_lr ? 4 * lr + 4 : 4 * nbusy_lr;
  return b - busy_before;
}

__device__ void phase4(const Params& P, char* smem, float* sred) {
  bfraw* sA = (bfraw*)smem; bfraw* sB = sA + 128 * LROW;
  bfraw* hb = P.regA;
  const int NG = 132 * 8, NCONV = 8192;
  for (int it = 0;; ++it) {
    {
      int rt, ct; if (!xcd_job(it, 8, 8, rt, ct)) break; int row0 = rt * 128, col0 = ct * 128;
      f32x4 acc[4][4]; ZERO_ACC(acc)
      gemm_main(acc, PlainLoad{P.regY + (size_t)row0 * 1024, 1024}, PlainLoad{P.Wt_out + (size_t)col0 * 1024, 1024}, 1024, sA, sB);
      float* sS = (float*)smem;
      acc_to_lds(acc, sS);
#pragma unroll 4
      for (int i = 0; i < 16; ++i) { SEG_VARS(i)
        int tau = row0 + row, c = col0 + c4;
        float4 xv = *(const float4*)(xrow(P, tau) + c);
        float4 h; h.x = xv.x + v.x; h.y = xv.y + v.y; h.z = xv.z + v.z; h.w = xv.w + v.w;
        *(float4*)(P.out + (size_t)tau * 1024 + c) = h;
        uint2 o; o.x = pack2(h.x, h.y); o.y = pack2(h.z, h.w);
        *(uint2*)(hb + (size_t)tau * 1024 + c) = o;
        float ss = h.x * h.x + h.y * h.y + h.z * h.z + h.w * h.w;
        ss += __shfl_xor(ss, 1, 64); ss += __shfl_xor(ss, 2, 64); ss += __shfl_xor(ss, 4, 64); ss += __shfl_xor(ss, 8, 64); ss += __shfl_xor(ss, 16, 64);
        if ((etid_ & 31) == 0) P.ssq1[(size_t)ct * NT + tau] = ss; }
    }
  }
  int nfill4; const int fr4 = filler_rank(8, nfill4);
  for (int job0 = NG + fr4 * 4; fr4 >= 0 && job0 < NG + NCONV; job0 += nfill4 * 4) {
    int job = job0;
    for (int jq = 0; jq < 4; ++jq, ++job) {
      size_t e0 = ((size_t)(job - NG) * 256 + threadIdx.x) * 16;
      const bool isu = e0 < (size_t)16777216;
      const float* src = isu ? P.peer_u + e0 : P.peer_v + (e0 - 16777216);
      const float sc = isu ? 256.f : 32.f;
      unsigned int wv[4];
#pragma unroll
      for (int q = 0; q < 4; ++q) {
        float4 a = *(const float4*)(src + q * 4);
        int wq = __builtin_amdgcn_cvt_pk_fp8_f32(a.x * sc, a.y * sc, 0, false);
        wq = __builtin_amdgcn_cvt_pk_fp8_f32(a.z * sc, a.w * sc, wq, true);
        wv[q] = (unsigned int)wq;
      }
      *(uint4*)((unsigned char*)P.regZ + e0) = make_uint4(wv[0], wv[1], wv[2], wv[3]);
    }
  }
}

struct PLoad {
  const Params* P; int row0;
  __device__ __forceinline__ uint4 operator()(int r, int k) const {
    int tau = row0 + r;
    const float* pr = (tau < NPR ? P->p_prompt + (size_t)tau * 256 : P->p_sample + (size_t)(tau - NPR) * 256) + k;
    float4 a = *(const float4*)pr, c = *(const float4*)(pr + 4);
    uint4 o; o.x = pack2(a.x, a.y); o.y = pack2(a.z, a.w); o.z = pack2(c.x, c.y); o.w = pack2(c.z, c.w); return o;
  }
};
#define TK_INS(x) { _Pragma("unroll") for (int i_ = 15; i_ > 0; --i_) s[i_] = __builtin_amdgcn_fmed3f(s[i_ - 1], s[i_], x); s[0] = fmaxf(s[0], x); }
__device__ void phase5(const Params& P, char* smem, float* sred) {
  bfraw* sA = (bfraw*)smem; bfraw* sB = sA + 128 * LROW;
  const bfraw* hb = P.regA; float* TK = (float*)P.regB;
  float* sS = (float*)smem;
  for (int it = 0;; ++it) {
    int rt, ct; if (!xcd_job(it, 16, 8, rt, ct)) break; int row0 = rt * 128, col0 = ct * 128;
    EPI_VARS
    if (tid < 128) {
      float s = 0.f;
#pragma unroll
      for (int c = 0; c < 8; ++c) s += P.ssq1[(size_t)c * NT + row0 + tid];
      sred[tid] = rsqrtf(s * (1.f / 1024.f) + 1e-6f);
    }
    f32x4 acc[4][4]; ZERO_ACC(acc)
    gemm_main<true>(acc, PlainLoad{hb + (size_t)row0 * 1024, 1024}, PlainLoad{P.Wt_q + (size_t)col0 * 1024, 1024}, 1024, sA, sB);
    EPI_LOOP { EPI_RC
      float v = acc[m][n][j] * sred[row];
      unsigned int bits = (__float_as_uint(v) & ~127u) | (unsigned)col;
      sS[row * 128 + (col ^ (row & 31))] = __uint_as_float(bits); }
    __syncthreads();
    int tk_ = threadIdx.x; asm volatile("" : "+v"(tk_));
    int r = tk_ & 127, q = tk_ >> 7;
    float s[16];
#pragma unroll
    for (int i = 0; i < 16; ++i) s[i] = -3.0e38f;
    for (int i = 0; i < 64; ++i) { float x = sS[r * 128 + ((q * 64 + i) ^ (r & 31))]; TK_INS(x) }
    __syncthreads();
    if (q == 1) {
#pragma unroll
      for (int i = 0; i < 16; ++i) sS[r * 17 + i] = s[i];
    }
    __syncthreads();
    if (q == 0) {
#pragma unroll
      for (int i = 0; i < 16; ++i) { float x = sS[r * 17 + i]; TK_INS(x) }
      float* dst = TK + (size_t)(row0 + r) * 256 + ct * 16;
#pragma unroll
      for (int i = 0; i < 4; ++i) *(float4*)(dst + i * 4) = make_float4(s[i * 4], s[i * 4 + 1], s[i * 4 + 2], s[i * 4 + 3]);
    }
    __syncthreads();
  }
  int nfill5; const int fr5 = filler_rank(16, nfill5);
  for (int job = fr5; fr5 >= 0 && job < 132 * 8; job += nfill5) {
    __syncthreads();
    int rt = job >> 3, ct = job & 7; int row0 = rt * 128, col0 = ct * 128;
    f32x4 acc[4][4]; ZERO_ACC(acc)
    gemm_main(acc, PLoad{&P, row0}, PlainLoad{P.Wt_ple + (size_t)col0 * 256, 256}, 256, sA, sB);
    acc_to_lds(acc, sS);
#pragma unroll 4
    for (int i = 0; i < 16; ++i) { SEG_VARS(i)
      uint2 o; o.x = pack2(v.x, v.y); o.y = pack2(v.z, v.w);
      *(uint2*)(P.regY + (size_t)(row0 + row) * 1024 + col0 + c4) = o; }
  }
}

typedef float f32x2 __attribute__((ext_vector_type(2)));
__device__ __forceinline__ float gelu_exact(float x) { return 0.5f * x * (1.f + erff(x * 0.70710678118f)); }
__device__ __forceinline__ float dot16_fp8(uint4 r, const f32x2 (&xn2)[8]) {
  f32x2 acc = __builtin_amdgcn_cvt_pk_f32_fp8((int)r.x, false) * xn2[0];
  acc += __builtin_amdgcn_cvt_pk_f32_fp8((int)r.x, true) * xn2[1];
  acc += __builtin_amdgcn_cvt_pk_f32_fp8((int)r.y, false) * xn2[2];
  acc += __builtin_amdgcn_cvt_pk_f32_fp8((int)r.y, true) * xn2[3];
  acc += __builtin_amdgcn_cvt_pk_f32_fp8((int)r.z, false) * xn2[4];
  acc += __builtin_amdgcn_cvt_pk_f32_fp8((int)r.z, true) * xn2[5];
  acc += __builtin_amdgcn_cvt_pk_f32_fp8((int)r.w, false) * xn2[6];
  acc += __builtin_amdgcn_cvt_pk_f32_fp8((int)r.w, true) * xn2[7];
  return acc.x + acc.y;
}
__device__ __forceinline__ void axpy16_fp8(uint4 r, float a, f32x2 (&o2)[8]) {
  f32x2 a2 = {a, a};
  o2[0] += a2 * __builtin_amdgcn_cvt_pk_f32_fp8((int)r.x, false);
  o2[1] += a2 * __builtin_amdgcn_cvt_pk_f32_fp8((int)r.x, true);
  o2[2] += a2 * __builtin_amdgcn_cvt_pk_f32_fp8((int)r.y, false);
  o2[3] += a2 * __builtin_amdgcn_cvt_pk_f32_fp8((int)r.y, true);
  o2[4] += a2 * __builtin_amdgcn_cvt_pk_f32_fp8((int)r.z, false);
  o2[5] += a2 * __builtin_amdgcn_cvt_pk_f32_fp8((int)r.z, true);
  o2[6] += a2 * __builtin_amdgcn_cvt_pk_f32_fp8((int)r.w, false);
  o2[7] += a2 * __builtin_amdgcn_cvt_pk_f32_fp8((int)r.w, true);
}
__device__ __forceinline__ float reduce8(const float (&p)[8], int lane) {
  float q[4], r[2], s;
  const bool b0 = lane & 1, b1 = lane & 2, b2 = lane & 4;
#pragma unroll
  for (int k = 0; k < 4; ++k) { float send = b0 ? p[k] : p[k + 4]; float keep = b0 ? p[k + 4] : p[k]; q[k] = keep + __shfl_xor(send, 1, 64); }
#pragma unroll
  for (int k = 0; k < 2; ++k) { float send = b1 ? q[k] : q[k + 2]; float keep = b1 ? q[k + 2] : q[k]; r[k] = keep + __shfl_xor(send, 2, 64); }
  { float send = b2 ? r[0] : r[1]; float keep = b2 ? r[1] : r[0]; s = keep + __shfl_xor(send, 4, 64); }
  s += __shfl_xor(s, 8, 64); s += __shfl_xor(s, 16, 64); s += __shfl_xor(s, 32, 64);
  return s;
}
#define PEER_LOAD(buf, tab, bt) _Pragma("unroll") for (int k_ = 0; k_ < 8; ++k_) { int e_ = __builtin_amdgcn_readfirstlane(sexp[(bt) * 8 + k_]); buf[k_] = *(const uint4*)(tab + (size_t)e_ * 1024 + lane * 16); }
#define PEER_UCOMP(buf, bt) { float p_[8]; _Pragma("unroll") for (int k_ = 0; k_ < 8; ++k_) p_[k_] = dot16_fp8(buf[k_], xn2); float s_ = reduce8(p_, lane); \
    if ((lane >> 3) == ((bt) & 7)) { if ((bt) < 8) d0 = s_; else d1 = s_; } }
#define PEER_VCOMP(buf, bt) { float asel_ = (bt) < 8 ? act0 : act1; _Pragma("unroll") for (int k_ = 0; k_ < 8; ++k_) { \
    const int br_ = ((k_ & 1) << 2) | (k_ & 2) | ((k_ >> 2) & 1); \
    float a_ = __uint_as_float((unsigned)__builtin_amdgcn_readlane((int)__float_as_uint(asel_), (((bt) & 7) << 3) | br_)); axpy16_fp8(buf[k_], a_, o2); } }

__device__ void peer_token(const Params& P, int tau, float* sw, bool dry = false) {
  const int lane = threadIdx.x & 63;
  float* scand = sw; int* sexp = (int*)(sw + 64); float* sgate = sw + 192;
  const unsigned char* U8 = (const unsigned char*)P.regZ; const unsigned char* V8 = U8 + (size_t)16777216;
  float* hrow = P.out + (size_t)tau * 1024;
  float x[16]; f32x2 xn2[8];
#pragma unroll
  for (int j = 0; j < 4; ++j) { float4 a = *(const float4*)(hrow + lane * 16 + j * 4); x[j * 4] = a.x; x[j * 4 + 1] = a.y; x[j * 4 + 2] = a.z; x[j * 4 + 3] = a.w; }
  float ss = 0.f;
#pragma unroll
  for (int i = 0; i < 16; ++i) ss += x[i] * x[i];
  ss = wsum(ss);
  const float rstd = rsqrtf(ss * (1.f / 1024.f) + 1e-6f) * (1.f / 256.f);
#pragma unroll
  for (int j = 0; j < 4; ++j) {
    float4 g = *(const float4*)(P.norm_ffn_g + lane * 16 + j * 4);
    xn2[j * 2] = f32x2{x[j * 4] * rstd * g.x, x[j * 4 + 1] * rstd * g.y};
    xn2[j * 2 + 1] = f32x2{x[j * 4 + 2] * rstd * g.z, x[j * 4 + 3] * rstd * g.w};
  }
  int ca, cb; { int c = lane;
    if (c < 16) { ca = 0; cb = c; } else if (c < 24) { ca = 1; cb = c - 16; } else if (c < 29) { ca = 2; cb = c - 24; }
    else if (c < 33) { ca = 3; cb = c - 29; } else if (c < 36) { ca = 4; cb = c - 33; } else if (c < 38) { ca = 5; cb = c - 36; }
    else if (c < 40) { ca = 6; cb = c - 38; } else if (c < 42) { ca = 7; cb = c - 40; } else if (c < 50) { ca = c - 34; cb = 0; } else { ca = 0; cb = 0; } }
  const float* tk = (const float*)P.regB + (size_t)tau * 256;
  for (int hh = 0; hh < 8; ++hh) {
    float k1 = tk[(hh * 2) * 16 + ca], k2 = tk[(hh * 2 + 1) * 16 + cb];
    float s = lane < 50 ? k1 + k2 : -3.0e38f;
    __builtin_amdgcn_wave_barrier();
    scand[lane] = s;
    __builtin_amdgcn_wave_barrier();
    int rank = 0;
#pragma unroll
    for (int c4 = 0; c4 < 13; ++c4) {
      float4 q = *(const float4*)(scand + c4 * 4);
      rank += (q.x > s || (q.x == s && c4 * 4 < lane)) ? 1 : 0;
      rank += (q.y > s || (q.y == s && c4 * 4 + 1 < lane)) ? 1 : 0;
      if (c4 < 12) { rank += (q.z > s || (q.z == s && c4 * 4 + 2 < lane)) ? 1 : 0; rank += (q.w > s || (q.w == s && c4 * 4 + 3 < lane)) ? 1 : 0; }
    }
    bool sel = lane < 50 && rank < 16;
    float mx = wmaxf(s);
    float e = sel ? __expf(s - mx) : 0.f;
    float Z = wsum(e);
    if (sel) { sexp[hh * 16 + rank] = (int)((__float_as_uint(k1) & 127u) * 128u + (__float_as_uint(k2) & 127u)); sgate[hh * 16 + rank] = e / Z; }
  }
  __builtin_amdgcn_wave_barrier();
  float d0 = 0.f, d1 = 0.f;
  uint4 A[8], B[8];
  PEER_LOAD(A, U8, 0)
  for (int b2 = 0; b2 < 8; ++b2) {
    PEER_LOAD(B, U8, 2 * b2 + 1)
    PEER_UCOMP(A, 2 * b2)
    if (b2 < 7) { PEER_LOAD(A, U8, 2 * b2 + 2) } else { PEER_LOAD(A, V8, 0) }
    PEER_UCOMP(B, 2 * b2 + 1)
  }
  const int slotA = (lane & ~7) | ((lane & 1) << 2) | (lane & 2) | ((lane >> 2) & 1);
  const float act0 = gelu_exact(d0) * sgate[slotA] * (1.f / 32.f), act1 = gelu_exact(d1) * sgate[64 + slotA] * (1.f / 32.f);
  f32x2 o2[8];
#pragma unroll
  for (int i = 0; i < 8; ++i) o2[i] = f32x2{0.f, 0.f};
  for (int b2 = 0; b2 < 8; ++b2) {
    PEER_LOAD(B, V8, 2 * b2 + 1)
    PEER_VCOMP(A, 2 * b2)
    if (b2 < 7) { PEER_LOAD(A, V8, 2 * b2 + 2) }
    PEER_VCOMP(B, 2 * b2 + 1)
  }
  float o[16]; float s2 = 0.f;
#pragma unroll
  for (int i = 0; i < 8; ++i) { o[2 * i] = x[2 * i] + o2[i].x; o[2 * i + 1] = x[2 * i + 1] + o2[i].y; }
#pragma unroll
  for (int i = 0; i < 16; ++i) s2 += o[i] * o[i];
  s2 = wsum(s2);
  if (dry) { if (s2 == 123.456f) P.rstd2[tau] = s2; return; }
  if (lane == 0) P.rstd2[tau] = rsqrtf(s2 * (1.f / 1024.f) + 1e-6f);
  bfraw* hb = P.regA + (size_t)tau * 1024;
#pragma unroll
  for (int j = 0; j < 4; ++j) *(float4*)(hrow + lane * 16 + j * 4) = make_float4(o[j * 4], o[j * 4 + 1], o[j * 4 + 2], o[j * 4 + 3]);
  *(uint4*)(hb + lane * 16) = pack8(o); *(uint4*)(hb + lane * 16 + 8) = pack8(o + 8);
}

__device__ void phase6(const Params& P, char* smem, bool dry = false) {
  const int wid = threadIdx.x >> 6;
  float* sw = (float*)smem + wid * 320;
  for (int tau = blockIdx.x * 4 + wid; tau < NT; tau += gridDim.x * 4) peer_token(P, tau, sw, dry);
}

__device__ void phase7(const Params& P, char* smem, float* sred) {
  bfraw* sA = (bfraw*)smem; bfraw* sB = sA + 128 * LROW;
  const bfraw* hb = P.regA;
  for (int it = 0;; ++it) {
    int rt, ct; if (!xcd_job(it, 8, 8, rt, ct)) break; int row0 = rt * 128, col0 = ct * 128;
    f32x4 acc[4][4]; ZERO_ACC(acc)
    float* sS = (float*)smem;
    gemm_main(acc, PlainLoad{hb + (size_t)row0 * 1024, 1024}, PlainLoad{P.Wt_pg + (size_t)col0 * 1024, 1024}, 1024, sA, sB);
    acc_to_lds(acc, sS);
#pragma unroll 2
    for (int i = 0; i < 16; ++i) { SEG_VARS(i)
      int tau = row0 + row, c = col0 + c4;
      float rs = P.rstd2[tau];
      float4 hv = *(float4*)(P.out + (size_t)tau * 1024 + c);
      uint2 ep = *(const uint2*)(P.regY + (size_t)tau * 1024 + c);
      hv.x += __uint_as_float(ep.x << 16) * sigmoidf_(v.x * rs);
      hv.y += __uint_as_float(ep.x & 0xffff0000u) * sigmoidf_(v.y * rs);
      hv.z += __uint_as_float(ep.y << 16) * sigmoidf_(v.z * rs);
      hv.w += __uint_as_float(ep.y & 0xffff0000u) * sigmoidf_(v.w * rs);
      *(float4*)(P.out + (size_t)tau * 1024 + c) = hv;
      float ss = hv.x * hv.x + hv.y * hv.y + hv.z * hv.z + hv.w * hv.w;
      ss += __shfl_xor(ss, 1, 64); ss += __shfl_xor(ss, 2, 64); ss += __shfl_xor(ss, 4, 64); ss += __shfl_xor(ss, 8, 64); ss += __shfl_xor(ss, 16, 64);
      if ((etid_ & 31) == 0) P.ssq3[(size_t)ct * NT + tau] = ss; }
  }
}

__device__ void phase8(const Params& P) {
  for (int job = blockIdx.x; job < NT; job += gridDim.x) {
    int tau = job; int c = threadIdx.x * 4;
    float s = 0.f;
#pragma unroll
    for (int i = 0; i < 8; ++i) s += P.ssq3[(size_t)i * NT + tau];
    float rs = rsqrtf(s * (1.f / 1024.f) + 1e-6f);
    float4 v = *(float4*)(P.out + (size_t)tau * 1024 + c); float4 g = *(const float4*)(P.final_norm_g + c);
    v.x *= rs * g.x; v.y *= rs * g.y; v.z *= rs * g.z; v.w *= rs * g.w;
    *(float4*)(P.out + (size_t)tau * 1024 + c) = v;
  }
}


#define XB_TMO      128
#define XB_XCNT(j)  (256  + 64 * (j))
#define XB_XSUB(j)  (1280 + 64 * (j))
#define XB_XGEN(j)  (2304 + 64 * (j))
#define XB_TOP      3328
#define XB_TOPGEN   3392
#define XCD_BAR_WORDS 3456
#define XB_SPIN_CAP (1u << 18)
#define LAS __attribute__((address_space(3)))
__device__ __forceinline__ unsigned xb_ld(unsigned* p)              { return __hip_atomic_load(p, __ATOMIC_RELAXED, __HIP_MEMORY_SCOPE_AGENT); }
__device__ __forceinline__ unsigned xb_add(unsigned* p, unsigned v) { return __hip_atomic_fetch_add(p, v, __ATOMIC_RELAXED, __HIP_MEMORY_SCOPE_AGENT); }
__device__ __forceinline__ unsigned xb_xcc_id() { return (unsigned)__builtin_amdgcn_s_getreg((3 << 11) | 20) & 0xFu; }
#define XB_SPIN(cond, bar) do { unsigned _sp = 0; while (cond) { __builtin_amdgcn_s_sleep(1); \
    if ((++_sp & 255u) == 0u) { if (xb_ld(&(bar)[XB_TMO])) break; if (_sp > XB_SPIN_CAP) { atomicAdd(&(bar)[XB_TMO], 1u); break; } } } } while (0)
struct XcdBarrier { unsigned* bar; unsigned x; volatile LAS unsigned* st; };
__device__ __forceinline__ XcdBarrier xcd_barrier_post(unsigned* bar, volatile LAS unsigned* st) {
    XcdBarrier b; b.bar = bar; b.x = xb_xcc_id(); b.st = st;
    if (threadIdx.x == 0) (void)xb_add(&bar[XB_XCNT(b.x)], 1u);
    return b;
}
__device__ __forceinline__ void xcd_barrier_complete(unsigned* bar, unsigned x, unsigned& nloc, unsigned& nx) {
    const unsigned G = gridDim.x * gridDim.y * gridDim.z;
    unsigned sum, cnt, mine, sp = 0u;
    for (;;) {
        sum = 0u; cnt = 0u; mine = 0u;
#pragma unroll
        for (unsigned j = 0; j < 16; ++j) { const unsigned c = xb_ld(&bar[XB_XCNT(j)]); sum += c; cnt += (c > 0u) ? 1u : 0u; mine = (j == x) ? c : mine; }
        if (sum == G) break;
        __builtin_amdgcn_s_sleep(1);
        if ((++sp & 255u) == 0u) { if (xb_ld(&bar[XB_TMO])) break; if (sp > XB_SPIN_CAP) { atomicAdd(&bar[XB_TMO], 1u); break; } }
    }
    nloc = mine > 0u ? mine : 1u; nx = cnt > 0u ? cnt : 1u;
}
__device__ __forceinline__ void xcd_barrier(const XcdBarrier& b) {
    asm volatile("s_waitcnt vmcnt(0)" ::: "memory");
    __syncthreads();
    if (threadIdx.x == 0) {
        unsigned* bar = b.bar;
        __builtin_amdgcn_s_waitcnt(0);
        unsigned nloc = b.st[0], nx = b.st[1];
        if (nloc == 0u) { xcd_barrier_complete(bar, b.x, nloc, nx); b.st[0] = nloc; b.st[1] = nx; }
        const unsigned old = xb_add(&bar[XB_XSUB(b.x)], 1u);
        const unsigned gen = old / nloc;
        if (old + 1u == (gen + 1u) * nloc) {
            __builtin_amdgcn_fence(__ATOMIC_RELEASE, "agent");
            asm volatile("s_waitcnt vmcnt(0)" ::: "memory");
            const unsigned og = xb_add(&bar[XB_TOP], 1u);
            const unsigned tg = og / nx;
            if (og + 1u == (tg + 1u) * nx) xb_add(&bar[XB_TOPGEN], 1u);
            else XB_SPIN(xb_ld(&bar[XB_TOPGEN]) == tg, bar);
            __builtin_amdgcn_fence(__ATOMIC_ACQUIRE, "agent");
            xb_add(&bar[XB_XGEN(b.x)], 1u);
            asm volatile("s_waitcnt vmcnt(0)" ::: "memory");
        } else {
            XB_SPIN(xb_ld(&bar[XB_XGEN(b.x)]) == gen, bar);
            __builtin_amdgcn_fence(__ATOMIC_ACQUIRE, "agent");
            asm volatile("s_waitcnt vmcnt(0)" ::: "memory");
        }
    }
    __syncthreads();
}

__global__ void __launch_bounds__(256, 2) mega(Params P) {
  __shared__ __attribute__((aligned(16))) char smem[65536];
  __shared__ float sred[256];
  cg::grid_group grid = cg::this_grid();
  __shared__ uint4 xb_words;
  if (threadIdx.x == 0) xb_words = make_uint4(0u, 0u, 0u, 0u);
  __syncthreads();
  XcdBarrier xb = xcd_barrier_post(P.bar, (volatile LAS unsigned*)&xb_words);
  if (P.phase_hi > 1000) grid.sync();
#ifndef REPMASK
#define REPMASK 0
#endif
#define RUNPH(n, call) if (P.phase_lo <= n && n < P.phase_hi) { call; if ((REPMASK >> n) & 1) { call; } if (n + 1 < P.phase_hi) xcd_barrier(xb); }
  RUNPH(0, phase0(P, smem))
  RUNPH(1, phase1(P, smem))
  RUNPH(2, phase2(P, smem))
  RUNPH(3, phase3a(P, smem))
  RUNPH(4, phase3b(P, smem, sred))
  RUNPH(5, phase3c(P))
  RUNPH(6, phase4(P, smem, sred))
  RUNPH(7, phase5(P, smem, sred))
#ifdef DRYPEER
  phase6(P, smem, P.phase_hi < 100);
#endif
  RUNPH(8, phase6(P, smem))
  RUNPH(9, phase7(P, smem, sred))
  RUNPH(10, phase8(P))
}

extern "C" void kernel_launch(void* const* d_in, const int* in_sizes, int n_in, void* d_out, int out_size, void* d_ws, size_t ws_size,
                              hipStream_t stream) {
  static int grid_blocks = 0;
  if (!grid_blocks) {
    int dev = 0, cus = 0, per_cu = 0;
    hipGetDevice(&dev);
    hipDeviceGetAttribute(&cus, hipDeviceAttributeMultiprocessorCount, dev);
    hipOccupancyMaxActiveBlocksPerMultiprocessor(&per_cu, mega, 256, 0);
    if (per_cu > 2) per_cu = 2;
    grid_blocks = cus * per_cu;
  }
  Params P{};
  const float** pf = (const float**)&P;
  for (int i = 0; i < 32; ++i) pf[i] = (const float*)d_in[i];
  P.out = (float*)d_out;
  char* w = (char*)d_ws; size_t off = 0;
  auto take = [&](size_t bytes) { char* p = w + off; off += (bytes + 255) & ~(size_t)255; return p; };
  P.Wt_in = (bfraw*)take((size_t)2304 * LDP * 2);
  P.Wt_out = (bfraw*)take((size_t)1024 * 1024 * 2);
  P.Wt_q = (bfraw*)take((size_t)2048 * 1024 * 2);
  P.Wt_pg = (bfraw*)take((size_t)1024 * 1024 * 2);
  P.Wt_ple = (bfraw*)take((size_t)1024 * 256 * 2);
  P.Wt_dec = (bfraw*)take((size_t)512 * 64 * 2);
  P.Wt_a = (bfraw*)take((size_t)512 * 64 * 2);
  P.Wt_g = (bfraw*)take((size_t)512 * 128 * 2);
  P.Wt_pool = (bfraw*)take((size_t)4 * 128 * 128 * 2);
  P.ssq1 = (float*)take((size_t)8 * NT * 4);
  P.rstd2 = (float*)take((size_t)NT * 4);
  P.ssq3 = (float*)take((size_t)8 * NT * 4);
  P.regA = (bfraw*)take((size_t)NT * LDP * 2);
  P.regB = (bfraw*)take((size_t)NT * 1024 * 2);
  P.regY = (bfraw*)take((size_t)NT * 1024 * 2);
  P.bar = (unsigned*)take((size_t)4096 * 4);
  P.bonus = (float*)take((size_t)NPR * 8 * 4);
  P.regPQ = (bfraw*)take((size_t)4096 * 12288);
  P.regP = (bfraw*)take((size_t)NT * 512 * 2);
  P.regZ = (bfraw*)take((size_t)NT * 2304 * 2);
  P.phase_lo = 0; P.phase_hi = 11;
  hipMemsetAsync(P.bar, 0, 4096 * 4, stream);
  void* args[] = {&P};
  hipError_t e = hipLaunchCooperativeKernel((void*)mega, dim3(grid_blocks), dim3(256), args, 0, stream);
  if (e != hipSuccess) fprintf(stderr, "cooperative launch failed: %s (grid %d)\n", hipGetErrorString(e), grid_blocks);
}
```

```cpp
#include <hip/hip_runtime.h>
#include <hip/hip_bf16.h>
#include <hip/hip_cooperative_groups.h>
#include <stdint.h>
#include <cstdio>
namespace cg = cooperative_groups;

typedef __attribute__((ext_vector_type(8))) short bf16x8;
typedef __attribute__((ext_vector_type(4))) float f32x4;
typedef unsigned short bfraw;

#define NT 16896
#define NPR 16384
#define DM 1024
#define DIN 2304
#define DSH 1792
#define LDP 1088

struct Params {
  const float *x_prompt, *x_sample, *state_shift, *state_wkv, *state_pool, *p_prompt, *p_sample;
  const float *norm_mix_g, *w_in, *shift_mu, *decay_w0, *decay_b, *a_0, *a_b, *g_b, *k_k, *k_a, *r_k;
  const float *lnx_g, *lnx_b, *pool_w, *pool_scale, *w_out, *norm_ffn_g, *peer_wq, *peer_keys;
  const float *peer_u, *peer_v, *norm_ple_g, *ple_w, *ple_gate_w, *final_norm_g;
  float* out;
  bfraw *Wt_in, *Wt_out, *Wt_q, *Wt_pg, *Wt_ple, *Wt_dec, *Wt_a, *Wt_g, *Wt_pool;
  float *ssq1, *rstd2, *ssq3, *bonus, *Sbuf;
  unsigned* bar;
  bfraw *regPQ;
  bfraw *regA;
  bfraw *regB;
  bfraw *regY;
  bfraw *regP;
  bfraw *regZ;
  int phase_lo, phase_hi;
};

#define O_Y 0
#define O_SHP 17301504
#define O_WKP 17315840
#define O_POP 17577984
#define O_SHS 17639424
#define O_WKS 17868800
#define O_POS 22063104

typedef float f32x2_ __attribute__((ext_vector_type(2)));
typedef __bf16 bf16x2_t __attribute__((ext_vector_type(2)));
__device__ __forceinline__ unsigned int pack2(float a, float b) {
  f32x2_ v = {a, b};
  bf16x2_t r = __builtin_convertvector(v, bf16x2_t);
  return __builtin_bit_cast(unsigned int, r);
}
__device__ __forceinline__ unsigned short f2bf(float f) { return (unsigned short)(pack2(f, 0.f) & 0xffffu); }
__device__ __forceinline__ float bf2f(unsigned short h) { return __uint_as_float(((unsigned int)h) << 16); }
__device__ __forceinline__ void unpack8(uint4 v, float* f) {
  f[0] = __uint_as_float(v.x << 16); f[1] = __uint_as_float(v.x & 0xffff0000u);
  f[2] = __uint_as_float(v.y << 16); f[3] = __uint_as_float(v.y & 0xffff0000u);
  f[4] = __uint_as_float(v.z << 16); f[5] = __uint_as_float(v.z & 0xffff0000u);
  f[6] = __uint_as_float(v.w << 16); f[7] = __uint_as_float(v.w & 0xffff0000u);
}
__device__ __forceinline__ uint4 pack8(const float* f) {
  uint4 v; v.x = pack2(f[0], f[1]); v.y = pack2(f[2], f[3]); v.z = pack2(f[4], f[5]); v.w = pack2(f[6], f[7]); return v;
}
__device__ __forceinline__ float wsum(float v) {
#pragma unroll
  for (int o = 32; o > 0; o >>= 1) v += __shfl_xor(v, o, 64);
  return v;
}
__device__ __forceinline__ float wmaxf(float v) {
#pragma unroll
  for (int o = 32; o > 0; o >>= 1) v = fmaxf(v, __shfl_xor(v, o, 64));
  return v;
}
__device__ __forceinline__ float sigmoidf_(float x) { return 1.f / (1.f + __expf(-x)); }

#define LROW 80
template <bool SEQ = false, class AL, class BL>
__device__ __forceinline__ void gemm_main(f32x4 (&acc)[4][4], AL aload, BL bload, int K, bfraw* sA, bfraw* sB) {
  int tid0_ = threadIdx.x; asm volatile("" : "+v"(tid0_));
  const int tid = tid0_, lane = tid & 63, wid = tid >> 6, wr = wid >> 1, wc = wid & 1, fr = lane & 15, fq = lane >> 4;
  uint4 ra0[4], rb0[4], ra1[4], rb1[4];
#define G_LOAD(ra_, rb_, kk_) _Pragma("unroll") for (int i = 0; i < 4; ++i) { int ch = tid + 256 * i; ra_[i] = aload(ch >> 3, (kk_) + (ch & 7) * 8); rb_[i] = bload(ch >> 3, (kk_) + (ch & 7) * 8); if (SEQ) __builtin_amdgcn_sched_barrier(0); }
#define G_STORE(ra_, rb_) _Pragma("unroll") for (int i = 0; i < 4; ++i) { int ch = tid + 256 * i; int r = ch >> 3, c = (ch & 7) * 8; *(uint4*)(sA + r * LROW + c) = ra_[i]; *(uint4*)(sB + r * LROW + c) = rb_[i]; }
#define G_COMPUTE _Pragma("unroll") for (int kk = 0; kk < 2; ++kk) { bf16x8 af[4], bfr[4]; \
        _Pragma("unroll") for (int m = 0; m < 4; ++m) af[m] = *(const bf16x8*)(sA + (wr * 64 + m * 16 + fr) * LROW + kk * 32 + fq * 8); \
        _Pragma("unroll") for (int n = 0; n < 4; ++n) bfr[n] = *(const bf16x8*)(sB + (wc * 64 + n * 16 + fr) * LROW + kk * 32 + fq * 8); \
      __builtin_amdgcn_s_setprio(1); \
      _Pragma("unroll") for (int m = 0; m < 4; ++m) _Pragma("unroll") for (int n = 0; n < 4; ++n) \
        acc[m][n] = __builtin_amdgcn_mfma_f32_16x16x32_bf16(af[m], bfr[n], acc[m][n], 0, 0, 0); \
      __builtin_amdgcn_s_setprio(0); }
  G_LOAD(ra0, rb0, 0)
  if (SEQ) {
#pragma unroll 1
    for (int k0 = 0; k0 < K; k0 += 64) {
      __syncthreads();
      G_STORE(ra0, rb0)
      __syncthreads();
      if (k0 + 64 < K) { G_LOAD(ra0, rb0, k0 + 64) }
      G_COMPUTE
    }
    __syncthreads();
    return;
  }
  if (K > 64) { G_LOAD(ra1, rb1, 64) }
#pragma unroll 1
  for (int k0 = 0; k0 < K; k0 += 128) {
    __syncthreads();
    G_STORE(ra0, rb0)
    __syncthreads();
    if (k0 + 128 < K) { G_LOAD(ra0, rb0, k0 + 128) }
    G_COMPUTE
    if (k0 + 64 < K) {
      __syncthreads();
      G_STORE(ra1, rb1)
      __syncthreads();
      if (k0 + 192 < K) { G_LOAD(ra1, rb1, k0 + 192) }
      G_COMPUTE
    }
  }
  __syncthreads();
}
#define ZERO_ACC(acc) _Pragma("unroll") for (int m_ = 0; m_ < 4; ++m_) _Pragma("unroll") for (int n_ = 0; n_ < 4; ++n_) acc[m_][n_] = f32x4{0.f, 0.f, 0.f, 0.f};
#define EPI_VARS const int tid = threadIdx.x, lane = tid & 63, wid = tid >> 6, wr = wid >> 1, wc = wid & 1, fr = lane & 15, fq = lane >> 4; (void)tid;
#define EPI_LOOP _Pragma("unroll") for (int m = 0; m < 4; ++m) _Pragma("unroll") for (int n = 0; n < 4; ++n) _Pragma("unroll") for (int j = 0; j < 4; ++j)
#define EPI_RC const int row = wr * 64 + m * 16 + fq * 4 + j, col = wc * 64 + n * 16 + fr;

__device__ __forceinline__ int swz(int row, int col) { return row * 128 + (col ^ (((row >> 2) & 1) << 4)); }
__device__ __forceinline__ int acc_to_lds_(const f32x4 (&acc)[4][4], float* sS) {
  EPI_VARS
  EPI_LOOP { EPI_RC sS[swz(row, col)] = acc[m][n][j]; }
  __syncthreads();
  int t_ = threadIdx.x; asm volatile("" : "+v"(t_));
  return t_;
}
#define acc_to_lds(acc, sS) const int etid_ = acc_to_lds_(acc, sS);
#define SEG_VARS(i_) const int idx_ = etid_ + 256 * (i_); const int row = idx_ >> 5, c4 = (idx_ & 31) * 4; const float4 v = *(const float4*)(sS + swz(row, c4));

__device__ __forceinline__ bool xcd_job(int it, int nct, int G, int& rt, int& ct) {
  const int x = blockIdx.x & 7, lr = blockIdx.x >> 3, nl = gridDim.x >> 3;
  const int j = lr + it * nl;
  const int nrt = (132 - x + 7) >> 3;
  if (j >= nrt * nct) return false;
  const int per = nrt * G; const int grp = j / per, rem = j - grp * per;
  rt = (rem / G) * 8 + x; ct = grp * G + rem % G;
  return true;
}

struct PlainLoad {
  const bfraw* base; int ld;
  __device__ __forceinline__ uint4 operator()(int r, int k) const { return *(const uint4*)(base + (size_t)r * ld + k); }
};

__device__ __forceinline__ void row_ssq_store(float (&ps)[4][4], float* sred, float* dst  ) {
  EPI_VARS
#pragma unroll
  for (int m = 0; m < 4; ++m)
#pragma unroll
    for (int j = 0; j < 4; ++j) {
      float v = ps[m][j];
      v += __shfl_xor(v, 1, 64); v += __shfl_xor(v, 2, 64); v += __shfl_xor(v, 4, 64); v += __shfl_xor(v, 8, 64);
      if (fr == 0) sred[wc * 128 + wr * 64 + m * 16 + fq * 4 + j] = v;
    }
  __syncthreads();
  if (tid < 128) dst[tid] = sred[tid] + sred[128 + tid];
  __syncthreads();
}

__device__ void transpose_tile(const float* src, int R, int C, bfraw* dst, const float* scale, int tile, float* sT, int dld = 0) {
  if (dld == 0) dld = R;
  int tc = C / 64; int tk = tile / tc, tn = tile % tc; int k0 = tk * 64, n0 = tn * 64;
  int tid = threadIdx.x, c = tid & 63, r0 = tid >> 6;
  __syncthreads();
  for (int i = 0; i < 16; ++i) { int r = r0 + 4 * i; sT[r * 65 + c] = src[(size_t)(k0 + r) * C + n0 + c]; }
  __syncthreads();
  float sc = scale ? scale[k0 + c] : 1.f;
  for (int i = 0; i < 16; ++i) { int r = r0 + 4 * i; dst[(size_t)(n0 + r) * dld + k0 + c] = f2bf(sT[c * 65 + r] * sc); }
}

__device__ void fold_job(const Params& P, int job, float* sm) {
  int hp = job >> 5, rem = job & 31, kt = rem >> 1, keyt = rem & 1;
  int p = hp & 1;
  float* sK = sm; float* sW = sm + 64 * 65;
  int tid = threadIdx.x, tx = tid & 15, ty = tid >> 4;
  float acc[4][4];
#pragma unroll
  for (int i = 0; i < 4; ++i)
#pragma unroll
    for (int j = 0; j < 4; ++j) acc[i][j] = 0.f;
  for (int ch = 0; ch < 2; ++ch) {
    __syncthreads();
    int c = tid & 63, r0 = tid >> 6;
    for (int i = 0; i < 16; ++i) {
      int r = r0 + 4 * i;
      sK[r * 65 + c] = P.peer_keys[((size_t)p * 128 + keyt * 64 + r) * 128 + ch * 64 + c];
      sW[r * 65 + c] = P.peer_wq[(size_t)(kt * 64 + r) * 2048 + hp * 128 + ch * 64 + c];
    }
    __syncthreads();
    for (int cc = 0; cc < 64; ++cc) {
      float kv[4], wv[4];
#pragma unroll
      for (int i = 0; i < 4; ++i) { kv[i] = sK[(ty * 4 + i) * 65 + cc]; wv[i] = sW[(tx * 4 + i) * 65 + cc]; }
#pragma unroll
      for (int i = 0; i < 4; ++i)
#pragma unroll
        for (int j = 0; j < 4; ++j) acc[i][j] += kv[i] * wv[j];
    }
  }
#pragma unroll
  for (int i = 0; i < 4; ++i) {
    int key = keyt * 64 + ty * 4 + i; int k = kt * 64 + tx * 4;
    float g0 = P.norm_ffn_g[k], g1 = P.norm_ffn_g[k + 1], g2 = P.norm_ffn_g[k + 2], g3 = P.norm_ffn_g[k + 3];
    uint2 v; v.x = pack2(acc[i][0] * g0, acc[i][1] * g1); v.y = pack2(acc[i][2] * g2, acc[i][3] * g3);
    *(uint2*)(P.Wt_q + (size_t)(hp * 128 + key) * 1024 + k) = v;
  }
}

__device__ __forceinline__ const float* xrow(const Params& P, int tau) {
  return tau < NPR ? P.x_prompt + (size_t)tau * 1024 : P.x_sample + (size_t)(tau - NPR) * 1024;
}

__device__ void prep_transpose(const Params& P, int t, float* sT) {
  if (t < 576) transpose_tile(P.w_in, 1024, 2304, P.Wt_in, nullptr, t, sT, LDP);
  else if (t < 832) transpose_tile(P.w_out, 1024, 1024, P.Wt_out, nullptr, t - 576, sT);
  else if (t < 1088) transpose_tile(P.ple_gate_w, 1024, 1024, P.Wt_pg, P.norm_ple_g, t - 832, sT);
  else if (t < 1152) transpose_tile(P.ple_w, 256, 1024, P.Wt_ple, nullptr, t - 1088, sT);
  else if (t < 1160) transpose_tile(P.decay_b, 64, 512, P.Wt_dec, nullptr, t - 1152, sT);
  else if (t < 1168) transpose_tile(P.a_b, 64, 512, P.Wt_a, nullptr, t - 1160, sT);
  else if (t < 1184) transpose_tile(P.g_b, 128, 512, P.Wt_g, nullptr, t - 1168, sT);
  else { int u = t - 1184; int gi = u >> 2; transpose_tile(P.pool_w + gi * 16384, 128, 128, P.Wt_pool + gi * 16384, nullptr, u & 3, sT); }
}
__device__ void late_prep_job(const Params& P, int job, char* smem) {
  if (job < 576) prep_transpose(P, 576 + job, (float*)smem);
  else fold_job(P, job - 576, (float*)smem);
}
#define N_LATE_PREP 1088

__device__ void phase0(const Params& P, char* smem) {
  const int NJ_RMS = NT / 4, NJ_TR = 576 + 48, NJ_POOLCP = 704;
  const int total = NJ_RMS + NJ_TR + NJ_POOLCP;
  int tid = threadIdx.x, lane = tid & 63, wid = tid >> 6;
  for (int job = blockIdx.x; job < total; job += gridDim.x) {
    if (job < NJ_RMS) {
      int tau = job * 4 + wid;
      const float* xr = xrow(P, tau);
      float4 v[4]; float ss = 0.f;
#pragma unroll
      for (int j = 0; j < 4; ++j) { v[j] = *(const float4*)(xr + lane * 4 + 256 * j); ss += v[j].x * v[j].x + v[j].y * v[j].y + v[j].z * v[j].z + v[j].w * v[j].w; }
      ss = wsum(ss);
      float rs = rsqrtf(ss * (1.f / 1024.f) + 1e-6f);
#pragma unroll
      for (int j = 0; j < 4; ++j) {
        float4 g = *(const float4*)(P.norm_mix_g + lane * 4 + 256 * j);
        uint2 o; o.x = pack2(v[j].x * rs * g.x, v[j].y * rs * g.y); o.y = pack2(v[j].z * rs * g.z, v[j].w * rs * g.w);
        *(uint2*)(P.regA + (size_t)tau * LDP + lane * 4 + 256 * j) = o;
      }
    } else if (job < NJ_RMS + NJ_TR) {
      int t = job - NJ_RMS;
      prep_transpose(P, t < 576 ? t : 1152 + (t - 576), (float*)smem);
    } else {
      int e0 = (job - NJ_RMS - NJ_TR) * 1024 + tid * 4;
      if (e0 < 128 * 11 * 512) {
        int b = e0 / (11 * 512), rem = e0 % (11 * 512), j = rem / 512, c = rem % 512;
        float4 v = *(const float4*)(P.state_pool + ((size_t)b * 15 + j + 4) * 512 + c);
        *(float4*)(P.out + O_POS + ((size_t)b * 15 + j) * 512 + c) = v;
      }
    }
  }
}

__device__ void phase1(const Params& P, char* smem) {
  bfraw* sA = (bfraw*)smem; bfraw* sB = sA + 128 * LROW;
  const int nct = DIN / 128;
  for (int it = 0;; ++it) {
    int rt, ct; if (!xcd_job(it, nct, 9, rt, ct)) break; int row0 = rt * 128, col0 = ct * 128;
    f32x4 acc[4][4]; ZERO_ACC(acc)
    gemm_main(acc, PlainLoad{P.regA + (size_t)row0 * LDP, LDP}, PlainLoad{P.Wt_in + (size_t)col0 * LDP, LDP}, 1024, sA, sB);
    float* sS = (float*)smem;
    acc_to_lds(acc, sS);
#pragma unroll 4
    for (int i = 0; i < 16; ++i) {
      SEG_VARS(i)
      int tau = row0 + row, c = col0 + c4;
      uint2 o; o.x = pack2(v.x, v.y); o.y = pack2(v.z, v.w);
      *(uint2*)(P.regZ + (size_t)tau * DIN + c) = o;
      if (tau < NPR) {
        int t = tau & 2047, b = tau >> 11;
        if (c < DSH) { if (t == 2047) *(float4*)(P.out + O_SHP + b * DSH + c) = v; }
        else if (t >= 2033) *(float4*)(P.out + O_POP + ((size_t)b * 15 + (t - 2033)) * 512 + (c - DSH)) = v;
      } else {
        int s = tau - NPR, b = s >> 2, t = s & 3;
        if (c < DSH) { if (t == 3) *(float4*)(P.out + O_SHS + b * DSH + c) = v; }
        else *(float4*)(P.out + O_POS + ((size_t)b * 15 + 11 + t) * 512 + (c - DSH)) = v;
      }
    }
  }
}

struct LoraLoad {
  const Params* P; int row0; int cb; int mode;
  __device__ __forceinline__ uint4 operator()(int r, int k) const {
    int tau = row0 + r; int zc = cb + k;
    float z[8], zp[8];
    unpack8(*(const uint4*)(P->regZ + (size_t)tau * DIN + zc), z);
    bool first; int b;
    if (tau < NPR) { first = (tau & 2047) == 0; b = 0; } else { int s = tau - NPR; first = (s & 3) == 0; b = s >> 2; }
    if (!first) unpack8(*(const uint4*)(P->regZ + (size_t)(tau - 1) * DIN + zc), zp);
    else if (tau < NPR) { for (int i = 0; i < 8; ++i) zp[i] = 0.f; }
    else {
      float4 a = *(const float4*)(P->state_shift + (size_t)b * DSH + zc), c = *(const float4*)(P->state_shift + (size_t)b * DSH + zc + 4);
      zp[0] = a.x; zp[1] = a.y; zp[2] = a.z; zp[3] = a.w; zp[4] = c.x; zp[5] = c.y; zp[6] = c.z; zp[7] = c.w;
    }
    float4 m0 = *(const float4*)(P->shift_mu + zc), m1 = *(const float4*)(P->shift_mu + zc + 4);
    float mu[8] = {m0.x, m0.y, m0.z, m0.w, m1.x, m1.y, m1.z, m1.w};
    float o[8];
#pragma unroll
    for (int i = 0; i < 8; ++i) {
      float zs = z[i] + (zp[i] - z[i]) * mu[i];
      o[i] = mode == 0 ? (1.f - 2.f / (1.f + __expf(2.f * zs))) : (mode == 1 ? zs : sigmoidf_(zs));
    }
    return pack8(o);
  }
};

struct PoolLoad {
  const Params* P; int row0; int gi;
  __device__ __forceinline__ uint4 operator()(int r, int k) const {
    int tau = row0 + r; int pc = gi * 128 + k; int zc = DSH + pc; int w = 2 << gi;
    float u[8], s[8], t8[8];
    unpack8(*(const uint4*)(P->regZ + (size_t)tau * DIN + zc), u);
#pragma unroll
    for (int i = 0; i < 8; ++i) s[i] = u[i];
    float cnt;
    if (tau < NPR) {
      int t = tau & 2047; int nv = min(t + 1, w); cnt = (float)nv;
      for (int d = 1; d < nv; ++d) {
        unpack8(*(const uint4*)(P->regZ + (size_t)(tau - d) * DIN + zc), t8);
#pragma unroll
        for (int i = 0; i < 8; ++i) s[i] += t8[i];
      }
    } else {
      int sidx = tau - NPR, b = sidx >> 2, t = sidx & 3; cnt = (float)w;
      for (int d = 1; d < w; ++d) {
        if (t - d >= 0) unpack8(*(const uint4*)(P->regZ + (size_t)(tau - d) * DIN + zc), t8);
        else {
          const float* sp = P->state_pool + ((size_t)b * 15 + (15 + t - d)) * 512 + pc;
          float4 a = *(const float4*)sp, c = *(const float4*)(sp + 4);
          t8[0] = a.x; t8[1] = a.y; t8[2] = a.z; t8[3] = a.w; t8[4] = c.x; t8[5] = c.y; t8[6] = c.z; t8[7] = c.w;
        }
#pragma unroll
        for (int i = 0; i < 8; ++i) s[i] += t8[i];
      }
    }
    float inv = 1.f / cnt; float o[8];
#pragma unroll
    for (int i = 0; i < 8; ++i) o[i] = s[i] * inv - u[i];
    return pack8(o);
  }
};

__device__ void phase2(const Params& P, char* smem) {
  bfraw* sA = (bfraw*)smem; bfraw* sB = sA + 128 * LROW;
  float* Wd = (float*)P.regA; bfraw* Aa = P.regB; bfraw* Gg = P.regB + (size_t)NT * 512;
  for (int job = blockIdx.x; job < 4224; job += gridDim.x) {
    int item = job * 256 + threadIdx.x; int tau = item >> 6, chunk = item & 63;
    PoolLoad pl{&P, 0, chunk >> 4};
    *(uint4*)(P.regP + (size_t)tau * 512 + chunk * 8) = pl(tau, (chunk & 15) * 8);
  }
  for (int job = blockIdx.x; job < 1584; job += gridDim.x) {
    int kind = job / 528, jj = job % 528, rt = jj >> 2, ct = jj & 3; int row0 = rt * 128;
    f32x4 acc[4][4]; ZERO_ACC(acc)
    float* sS = (float*)smem;
    if (kind == 0) {
      gemm_main<true>(acc, LoraLoad{&P, row0, 1536, 0}, PlainLoad{P.Wt_dec + (size_t)ct * 128 * 64, 64}, 64, sA, sB);
      acc_to_lds(acc, sS);
#pragma unroll 4
      for (int i = 0; i < 16; ++i) { SEG_VARS(i) int c = ct * 128 + c4;
        float4 w0 = *(const float4*)(P.decay_w0 + c); float4 o;
        o.x = __expf(-0.6065306597f * sigmoidf_(w0.x + v.x)); o.y = __expf(-0.6065306597f * sigmoidf_(w0.y + v.y));
        o.z = __expf(-0.6065306597f * sigmoidf_(w0.z + v.z)); o.w = __expf(-0.6065306597f * sigmoidf_(w0.w + v.w));
        *(float4*)(Wd + (size_t)(row0 + row) * 512 + c) = o; }
    } else if (kind == 1) {
      gemm_main<true>(acc, LoraLoad{&P, row0, 1600, 1}, PlainLoad{P.Wt_a + (size_t)ct * 128 * 64, 64}, 64, sA, sB);
      acc_to_lds(acc, sS);
#pragma unroll 4
      for (int i = 0; i < 16; ++i) { SEG_VARS(i) int c = ct * 128 + c4;
        float4 a0 = *(const float4*)(P.a_0 + c); uint2 o;
        o.x = pack2(sigmoidf_(a0.x + v.x), sigmoidf_(a0.y + v.y)); o.y = pack2(sigmoidf_(a0.z + v.z), sigmoidf_(a0.w + v.w));
        *(uint2*)(Aa + (size_t)(row0 + row) * 512 + c) = o; }
    } else if (kind == 2) {
      gemm_main<true>(acc, LoraLoad{&P, row0, 1664, 2}, PlainLoad{P.Wt_g + (size_t)ct * 128 * 128, 128}, 128, sA, sB);
      acc_to_lds(acc, sS);
#pragma unroll 4
      for (int i = 0; i < 16; ++i) { SEG_VARS(i) int c = ct * 128 + c4;
        uint2 o; o.x = pack2(v.x, v.y); o.y = pack2(v.z, v.w);
        *(uint2*)(Gg + (size_t)(row0 + row) * 512 + c) = o; }
    }
  }
}

__device__ void wkv_direct(const Params& P, int unit, float* sw) {
  const int lane = threadIdx.x & 63;
  const float* Wd = (const float*)P.regA; const bfraw* Aa = P.regB; const bfraw* Gg = P.regB + (size_t)NT * 512;
  bool prompt = unit < 64; int b, h, T, tok0;
  if (prompt) { b = unit >> 3; h = unit & 7; T = 2048; tok0 = b * 2048; }
  else { int u = unit - 64; b = u >> 3; h = u & 7; T = 4; tok0 = NPR + 4 * b; }
  float S[64];
  if (prompt) {
#pragma unroll
    for (int j = 0; j < 64; ++j) S[j] = 0.f;
  } else {
    const float* sp = P.state_wkv + (((size_t)b * 8 + h) * 64 + lane) * 64;
#pragma unroll
    for (int j = 0; j < 16; ++j) { float4 v = *(const float4*)(sp + j * 4); S[j * 4] = v.x; S[j * 4 + 1] = v.y; S[j * 4 + 2] = v.z; S[j * 4 + 3] = v.w; }
  }
  const int hc = h * 64 + lane;
  const float mu_r = P.shift_mu[hc], mu_k = P.shift_mu[512 + hc], mu_v = P.shift_mu[1024 + hc];
  const float kkw = P.k_k[hc], kaw = P.k_a[hc], rkw = P.r_k[hc], lg = P.lnx_g[hc], lb = P.lnx_b[hc];
  float pr, pk, pv;
  if (prompt) { pr = pk = pv = 0.f; }
  else { const float* ss = P.state_shift + (size_t)b * DSH; pr = ss[hc]; pk = ss[512 + hc]; pv = ss[1024 + hc]; }
  float* s_kk = sw; float* s_w = sw + 64; float* s_ka = sw + 128; float* s_k = sw + 192; float* s_r = sw + 256;
  for (int t = 0; t < T; ++t) {
    int tau = tok0 + t;
    const bfraw* zr = P.regZ + (size_t)tau * DIN;
    float zr_ = bf2f(zr[hc]), zk_ = bf2f(zr[512 + hc]), zv_ = bf2f(zr[1024 + hc]);
    float r = zr_ + (pr - zr_) * mu_r, k = zk_ + (pk - zk_) * mu_k, v = zv_ + (pv - zv_) * mu_v;
    pr = zr_; pk = zk_; pv = zv_;
    float a = bf2f(Aa[(size_t)tau * 512 + hc]), w = Wd[(size_t)tau * 512 + hc], g = bf2f(Gg[(size_t)tau * 512 + hc]);
    float kkf = k * kkw; float nrm = sqrtf(wsum(kkf * kkf)); float kk = kkf / fmaxf(nrm, 1e-12f);
    float k2 = k * (1.f + (a - 1.f) * kaw);
    float ka = kk * a;
    float bsum = wsum(r * k2 * rkw);
    __builtin_amdgcn_wave_barrier();
    s_kk[lane] = kk; s_w[lane] = w; s_ka[lane] = ka; s_k[lane] = k2; s_r[lane] = r;
    __builtin_amdgcn_wave_barrier();
    float skk = 0.f;
#pragma unroll
    for (int j = 0; j < 16; ++j) { float4 q = *(const float4*)(s_kk + j * 4); skk += S[j * 4] * q.x + S[j * 4 + 1] * q.y + S[j * 4 + 2] * q.z + S[j * 4 + 3] * q.w; }
    skk = -skk;
    float o = 0.f;
#pragma unroll
    for (int j = 0; j < 16; ++j) {
      float4 qw = *(const float4*)(s_w + j * 4), qa = *(const float4*)(s_ka + j * 4), qk = *(const float4*)(s_k + j * 4), qr = *(const float4*)(s_r + j * 4);
      S[j * 4] = S[j * 4] * qw.x + skk * qa.x + v * qk.x; o += S[j * 4] * qr.x;
      S[j * 4 + 1] = S[j * 4 + 1] * qw.y + skk * qa.y + v * qk.y; o += S[j * 4 + 1] * qr.y;
      S[j * 4 + 2] = S[j * 4 + 2] * qw.z + skk * qa.z + v * qk.z; o += S[j * 4 + 2] * qr.z;
      S[j * 4 + 3] = S[j * 4 + 3] * qw.w + skk * qa.w + v * qk.w; o += S[j * 4 + 3] * qr.w;
    }
    float mean = wsum(o) * (1.f / 64.f); float dd = o - mean; float var = wsum(dd * dd) * (1.f / 64.f);
    float y = (dd * rsqrtf(var + 64e-5f) * lg + lb + bsum * v) * g;
    P.regY[(size_t)tau * 1024 + hc] = f2bf(y);
  }
  float* so = P.out + (prompt ? O_WKP : O_WKS) + (((size_t)b * 8 + h) * 64 + lane) * 64;
#pragma unroll
  for (int j = 0; j < 16; ++j) *(float4*)(so + j * 4) = make_float4(S[j * 4], S[j * 4 + 1], S[j * 4 + 2], S[j * 4 + 3]);
}

#define MFMA16(a, b, c) __builtin_amdgcn_mfma_f32_16x16x32_bf16(a, b, c, 0, 0, 0)
__device__ void wkv_chunk_pre(const Params& P, int unit, char* smem) {
  const int tid = threadIdx.x, lane = tid & 63, w = tid >> 6, fr = lane & 15, fq = lane >> 4;
  bfraw* Ah = (bfraw*)smem; bfraw* Bh = Ah + 2304; bfraw* Kh = Bh + 2304; bfraw* Rh = Kh + 2304;
  bfraw* AhT = Rh + 2304;
  bfraw* Vt = AhT + 2560; bfraw* NakT = Vt + 2560; bfraw* MbrT = NakT + 1280; bfraw* MkrT = MbrT + 1280; bfraw* Tt = MkrT + 1280;
  bfraw* VN = Tt + 1280; bfraw* nAt = VN + 2560; bfraw* nD0 = nAt + 2560;
  float* G = (float*)(nD0 + 2560);
  float* gC = G + 2048;
  float* NabT = G;
  const float* Wd = (const float*)P.regA; const bfraw* Aa = P.regB;
  const int b = unit >> 9, h = (unit >> 6) & 7, c = unit & 63;
  const int tok0 = b * 2048 + c * 32;
  __syncthreads();
  {
    const int t = tid >> 3, jg = tid & 7, j0 = jg * 8, hc = h * 64 + j0;
    const int tau = tok0 + t;
    const bool first = (c == 0 && t == 0);
    const bfraw* zr = P.regZ + (size_t)tau * DIN;
    float zr_[8], zk_[8], zv_[8], pr[8], pk[8], pv[8];
    unpack8(*(const uint4*)(zr + hc), zr_); unpack8(*(const uint4*)(zr + 512 + hc), zk_); unpack8(*(const uint4*)(zr + 1024 + hc), zv_);
    if (!first) { unpack8(*(const uint4*)(zr - DIN + hc), pr); unpack8(*(const uint4*)(zr - DIN + 512 + hc), pk); unpack8(*(const uint4*)(zr - DIN + 1024 + hc), pv); }
    else {
#pragma unroll
      for (int i = 0; i < 8; ++i) { pr[i] = 0.f; pk[i] = 0.f; pv[i] = 0.f; }
    }
    float a[8], wd[8], r[8], k[8], v[8], kk[8], k2[8];
    unpack8(*(const uint4*)(Aa + (size_t)tau * 512 + hc), a);
    { float4 x = *(const float4*)(Wd + (size_t)tau * 512 + hc), y = *(const float4*)(Wd + (size_t)tau * 512 + hc + 4);
      wd[0] = x.x; wd[1] = x.y; wd[2] = x.z; wd[3] = x.w; wd[4] = y.x; wd[5] = y.y; wd[6] = y.z; wd[7] = y.w; }
    float ss = 0.f, bs = 0.f;
#pragma unroll
    for (int i = 0; i < 8; ++i) {
      float mr = P.shift_mu[hc + i], mk = P.shift_mu[512 + hc + i], mv = P.shift_mu[1024 + hc + i];
      r[i] = zr_[i] + (pr[i] - zr_[i]) * mr; k[i] = zk_[i] + (pk[i] - zk_[i]) * mk; v[i] = zv_[i] + (pv[i] - zv_[i]) * mv;
      float kkf = k[i] * P.k_k[hc + i]; kk[i] = kkf; ss += kkf * kkf;
      k2[i] = k[i] * (1.f + (a[i] - 1.f) * P.k_a[hc + i]);
      bs += r[i] * k2[i] * P.r_k[hc + i];
    }
    ss += __shfl_xor(ss, 1, 64); ss += __shfl_xor(ss, 2, 64); ss += __shfl_xor(ss, 4, 64);
    bs += __shfl_xor(bs, 1, 64); bs += __shfl_xor(bs, 2, 64); bs += __shfl_xor(bs, 4, 64);
    if (jg == 0) P.bonus[(size_t)tau * 8 + h] = bs;
    float inv = 1.f / fmaxf(sqrtf(ss), 1e-12f);
    *(float4*)(G + t * 64 + j0) = make_float4(wd[0], wd[1], wd[2], wd[3]);
    *(float4*)(G + t * 64 + j0 + 4) = make_float4(wd[4], wd[5], wd[6], wd[7]);
    __syncthreads();
    if (tid < 64) {
      float g = 1.f;
      for (int t2 = 0; t2 < 32; ++t2) { g *= G[t2 * 64 + tid]; G[t2 * 64 + tid] = g; }
      gC[tid] = g;
    }
    __syncthreads();
    float ah[8], bh[8], kh[8], rh[8];
#pragma unroll
    for (int i = 0; i < 8; ++i) {
      float gt = G[t * 64 + j0 + i]; float gp = t > 0 ? G[(t - 1) * 64 + j0 + i] : 1.f; float ig = 1.f / gt;
      float kkn = kk[i] * inv;
      ah[i] = kkn * gp; bh[i] = kkn * a[i] * ig; kh[i] = k2[i] * ig; rh[i] = r[i] * gt;
    }
    uint4 pa = pack8(ah);
    *(uint4*)(Ah + t * 72 + j0) = pa; *(uint4*)(Bh + t * 72 + j0) = pack8(bh); *(uint4*)(Kh + t * 72 + j0) = pack8(kh); *(uint4*)(Rh + t * 72 + j0) = pack8(rh);
    unsigned int paw[4] = {pa.x, pa.y, pa.z, pa.w};
#pragma unroll
    for (int i = 0; i < 8; ++i) {
      AhT[(j0 + i) * 40 + t] = (bfraw)((i & 1) ? (paw[i >> 1] >> 16) : (paw[i >> 1] & 0xffffu));
      Vt[(j0 + i) * 40 + t] = f2bf(v[i]);
    }
  }
  __syncthreads();
  const f32x4 z4 = {0.f, 0.f, 0.f, 0.f};
  {
    const bfraw* Xp = (w & 1) ? Kh : Bh; const bfraw* Yp = (w >> 1) ? Rh : Ah;
    f32x4 acc[2][2] = {{z4, z4}, {z4, z4}};
#pragma unroll
    for (int ks = 0; ks < 2; ++ks) {
      bf16x8 xa[2], yb[2];
#pragma unroll
      for (int mt = 0; mt < 2; ++mt) { xa[mt] = *(const bf16x8*)(Xp + (mt * 16 + fr) * 72 + ks * 32 + fq * 8); yb[mt] = *(const bf16x8*)(Yp + (mt * 16 + fr) * 72 + ks * 32 + fq * 8); }
#pragma unroll
      for (int mt = 0; mt < 2; ++mt)
#pragma unroll
        for (int nt = 0; nt < 2; ++nt) acc[mt][nt] = MFMA16(xa[mt], yb[nt], acc[mt][nt]);
    }
    bfraw* dst = (w == 1) ? NakT : (w == 2 ? MbrT : MkrT);
#pragma unroll
    for (int mt = 0; mt < 2; ++mt)
#pragma unroll
      for (int nt = 0; nt < 2; ++nt)
#pragma unroll
        for (int jj = 0; jj < 4; ++jj) {
          int ta = mt * 16 + fq * 4 + jj, tt = nt * 16 + fr; float val = acc[mt][nt][jj];
          if (w == 0) NabT[tt * 32 + ta] = (ta < tt) ? val : 0.f;
          else { bool keep = (w == 1) ? (ta < tt) : (ta <= tt); dst[tt * 40 + ta] = f2bf(keep ? val : 0.f); }
        }
  }
  __syncthreads();
  const bf16x8 xv = *(const bf16x8*)(Vt + (16 * w + fr) * 40 + fq * 8);
  {
#pragma unroll
    for (int nt = 0; nt < 2; ++nt) {
      bf16x8 yb = *(const bf16x8*)(NakT + (nt * 16 + fr) * 40 + fq * 8);
      f32x4 acc = MFMA16(xv, yb, z4);
#pragma unroll
      for (int jj = 0; jj < 4; ++jj) VN[(16 * w + fq * 4 + jj) * 40 + nt * 16 + fr] = f2bf(acc[jj]);
    }
  }
  if (w == 0 && lane < 32) {
    float Tr[32];
#pragma unroll
    for (int t = 0; t < 32; ++t) {
      float a0 = (lane == t) ? 1.f : 0.f, a1 = 0.f, a2 = 0.f, a3 = 0.f;
#pragma unroll
      for (int q = 0; q < (t + 3) / 4; ++q) {
        float4 nv = *(const float4*)(NabT + t * 32 + q * 4);
        a0 -= Tr[q * 4] * nv.x;
        if (q * 4 + 1 < t) a1 -= Tr[q * 4 + 1] * nv.y;
        if (q * 4 + 2 < t) a2 -= Tr[q * 4 + 2] * nv.z;
        if (q * 4 + 3 < t) a3 -= Tr[q * 4 + 3] * nv.w;
      }
      float acc = (a0 + a1) + (a2 + a3);
      Tr[t] = acc;
      Tt[t * 40 + lane] = f2bf(acc);
    }
  }
  __syncthreads();
  bf16x8 xn, xd;
  {
    bf16x8 xa = *(const bf16x8*)(AhT + (16 * w + fr) * 40 + fq * 8);
    bf16x8 xvn = *(const bf16x8*)(VN + (16 * w + fr) * 40 + fq * 8);
#pragma unroll
    for (int nt = 0; nt < 2; ++nt) {
      bf16x8 yb = *(const bf16x8*)(Tt + (nt * 16 + fr) * 40 + fq * 8);
      f32x4 aA = MFMA16(xa, yb, z4), aD = MFMA16(xvn, yb, z4);
#pragma unroll
      for (int jj = 0; jj < 4; ++jj) {
        nAt[(16 * w + fq * 4 + jj) * 40 + nt * 16 + fr] = f2bf(-aA[jj]);
        nD0[(16 * w + fq * 4 + jj) * 40 + nt * 16 + fr] = f2bf(-aD[jj]);
      }
    }
    __builtin_amdgcn_wave_barrier();
    xn = *(const bf16x8*)(nAt + (16 * w + fr) * 40 + fq * 8);
    xd = *(const bf16x8*)(nD0 + (16 * w + fr) * 40 + fq * 8);
  }
  char* pq = (char*)P.regPQ + (size_t)unit * 12288;
  char* lo = (char*)P.out + (size_t)unit * 12288;
  bfraw* PmT = (bfraw*)pq; bfraw* QT = (bfraw*)(pq + 8192);
  uint2* Lb = (uint2*)lo; uint2* Ob = (uint2*)(lo + 8192);
#pragma unroll
  for (int nt = 0; nt < 2; ++nt) {
    bf16x8 ymb = *(const bf16x8*)(MbrT + (nt * 16 + fr) * 40 + fq * 8), ymk = *(const bf16x8*)(MkrT + (nt * 16 + fr) * 40 + fq * 8);
    f32x4 aQ = MFMA16(xn, ymb, z4);
    f32x4 aO = MFMA16(xv, ymk, z4); aO = MFMA16(xd, ymb, aO);
    int tt = nt * 16 + fr; float q[4];
#pragma unroll
    for (int jj = 0; jj < 4; ++jj) q[jj] = aQ[jj] + bf2f(Rh[tt * 72 + 16 * w + fq * 4 + jj]);
    uint2 o; o.x = pack2(q[0], q[1]); o.y = pack2(q[2], q[3]);
    *(uint2*)(QT + tt * 64 + 16 * w + fq * 4) = o;
    uint2 o2; o2.x = pack2(aO[0], aO[1]); o2.y = pack2(aO[2], aO[3]);
    Ob[(w * 2 + nt) * 64 + lane] = o2;
  }
#pragma unroll
  for (int nt = 0; nt < 4; ++nt) {
    bf16x8 ybB, ybK;
#pragma unroll
    for (int e = 0; e < 8; ++e) { ybB[e] = (short)Bh[(fq * 8 + e) * 72 + nt * 16 + fr]; ybK[e] = (short)Kh[(fq * 8 + e) * 72 + nt * 16 + fr]; }
    f32x4 aP = MFMA16(xn, ybB, z4);
    f32x4 aL = MFMA16(xv, ybK, z4); aL = MFMA16(xd, ybB, aL);
    int jp = nt * 16 + fr; float gc = gC[jp]; float pm[4], l[4];
#pragma unroll
    for (int jj = 0; jj < 4; ++jj) { int j = 16 * w + fq * 4 + jj; pm[jj] = gc * ((j == jp ? 1.f : 0.f) + aP[jj]); l[jj] = gc * aL[jj]; }
    uint2 o; o.x = pack2(pm[0], pm[1]); o.y = pack2(pm[2], pm[3]);
    *(uint2*)(PmT + jp * 64 + 16 * w + fq * 4) = o;
    uint2 o2; o2.x = pack2(l[0], l[1]); o2.y = pack2(l[2], l[3]);
    Lb[(w * 4 + nt) * 64 + lane] = o2;
  }
}

__device__ __forceinline__ f32x4 unpack4(uint2 u) {
  f32x4 r; r[0] = __uint_as_float(u.x << 16); r[1] = __uint_as_float(u.x & 0xffff0000u); r[2] = __uint_as_float(u.y << 16); r[3] = __uint_as_float(u.y & 0xffff0000u); return r;
}
struct SeqOps { bf16x8 pm[4][2]; bf16x8 qt[2][2]; uint2 l[4]; uint2 o0[2]; };
__device__ __forceinline__ void seq_load(const Params& P, int bh, int c, int w, int lane, SeqOps& o, int cmax = 63) {
  const int fr = lane & 15, fq = lane >> 4;
  const int unit = bh * 64 + (c < cmax ? c : cmax);
  const char* pq = (const char*)P.regPQ + (size_t)unit * 12288; const char* lo = (const char*)P.out + (size_t)unit * 12288;
  const bfraw* PmT = (const bfraw*)pq; const bfraw* QT = (const bfraw*)(pq + 8192);
  const uint2* Lb = (const uint2*)lo; const uint2* Ob = (const uint2*)(lo + 8192);
#pragma unroll
  for (int nt = 0; nt < 4; ++nt)
#pragma unroll
    for (int ks = 0; ks < 2; ++ks) o.pm[nt][ks] = *(const bf16x8*)(PmT + (nt * 16 + fr) * 64 + ks * 32 + fq * 8);
#pragma unroll
  for (int nt = 0; nt < 2; ++nt)
#pragma unroll
    for (int ks = 0; ks < 2; ++ks) o.qt[nt][ks] = *(const bf16x8*)(QT + (nt * 16 + fr) * 64 + ks * 32 + fq * 8);
#pragma unroll
  for (int nt = 0; nt < 4; ++nt) o.l[nt] = Lb[(w * 4 + nt) * 64 + lane];
#pragma unroll
  for (int nt = 0; nt < 2; ++nt) o.o0[nt] = Ob[(w * 2 + nt) * 64 + lane];
}
__device__ __forceinline__ void seq_step(const Params& P, int b, int h, int c, int w, int lane, float* strip, f32x4 (&S)[4], const SeqOps& o) {
  const int fr = lane & 15, fq = lane >> 4;
  bfraw* Oraw = (bfraw*)((char*)P.out + 50331648);
  __builtin_amdgcn_wave_barrier();
#pragma unroll
  for (int nt = 0; nt < 4; ++nt)
#pragma unroll
    for (int jj = 0; jj < 4; ++jj) strip[(fq * 4 + jj) * 68 + nt * 16 + fr] = S[nt][jj];
  __builtin_amdgcn_wave_barrier();
  bf16x8 xh[2], xl[2];
#pragma unroll
  for (int ks = 0; ks < 2; ++ks) {
    float4 p0 = *(const float4*)(strip + fr * 68 + ks * 32 + fq * 8), p1 = *(const float4*)(strip + fr * 68 + ks * 32 + fq * 8 + 4);
    float xs[8] = {p0.x, p0.y, p0.z, p0.w, p1.x, p1.y, p1.z, p1.w};
    unsigned int hp[4], lp[4];
#pragma unroll
    for (int e = 0; e < 4; ++e) {
      hp[e] = pack2(xs[2 * e], xs[2 * e + 1]);
      lp[e] = pack2(xs[2 * e] - __uint_as_float(hp[e] << 16), xs[2 * e + 1] - __uint_as_float(hp[e] & 0xffff0000u));
    }
    xh[ks] = __builtin_bit_cast(bf16x8, make_uint4(hp[0], hp[1], hp[2], hp[3]));
    xl[ks] = __builtin_bit_cast(bf16x8, make_uint4(lp[0], lp[1], lp[2], lp[3]));
  }
  f32x4 aO[2];
#pragma unroll
  for (int nt = 0; nt < 2; ++nt) {
    aO[nt] = unpack4(o.o0[nt]);
#pragma unroll
    for (int ks = 0; ks < 2; ++ks) { aO[nt] = MFMA16(xh[ks], o.qt[nt][ks], aO[nt]); aO[nt] = MFMA16(xl[ks], o.qt[nt][ks], aO[nt]); }
  }
#pragma unroll
  for (int nt = 0; nt < 4; ++nt) {
    f32x4 aS = unpack4(o.l[nt]);
#pragma unroll
    for (int ks = 0; ks < 2; ++ks) { aS = MFMA16(xh[ks], o.pm[nt][ks], aS); aS = MFMA16(xl[ks], o.pm[nt][ks], aS); }
    S[nt] = aS;
  }
  const int tok0 = b * 2048 + c * 32;
#pragma unroll
  for (int nt = 0; nt < 2; ++nt) {
    uint2 ov; ov.x = pack2(aO[nt][0], aO[nt][1]); ov.y = pack2(aO[nt][2], aO[nt][3]);
    *(uint2*)(Oraw + (size_t)(tok0 + nt * 16 + fr) * 512 + h * 64 + 16 * w + fq * 4) = ov;
  }
}
__device__ void wkv_seq(const Params& P, int bh, char* smem, int c0, int c1) {
  const int tid = threadIdx.x, lane = tid & 63, w = tid >> 6, fr = lane & 15, fq = lane >> 4;
  float* strip = (float*)smem + w * 16 * 68;
  const int b = bh >> 3, h = bh & 7;
  f32x4* sb = (f32x4*)P.Sbuf + ((size_t)(bh * 4 + w) * 4) * 64 + lane;
  f32x4 S[4];
#pragma unroll
  for (int nt = 0; nt < 4; ++nt) S[nt] = (c0 == 0) ? f32x4{0.f, 0.f, 0.f, 0.f} : sb[nt * 64];
  const int cm = c1 - 1;
  SeqOps o0, o1, o2;
  seq_load(P, bh, c0, w, lane, o0, cm);
  seq_load(P, bh, c0 + 1, w, lane, o1, cm);
#pragma unroll 1
  for (int c = c0; c < c1; c += 3) {
    seq_load(P, bh, c + 2, w, lane, o2, cm);
    seq_step(P, b, h, c, w, lane, strip, S, o0);
    seq_load(P, bh, c + 3, w, lane, o0, cm);
    if (c + 1 < c1) seq_step(P, b, h, c + 1, w, lane, strip, S, o1);
    seq_load(P, bh, c + 4, w, lane, o1, cm);
    if (c + 2 < c1) seq_step(P, b, h, c + 2, w, lane, strip, S, o2);
  }
  if (c1 < 64) {
#pragma unroll
    for (int nt = 0; nt < 4; ++nt) sb[nt * 64] = S[nt];
    return;
  }
  float* so = P.out + O_WKP + ((size_t)bh * 64) * 64;
#pragma unroll
  for (int nt = 0; nt < 4; ++nt)
#pragma unroll
    for (int jj = 0; jj < 4; ++jj) so[(16 * w + fq * 4 + jj) * 64 + nt * 16 + fr] = S[nt][jj];
}
__device__ void phase3a(const Params& P, char* smem) {
  for (int u = blockIdx.x; u < 2048; u += gridDim.x) wkv_chunk_pre(P, (u >> 5) * 64 + (u & 31), smem);
}
__device__ void phase3x(const Params& P, char* smem) {
  if (blockIdx.x < 64) { wkv_seq(P, blockIdx.x, smem, 0, 32); return; }
  const int nb = gridDim.x - 64;
  bfraw* sA = (bfraw*)smem; bfraw* sB = sA + 128 * LROW;
  for (int u = blockIdx.x - 64; u < 2048; u += nb) wkv_chunk_pre(P, (u >> 5) * 64 + 32 + (u & 31), smem);
  __syncthreads();
  for (int job = (blockIdx.x - 64 + nb - (2048 % nb)) % nb; job < 528; job += nb) {
    int rt = job >> 2, gi = job & 3; int row0 = rt * 128;
    f32x4 acc[4][4]; ZERO_ACC(acc)
    float* sS = (float*)smem;
    gemm_main(acc, PlainLoad{P.regP + (size_t)row0 * 512 + gi * 128, 512}, PlainLoad{P.Wt_pool + (size_t)gi * 16384, 128}, 128, sA, sB);
    acc_to_lds(acc, sS);
#pragma unroll 4
    for (int i = 0; i < 16; ++i) { SEG_VARS(i) int c = gi * 128 + c4;
      float4 ps = *(const float4*)(P.pool_scale + c);
      uint2 o; o.x = pack2(v.x * ps.x, v.y * ps.y); o.y = pack2(v.z * ps.z, v.w * ps.w);
      *(uint2*)(P.regY + (size_t)(row0 + row) * 1024 + 512 + c) = o; }
  }
}

struct F32Load {
  const float* base; int ld;
  __device__ __forceinline__ uint4 operator()(int r, int k) const {
    const float* p = base + (size_t)r * ld + k;
    float4 a = *(const float4*)p, c = *(const float4*)(p + 4);
    uint4 o; o.x = pack2(a.x, a.y); o.y = pack2(a.z, a.w); o.z = pack2(c.x, c.y); o.w = pack2(c.z, c.w); return o;
  }
};
__device__ void fold_job_mfma(const Params& P, int job, char* smem) {
  bfraw* sA = (bfraw*)smem; bfraw* sB = sA + 128 * LROW;
  const int hp = job >> 3, k0 = (job & 7) * 128, p = hp & 1;
  f32x4 acc[4][4]; ZERO_ACC(acc)
  float* sS = (float*)smem;
  gemm_main(acc, F32Load{P.peer_keys + (size_t)p * 128 * 128, 128}, F32Load{P.peer_wq + (size_t)k0 * 2048 + hp * 128, 2048}, 128, sA, sB);
  acc_to_lds(acc, sS);
#pragma unroll 4
  for (int i = 0; i < 16; ++i) { SEG_VARS(i)
    float4 g = *(const float4*)(P.norm_ffn_g + k0 + c4);
    uint2 o; o.x = pack2(v.x * g.x, v.y * g.y); o.y = pack2(v.z * g.z, v.w * g.w);
    *(uint2*)(P.Wt_q + (size_t)(hp * 128 + row) * 1024 + k0 + c4) = o; }
}

__device__ void phase3b(const Params& P, char* smem, float* sred) {
  int wid = threadIdx.x >> 6;
  bfraw* sA = (bfraw*)smem; bfraw* sB = sA + 128 * LROW;
  if (blockIdx.x < 64) { wkv_seq(P, blockIdx.x, smem, 32, 64); return; }
  const int nb = gridDim.x - 64;
  for (int job = blockIdx.x - 64; job < 256; job += nb) wkv_direct(P, 64 + job * 4 + wid, (float*)smem + wid * 320);
  __syncthreads();
  __syncthreads();
  for (int job = (blockIdx.x - 64 + nb - (256 % nb)) % nb; job < 128; job += nb) fold_job_mfma(P, job, smem);
  __syncthreads();
  for (int job = (blockIdx.x - 64 + 2 * nb - ((256 + 128) % nb)) % nb; job < 576; job += nb) { __syncthreads(); prep_transpose(P, 576 + job, (float*)smem); }
}

__device__ void phase3c(const Params& P) {
  const int lane = threadIdx.x & 63, wid = threadIdx.x >> 6;
  const bfraw* Oraw = (const bfraw*)((const char*)P.out + 50331648);
  const bfraw* Gg = P.regB + (size_t)NT * 512;
  const int c0 = lane * 8, hd = lane >> 3;
  float mu[8], lg[8], lb[8];
  { float4 a = *(const float4*)(P.shift_mu + 1024 + c0), c = *(const float4*)(P.shift_mu + 1024 + c0 + 4);
    mu[0] = a.x; mu[1] = a.y; mu[2] = a.z; mu[3] = a.w; mu[4] = c.x; mu[5] = c.y; mu[6] = c.z; mu[7] = c.w;
    a = *(const float4*)(P.lnx_g + c0); c = *(const float4*)(P.lnx_g + c0 + 4);
    lg[0] = a.x; lg[1] = a.y; lg[2] = a.z; lg[3] = a.w; lg[4] = c.x; lg[5] = c.y; lg[6] = c.z; lg[7] = c.w;
    a = *(const float4*)(P.lnx_b + c0); c = *(const float4*)(P.lnx_b + c0 + 4);
    lb[0] = a.x; lb[1] = a.y; lb[2] = a.z; lb[3] = a.w; lb[4] = c.x; lb[5] = c.y; lb[6] = c.z; lb[7] = c.w; }
#pragma unroll 2
  for (int tau = blockIdx.x * 4 + wid; tau < NPR; tau += gridDim.x * 4) {
    const bool first = (tau & 2047) == 0;
    float o[8], zv[8], pv[8], g[8];
    unpack8(*(const uint4*)(Oraw + (size_t)tau * 512 + c0), o);
    unpack8(*(const uint4*)(P.regZ + (size_t)tau * DIN + 1024 + c0), zv);
    unpack8(*(const uint4*)(P.regZ + (size_t)(first ? tau : tau - 1) * DIN + 1024 + c0), pv);
    unpack8(*(const uint4*)(Gg + (size_t)tau * 512 + c0), g);
    const float bon = P.bonus[(size_t)tau * 8 + hd];
    float sm = 0.f;
#pragma unroll
    for (int i = 0; i < 8; ++i) sm += o[i];
    sm += __shfl_xor(sm, 1, 64); sm += __shfl_xor(sm, 2, 64); sm += __shfl_xor(sm, 4, 64);
    const float mean = sm * (1.f / 64.f);
    float sq = 0.f;
#pragma unroll
    for (int i = 0; i < 8; ++i) { o[i] -= mean; sq += o[i] * o[i]; }
    sq += __shfl_xor(sq, 1, 64); sq += __shfl_xor(sq, 2, 64); sq += __shfl_xor(sq, 4, 64);
    const float rs = rsqrtf(sq * (1.f / 64.f) + 64e-5f);
    float y[8];
#pragma unroll
    for (int i = 0; i < 8; ++i) {
      float p = first ? 0.f : pv[i];
      float v = zv[i] + (p - zv[i]) * mu[i];
      y[i] = (o[i] * rs * lg[i] + lb[i] + bon * v) * g[i];
    }
    *(uint4*)(P.regY + (size_t)tau * 1024 + c0) = pack8(y);
  }
}

__device__ __forceinline__ int filler_rank(int nbusy_lr, int& nfill) {
  const int b = blockIdx.x;
  if (gridDim.x != 512) { nfill = gridDim.x; return b; }
  const int x = b & 7, lr = b >> 3;
  nfill = 512 - 4 * nbusy_lr;
  if (x < 4 && lr < nbusy_lr) return -1;
  const int busy_before = lr < nbusy_lr ? 4 * lr + 4 : 4 * nbusy_lr;
  return b - busy_before;
}

__device__ void phase4(const Params& P, char* smem, float* sred) {
  bfraw* sA = (bfraw*)smem; bfraw* sB = sA + 128 * LROW;
  bfraw* hb = P.regA;
  const int NG = 132 * 8, NCONV = 8192;
  for (int it = 0;; ++it) {
    {
      int rt, ct; if (!xcd_job(it, 8, 8, rt, ct)) break; int row0 = rt * 128, col0 = ct * 128;
      f32x4 acc[4][4]; ZERO_ACC(acc)
      gemm_main(acc, PlainLoad{P.regY + (size_t)row0 * 1024, 1024}, PlainLoad{P.Wt_out + (size_t)col0 * 1024, 1024}, 1024, sA, sB);
      float* sS = (float*)smem;
      acc_to_lds(acc, sS);
#pragma unroll 4
      for (int i = 0; i < 16; ++i) { SEG_VARS(i)
        int tau = row0 + row, c = col0 + c4;
        float4 xv = *(const float4*)(xrow(P, tau) + c);
        float4 h; h.x = xv.x + v.x; h.y = xv.y + v.y; h.z = xv.z + v.z; h.w = xv.w + v.w;
        *(float4*)(P.out + (size_t)tau * 1024 + c) = h;
        uint2 o; o.x = pack2(h.x, h.y); o.y = pack2(h.z, h.w);
        *(uint2*)(hb + (size_t)tau * 1024 + c) = o;
        float ss = h.x * h.x + h.y * h.y + h.z * h.z + h.w * h.w;
        ss += __shfl_xor(ss, 1, 64); ss += __shfl_xor(ss, 2, 64); ss += __shfl_xor(ss, 4, 64); ss += __shfl_xor(ss, 8, 64); ss += __shfl_xor(ss, 16, 64);
        if ((etid_ & 31) == 0) P.ssq1[(size_t)ct * NT + tau] = ss; }
    }
  }
  int nfill4; const int fr4 = filler_rank(8, nfill4);
  for (int job0 = NG + fr4 * 4; fr4 >= 0 && job0 < NG + NCONV; job0 += nfill4 * 4) {
    int job = job0;
    for (int jq = 0; jq < 4; ++jq, ++job) {
      size_t e0 = ((size_t)(job - NG) * 256 + threadIdx.x) * 16;
      const bool isu = e0 < (size_t)16777216;
      const float* src = isu ? P.peer_u + e0 : P.peer_v + (e0 - 16777216);
      const float sc = isu ? 256.f : 32.f;
      unsigned int wv[4];
#pragma unroll
      for (int q = 0; q < 4; ++q) {
        float4 a = *(const float4*)(src + q * 4);
        int wq = __builtin_amdgcn_cvt_pk_fp8_f32(a.x * sc, a.y * sc, 0, false);
        wq = __builtin_amdgcn_cvt_pk_fp8_f32(a.z * sc, a.w * sc, wq, true);
        wv[q] = (unsigned int)wq;
      }
      *(uint4*)((unsigned char*)P.regZ + e0) = make_uint4(wv[0], wv[1], wv[2], wv[3]);
    }
  }
}

struct PLoad {
  const Params* P; int row0;
  __device__ __forceinline__ uint4 operator()(int r, int k) const {
    int tau = row0 + r;
    const float* pr = (tau < NPR ? P->p_prompt + (size_t)tau * 256 : P->p_sample + (size_t)(tau - NPR) * 256) + k;
    float4 a = *(const float4*)pr, c = *(const float4*)(pr + 4);
    uint4 o; o.x = pack2(a.x, a.y); o.y = pack2(a.z, a.w); o.z = pack2(c.x, c.y); o.w = pack2(c.z, c.w); return o;
  }
};
#define TK_INS(x) { _Pragma("unroll") for (int i_ = 15; i_ > 0; --i_) s[i_] = __builtin_amdgcn_fmed3f(s[i_ - 1], s[i_], x); s[0] = fmaxf(s[0], x); }
__device__ void phase5(const Params& P, char* smem, float* sred) {
  bfraw* sA = (bfraw*)smem; bfraw* sB = sA + 128 * LROW;
  const bfraw* hb = P.regA; float* TK = (float*)P.regB;
  float* sS = (float*)smem;
  for (int it = 0;; ++it) {
    int rt, ct; if (!xcd_job(it, 16, 8, rt, ct)) break; int row0 = rt * 128, col0 = ct * 128;
    EPI_VARS
    if (tid < 128) {
      float s = 0.f;
#pragma unroll
      for (int c = 0; c < 8; ++c) s += P.ssq1[(size_t)c * NT + row0 + tid];
      sred[tid] = rsqrtf(s * (1.f / 1024.f) + 1e-6f);
    }
    f32x4 acc[4][4]; ZERO_ACC(acc)
    gemm_main<true>(acc, PlainLoad{hb + (size_t)row0 * 1024, 1024}, PlainLoad{P.Wt_q + (size_t)col0 * 1024, 1024}, 1024, sA, sB);
    EPI_LOOP { EPI_RC
      float v = acc[m][n][j] * sred[row];
      unsigned int bits = (__float_as_uint(v) & ~127u) | (unsigned)col;
      sS[row * 128 + (col ^ (row & 31))] = __uint_as_float(bits); }
    __syncthreads();
    int tk_ = threadIdx.x; asm volatile("" : "+v"(tk_));
    int r = tk_ & 127, q = tk_ >> 7;
    float s[16];
#pragma unroll
    for (int i = 0; i < 16; ++i) s[i] = -3.0e38f;
    for (int i = 0; i < 64; ++i) { float x = sS[r * 128 + ((q * 64 + i) ^ (r & 31))]; TK_INS(x) }
    __syncthreads();
    if (q == 1) {
#pragma unroll
      for (int i = 0; i < 16; ++i) sS[r * 17 + i] = s[i];
    }
    __syncthreads();
    if (q == 0) {
#pragma unroll
      for (int i = 0; i < 16; ++i) { float x = sS[r * 17 + i]; TK_INS(x) }
      float* dst = TK + (size_t)(row0 + r) * 256 + ct * 16;
#pragma unroll
      for (int i = 0; i < 4; ++i) *(float4*)(dst + i * 4) = make_float4(s[i * 4], s[i * 4 + 1], s[i * 4 + 2], s[i * 4 + 3]);
    }
    __syncthreads();
  }
  int nfill5; const int fr5 = filler_rank(16, nfill5);
  for (int job = fr5; fr5 >= 0 && job < 132 * 8; job += nfill5) {
    __syncthreads();
    int rt = job >> 3, ct = job & 7; int row0 = rt * 128, col0 = ct * 128;
    f32x4 acc[4][4]; ZERO_ACC(acc)
    gemm_main(acc, PLoad{&P, row0}, PlainLoad{P.Wt_ple + (size_t)col0 * 256, 256}, 256, sA, sB);
    acc_to_lds(acc, sS);
#pragma unroll 4
    for (int i = 0; i < 16; ++i) { SEG_VARS(i)
      uint2 o; o.x = pack2(v.x, v.y); o.y = pack2(v.z, v.w);
      *(uint2*)(P.regY + (size_t)(row0 + row) * 1024 + col0 + c4) = o; }
  }
}

typedef float f32x2 __attribute__((ext_vector_type(2)));
__device__ __forceinline__ float gelu_exact(float x) { return 0.5f * x * (1.f + erff(x * 0.70710678118f)); }
__device__ __forceinline__ float dot16_fp8(uint4 r, const f32x2 (&xn2)[8]) {
  f32x2 acc = __builtin_amdgcn_cvt_pk_f32_fp8((int)r.x, false) * xn2[0];
  acc += __builtin_amdgcn_cvt_pk_f32_fp8((int)r.x, true) * xn2[1];
  acc += __builtin_amdgcn_cvt_pk_f32_fp8((int)r.y, false) * xn2[2];
  acc += __builtin_amdgcn_cvt_pk_f32_fp8((int)r.y, true) * xn2[3];
  acc += __builtin_amdgcn_cvt_pk_f32_fp8((int)r.z, false) * xn2[4];
  acc += __builtin_amdgcn_cvt_pk_f32_fp8((int)r.z, true) * xn2[5];
  acc += __builtin_amdgcn_cvt_pk_f32_fp8((int)r.w, false) * xn2[6];
  acc += __builtin_amdgcn_cvt_pk_f32_fp8((int)r.w, true) * xn2[7];
  return acc.x + acc.y;
}
__device__ __forceinline__ void axpy16_fp8(uint4 r, float a, f32x2 (&o2)[8]) {
  f32x2 a2 = {a, a};
  o2[0] += a2 * __builtin_amdgcn_cvt_pk_f32_fp8((int)r.x, false);
  o2[1] += a2 * __builtin_amdgcn_cvt_pk_f32_fp8((int)r.x, true);
  o2[2] += a2 * __builtin_amdgcn_cvt_pk_f32_fp8((int)r.y, false);
  o2[3] += a2 * __builtin_amdgcn_cvt_pk_f32_fp8((int)r.y, true);
  o2[4] += a2 * __builtin_amdgcn_cvt_pk_f32_fp8((int)r.z, false);
  o2[5] += a2 * __builtin_amdgcn_cvt_pk_f32_fp8((int)r.z, true);
  o2[6] += a2 * __builtin_amdgcn_cvt_pk_f32_fp8((int)r.w, false);
  o2[7] += a2 * __builtin_amdgcn_cvt_pk_f32_fp8((int)r.w, true);
}
__device__ __forceinline__ float reduce8(const float (&p)[8], int lane) {
  float q[4], r[2], s;
  const bool b0 = lane & 1, b1 = lane & 2, b2 = lane & 4;
#pragma unroll
  for (int k = 0; k < 4; ++k) { float send = b0 ? p[k] : p[k + 4]; float keep = b0 ? p[k + 4] : p[k]; q[k] = keep + __shfl_xor(send, 1, 64); }
#pragma unroll
  for (int k = 0; k < 2; ++k) { float send = b1 ? q[k] : q[k + 2]; float keep = b1 ? q[k + 2] : q[k]; r[k] = keep + __shfl_xor(send, 2, 64); }
  { float send = b2 ? r[0] : r[1]; float keep = b2 ? r[1] : r[0]; s = keep + __shfl_xor(send, 4, 64); }
  s += __shfl_xor(s, 8, 64); s += __shfl_xor(s, 16, 64); s += __shfl_xor(s, 32, 64);
  return s;
}
#define PEER_LOAD(buf, tab, bt) _Pragma("unroll") for (int k_ = 0; k_ < 8; ++k_) { int e_ = __builtin_amdgcn_readfirstlane(sexp[(bt) * 8 + k_]); buf[k_] = *(const uint4*)(tab + (size_t)e_ * 1024 + lane * 16); }
#define PEER_UCOMP(buf, bt) { float p_[8]; _Pragma("unroll") for (int k_ = 0; k_ < 8; ++k_) p_[k_] = dot16_fp8(buf[k_], xn2); float s_ = reduce8(p_, lane); \
    if ((lane >> 3) == ((bt) & 7)) { if ((bt) < 8) d0 = s_; else d1 = s_; } }
#define PEER_VCOMP(buf, bt) { float asel_ = (bt) < 8 ? act0 : act1; _Pragma("unroll") for (int k_ = 0; k_ < 8; ++k_) { \
    const int br_ = ((k_ & 1) << 2) | (k_ & 2) | ((k_ >> 2) & 1); \
    float a_ = __uint_as_float((unsigned)__builtin_amdgcn_readlane((int)__float_as_uint(asel_), (((bt) & 7) << 3) | br_)); axpy16_fp8(buf[k_], a_, o2); } }

__device__ void peer_token(const Params& P, int tau, float* sw, bool dry = false) {
  const int lane = threadIdx.x & 63;
  float* scand = sw; int* sexp = (int*)(sw + 64); float* sgate = sw + 192;
  const unsigned char* U8 = (const unsigned char*)P.regZ; const unsigned char* V8 = U8 + (size_t)16777216;
  float* hrow = P.out + (size_t)tau * 1024;
  float x[16]; f32x2 xn2[8];
#pragma unroll
  for (int j = 0; j < 4; ++j) { float4 a = *(const float4*)(hrow + lane * 16 + j * 4); x[j * 4] = a.x; x[j * 4 + 1] = a.y; x[j * 4 + 2] = a.z; x[j * 4 + 3] = a.w; }
  float ss = 0.f;
#pragma unroll
  for (int i = 0; i < 16; ++i) ss += x[i] * x[i];
  ss = wsum(ss);
  const float rstd = rsqrtf(ss * (1.f / 1024.f) + 1e-6f) * (1.f / 256.f);
#pragma unroll
  for (int j = 0; j < 4; ++j) {
    float4 g = *(const float4*)(P.norm_ffn_g + lane * 16 + j * 4);
    xn2[j * 2] = f32x2{x[j * 4] * rstd * g.x, x[j * 4 + 1] * rstd * g.y};
    xn2[j * 2 + 1] = f32x2{x[j * 4 + 2] * rstd * g.z, x[j * 4 + 3] * rstd * g.w};
  }
  int ca, cb; { int c = lane;
    if (c < 16) { ca = 0; cb = c; } else if (c < 24) { ca = 1; cb = c - 16; } else if (c < 29) { ca = 2; cb = c - 24; }
    else if (c < 33) { ca = 3; cb = c - 29; } else if (c < 36) { ca = 4; cb = c - 33; } else if (c < 38) { ca = 5; cb = c - 36; }
    else if (c < 40) { ca = 6; cb = c - 38; } else if (c < 42) { ca = 7; cb = c - 40; } else if (c < 50) { ca = c - 34; cb = 0; } else { ca = 0; cb = 0; } }
  const float* tk = (const float*)P.regB + (size_t)tau * 256;
  for (int hh = 0; hh < 8; ++hh) {
    float k1 = tk[(hh * 2) * 16 + ca], k2 = tk[(hh * 2 + 1) * 16 + cb];
    float s = lane < 50 ? k1 + k2 : -3.0e38f;
    __builtin_amdgcn_wave_barrier();
    scand[lane] = s;
    __builtin_amdgcn_wave_barrier();
    int rank = 0;
#pragma unroll
    for (int c4 = 0; c4 < 13; ++c4) {
      float4 q = *(const float4*)(scand + c4 * 4);
      rank += (q.x > s || (q.x == s && c4 * 4 < lane)) ? 1 : 0;
      rank += (q.y > s || (q.y == s && c4 * 4 + 1 < lane)) ? 1 : 0;
      if (c4 < 12) { rank += (q.z > s || (q.z == s && c4 * 4 + 2 < lane)) ? 1 : 0; rank += (q.w > s || (q.w == s && c4 * 4 + 3 < lane)) ? 1 : 0; }
    }
    bool sel = lane < 50 && rank < 16;
    float mx = wmaxf(s);
    float e = sel ? __expf(s - mx) : 0.f;
    float Z = wsum(e);
    if (sel) { sexp[hh * 16 + rank] = (int)((__float_as_uint(k1) & 127u) * 128u + (__float_as_uint(k2) & 127u)); sgate[hh * 16 + rank] = e / Z; }
  }
  __builtin_amdgcn_wave_barrier();
  float d0 = 0.f, d1 = 0.f;
  uint4 A[8], B[8];
  PEER_LOAD(A, U8, 0)
  for (int b2 = 0; b2 < 8; ++b2) {
    PEER_LOAD(B, U8, 2 * b2 + 1)
    PEER_UCOMP(A, 2 * b2)
    if (b2 < 7) { PEER_LOAD(A, U8, 2 * b2 + 2) } else { PEER_LOAD(A, V8, 0) }
    PEER_UCOMP(B, 2 * b2 + 1)
  }
  const int slotA = (lane & ~7) | ((lane & 1) << 2) | (lane & 2) | ((lane >> 2) & 1);
  const float act0 = gelu_exact(d0) * sgate[slotA] * (1.f / 32.f), act1 = gelu_exact(d1) * sgate[64 + slotA] * (1.f / 32.f);
  f32x2 o2[8];
#pragma unroll
  for (int i = 0; i < 8; ++i) o2[i] = f32x2{0.f, 0.f};
  for (int b2 = 0; b2 < 8; ++b2) {
    PEER_LOAD(B, V8, 2 * b2 + 1)
    PEER_VCOMP(A, 2 * b2)
    if (b2 < 7) { PEER_LOAD(A, V8, 2 * b2 + 2) }
    PEER_VCOMP(B, 2 * b2 + 1)
  }
  float o[16]; float s2 = 0.f;
#pragma unroll
  for (int i = 0; i < 8; ++i) { o[2 * i] = x[2 * i] + o2[i].x; o[2 * i + 1] = x[2 * i + 1] + o2[i].y; }
#pragma unroll
  for (int i = 0; i < 16; ++i) s2 += o[i] * o[i];
  s2 = wsum(s2);
  if (dry) { if (s2 == 123.456f) P.rstd2[tau] = s2; return; }
  if (lane == 0) P.rstd2[tau] = rsqrtf(s2 * (1.f / 1024.f) + 1e-6f);
  bfraw* hb = P.regA + (size_t)tau * 1024;
#pragma unroll
  for (int j = 0; j < 4; ++j) *(float4*)(hrow + lane * 16 + j * 4) = make_float4(o[j * 4], o[j * 4 + 1], o[j * 4 + 2], o[j * 4 + 3]);
  *(uint4*)(hb + lane * 16) = pack8(o); *(uint4*)(hb + lane * 16 + 8) = pack8(o + 8);
}

__device__ void phase6(const Params& P, char* smem, bool dry = false) {
  const int wid = threadIdx.x >> 6;
  float* sw = (float*)smem + wid * 320;
  for (int tau = blockIdx.x * 4 + wid; tau < NT; tau += gridDim.x * 4) peer_token(P, tau, sw, dry);
}

__device__ void phase7(const Params& P, char* smem, float* sred) {
  bfraw* sA = (bfraw*)smem; bfraw* sB = sA + 128 * LROW;
  const bfraw* hb = P.regA;
  for (int it = 0;; ++it) {
    int rt, ct; if (!xcd_job(it, 8, 8, rt, ct)) break; int row0 = rt * 128, col0 = ct * 128;
    f32x4 acc[4][4]; ZERO_ACC(acc)
    float* sS = (float*)smem;
    gemm_main(acc, PlainLoad{hb + (size_t)row0 * 1024, 1024}, PlainLoad{P.Wt_pg + (size_t)col0 * 1024, 1024}, 1024, sA, sB);
    acc_to_lds(acc, sS);
#pragma unroll 2
    for (int i = 0; i < 16; ++i) { SEG_VARS(i)
      int tau = row0 + row, c = col0 + c4;
      float rs = P.rstd2[tau];
      float4 hv = *(float4*)(P.out + (size_t)tau * 1024 + c);
      uint2 ep = *(const uint2*)(P.regY + (size_t)tau * 1024 + c);
      hv.x += __uint_as_float(ep.x << 16) * sigmoidf_(v.x * rs);
      hv.y += __uint_as_float(ep.x & 0xffff0000u) * sigmoidf_(v.y * rs);
      hv.z += __uint_as_float(ep.y << 16) * sigmoidf_(v.z * rs);
      hv.w += __uint_as_float(ep.y & 0xffff0000u) * sigmoidf_(v.w * rs);
      *(float4*)(P.out + (size_t)tau * 1024 + c) = hv;
      float ss = hv.x * hv.x + hv.y * hv.y + hv.z * hv.z + hv.w * hv.w;
      ss += __shfl_xor(ss, 1, 64); ss += __shfl_xor(ss, 2, 64); ss += __shfl_xor(ss, 4, 64); ss += __shfl_xor(ss, 8, 64); ss += __shfl_xor(ss, 16, 64);
      if ((etid_ & 31) == 0) P.ssq3[(size_t)ct * NT + tau] = ss; }
  }
}

__device__ void phase8(const Params& P) {
  for (int job = blockIdx.x; job < NT; job += gridDim.x) {
    int tau = job; int c = threadIdx.x * 4;
    float s = 0.f;
#pragma unroll
    for (int i = 0; i < 8; ++i) s += P.ssq3[(size_t)i * NT + tau];
    float rs = rsqrtf(s * (1.f / 1024.f) + 1e-6f);
    float4 v = *(float4*)(P.out + (size_t)tau * 1024 + c); float4 g = *(const float4*)(P.final_norm_g + c);
    v.x *= rs * g.x; v.y *= rs * g.y; v.z *= rs * g.z; v.w *= rs * g.w;
    *(float4*)(P.out + (size_t)tau * 1024 + c) = v;
  }
}


#define XB_TMO      128
#define XB_XCNT(j)  (256  + 64 * (j))
#define XB_XSUB(j)  (1280 + 64 * (j))
#define XB_XGEN(j)  (2304 + 64 * (j))
#define XB_TOP      3328
#define XB_TOPGEN   3392
#define XCD_BAR_WORDS 3456
#define XB_SPIN_CAP (1u << 18)
#define LAS __attribute__((address_space(3)))
__device__ __forceinline__ unsigned xb_ld(unsigned* p)              { return __hip_atomic_load(p, __ATOMIC_RELAXED, __HIP_MEMORY_SCOPE_AGENT); }
__device__ __forceinline__ unsigned xb_add(unsigned* p, unsigned v) { return __hip_atomic_fetch_add(p, v, __ATOMIC_RELAXED, __HIP_MEMORY_SCOPE_AGENT); }
__device__ __forceinline__ unsigned xb_xcc_id() { return (unsigned)__builtin_amdgcn_s_getreg((3 << 11) | 20) & 0xFu; }
#define XB_SPIN(cond, bar) do { unsigned _sp = 0; while (cond) { __builtin_amdgcn_s_sleep(1); \
    if ((++_sp & 255u) == 0u) { if (xb_ld(&(bar)[XB_TMO])) break; if (_sp > XB_SPIN_CAP) { atomicAdd(&(bar)[XB_TMO], 1u); break; } } } } while (0)
struct XcdBarrier { unsigned* bar; unsigned x; volatile LAS unsigned* st; };
__device__ __forceinline__ XcdBarrier xcd_barrier_post(unsigned* bar, volatile LAS unsigned* st) {
    XcdBarrier b; b.bar = bar; b.x = xb_xcc_id(); b.st = st;
    if (threadIdx.x == 0) (void)xb_add(&bar[XB_XCNT(b.x)], 1u);
    return b;
}
__device__ __forceinline__ void xcd_barrier_complete(unsigned* bar, unsigned x, unsigned& nloc, unsigned& nx) {
    const unsigned G = gridDim.x * gridDim.y * gridDim.z;
    unsigned sum, cnt, mine, sp = 0u;
    for (;;) {
        sum = 0u; cnt = 0u; mine = 0u;
#pragma unroll
        for (unsigned j = 0; j < 16; ++j) { const unsigned c = xb_ld(&bar[XB_XCNT(j)]); sum += c; cnt += (c > 0u) ? 1u : 0u; mine = (j == x) ? c : mine; }
        if (sum == G) break;
        __builtin_amdgcn_s_sleep(1);
        if ((++sp & 255u) == 0u) { if (xb_ld(&bar[XB_TMO])) break; if (sp > XB_SPIN_CAP) { atomicAdd(&bar[XB_TMO], 1u); break; } }
    }
    nloc = mine > 0u ? mine : 1u; nx = cnt > 0u ? cnt : 1u;
}
__device__ __forceinline__ void xcd_barrier(const XcdBarrier& b) {
    asm volatile("s_waitcnt vmcnt(0)" ::: "memory");
    __syncthreads();
    if (threadIdx.x == 0) {
        unsigned* bar = b.bar;
        __builtin_amdgcn_s_waitcnt(0);
        unsigned nloc = b.st[0], nx = b.st[1];
        if (nloc == 0u) { xcd_barrier_complete(bar, b.x, nloc, nx); b.st[0] = nloc; b.st[1] = nx; }
        const unsigned old = xb_add(&bar[XB_XSUB(b.x)], 1u);
        const unsigned gen = old / nloc;
        if (old + 1u == (gen + 1u) * nloc) {
            __builtin_amdgcn_fence(__ATOMIC_RELEASE, "agent");
            asm volatile("s_waitcnt vmcnt(0)" ::: "memory");
            const unsigned og = xb_add(&bar[XB_TOP], 1u);
            const unsigned tg = og / nx;
            if (og + 1u == (tg + 1u) * nx) xb_add(&bar[XB_TOPGEN], 1u);
            else XB_SPIN(xb_ld(&bar[XB_TOPGEN]) == tg, bar);
            __builtin_amdgcn_fence(__ATOMIC_ACQUIRE, "agent");
            xb_add(&bar[XB_XGEN(b.x)], 1u);
            asm volatile("s_waitcnt vmcnt(0)" ::: "memory");
        } else {
            XB_SPIN(xb_ld(&bar[XB_XGEN(b.x)]) == gen, bar);
            __builtin_amdgcn_fence(__ATOMIC_ACQUIRE, "agent");
            asm volatile("s_waitcnt vmcnt(0)" ::: "memory");
        }
    }
    __syncthreads();
}

__global__ void __launch_bounds__(256, 2) mega(Params P) {
  __shared__ __attribute__((aligned(16))) char smem[65536];
  __shared__ float sred[256];
  cg::grid_group grid = cg::this_grid();
  __shared__ uint4 xb_words;
  if (threadIdx.x == 0) xb_words = make_uint4(0u, 0u, 0u, 0u);
  __syncthreads();
  XcdBarrier xb = xcd_barrier_post(P.bar, (volatile LAS unsigned*)&xb_words);
  if (P.phase_hi > 1000) grid.sync();
#ifndef REPMASK
#define REPMASK 0
#endif
#define RUNPH(n, call) if (P.phase_lo <= n && n < P.phase_hi) { call; if ((REPMASK >> n) & 1) { call; } if (n + 1 < P.phase_hi) xcd_barrier(xb); }
  RUNPH(0, phase0(P, smem))
  RUNPH(1, phase1(P, smem))
  RUNPH(2, phase2(P, smem))
  RUNPH(3, phase3a(P, smem))
  RUNPH(4, phase3x(P, smem))
  RUNPH(5, phase3b(P, smem, sred))
  RUNPH(6, phase3c(P))
  RUNPH(7, phase4(P, smem, sred))
  RUNPH(8, phase5(P, smem, sred))
  RUNPH(9, phase6(P, smem))
  RUNPH(10, phase7(P, smem, sred))
  RUNPH(11, phase8(P))
}

extern "C" void kernel_launch(void* const* d_in, const int* in_sizes, int n_in, void* d_out, int out_size, void* d_ws, size_t ws_size,
                              hipStream_t stream) {
  static int grid_blocks = 0;
  if (!grid_blocks) {
    int dev = 0, cus = 0, per_cu = 0;
    hipGetDevice(&dev);
    hipDeviceGetAttribute(&cus, hipDeviceAttributeMultiprocessorCount, dev);
    hipOccupancyMaxActiveBlocksPerMultiprocessor(&per_cu, mega, 256, 0);
    if (per_cu > 2) per_cu = 2;
    grid_blocks = cus * per_cu;
  }
  Params P{};
  const float** pf = (const float**)&P;
  for (int i = 0; i < 32; ++i) pf[i] = (const float*)d_in[i];
  P.out = (float*)d_out;
  char* w = (char*)d_ws; size_t off = 0;
  auto take = [&](size_t bytes) { char* p = w + off; off += (bytes + 255) & ~(size_t)255; return p; };
  P.Wt_in = (bfraw*)take((size_t)2304 * LDP * 2);
  P.Wt_out = (bfraw*)take((size_t)1024 * 1024 * 2);
  P.Wt_q = (bfraw*)take((size_t)2048 * 1024 * 2);
  P.Wt_pg = (bfraw*)take((size_t)1024 * 1024 * 2);
  P.Wt_ple = (bfraw*)take((size_t)1024 * 256 * 2);
  P.Wt_dec = (bfraw*)take((size_t)512 * 64 * 2);
  P.Wt_a = (bfraw*)take((size_t)512 * 64 * 2);
  P.Wt_g = (bfraw*)take((size_t)512 * 128 * 2);
  P.Wt_pool = (bfraw*)take((size_t)4 * 128 * 128 * 2);
  P.ssq1 = (float*)take((size_t)8 * NT * 4);
  P.rstd2 = (float*)take((size_t)NT * 4);
  P.ssq3 = (float*)take((size_t)8 * NT * 4);
  P.Sbuf = P.ssq1;
  P.regA = (bfraw*)take((size_t)NT * LDP * 2);
  P.regB = (bfraw*)take((size_t)NT * 1024 * 2);
  P.regY = (bfraw*)take((size_t)NT * 1024 * 2);
  P.bar = (unsigned*)take((size_t)4096 * 4);
  P.bonus = (float*)take((size_t)NPR * 8 * 4);
  P.regPQ = (bfraw*)take((size_t)4096 * 12288);
  P.regP = (bfraw*)take((size_t)NT * 512 * 2);
  P.regZ = (bfraw*)take((size_t)NT * 2304 * 2);
  P.phase_lo = 0; P.phase_hi = 12;
  hipMemsetAsync(P.bar, 0, 4096 * 4, stream);
  void* args[] = {&P};
  hipError_t e = hipLaunchCooperativeKernel((void*)mega, dim3(grid_blocks), dim3(256), args, 0, stream);
  if (e != hipSuccess) fprintf(stderr, "cooperative launch failed: %s (grid %d)\n", hipGetErrorString(e), grid_blocks);
}
```

```cpp
#include <hip/hip_runtime.h>
#include <hip/hip_bf16.h>
#include <hip/hip_cooperative_groups.h>
#include <stdint.h>
#include <cstdio>
namespace cg = cooperative_groups;

typedef __attribute__((ext_vector_type(8))) short bf16x8;
typedef __attribute__((ext_vector_type(4))) float f32x4;
typedef unsigned short bfraw;

#define NT 16896
#define NPR 16384
#define DM 1024
#define DIN 2304
#define DSH 1792
#define LDP 1088

struct Params {
  const float *x_prompt, *x_sample, *state_shift, *state_wkv, *state_pool, *p_prompt, *p_sample;
  const float *norm_mix_g, *w_in, *shift_mu, *decay_w0, *decay_b, *a_0, *a_b, *g_b, *k_k, *k_a, *r_k;
  const float *lnx_g, *lnx_b, *pool_w, *pool_scale, *w_out, *norm_ffn_g, *peer_wq, *peer_keys;
  const float *peer_u, *peer_v, *norm_ple_g, *ple_w, *ple_gate_w, *final_norm_g;
  float* out;
  bfraw *Wt_in, *Wt_out, *Wt_q, *Wt_pg, *Wt_ple, *Wt_dec, *Wt_a, *Wt_g, *Wt_pool;
  float *ssq1, *rstd2, *ssq3, *bonus, *Sbuf;
  unsigned* bar;
  bfraw *regPQ;
  bfraw *regA;
  bfraw *regB;
  bfraw *regY;
  bfraw *regP;
  bfraw *regZ;
  int phase_lo, phase_hi;
};

#define O_Y 0
#define O_SHP 17301504
#define O_WKP 17315840
#define O_POP 17577984
#define O_SHS 17639424
#define O_WKS 17868800
#define O_POS 22063104

typedef float f32x2_ __attribute__((ext_vector_type(2)));
typedef __bf16 bf16x2_t __attribute__((ext_vector_type(2)));
__device__ __forceinline__ unsigned int pack2(float a, float b) {
  f32x2_ v = {a, b};
  bf16x2_t r = __builtin_convertvector(v, bf16x2_t);
  return __builtin_bit_cast(unsigned int, r);
}
__device__ __forceinline__ unsigned short f2bf(float f) { return (unsigned short)(pack2(f, 0.f) & 0xffffu); }
__device__ __forceinline__ float bf2f(unsigned short h) { return __uint_as_float(((unsigned int)h) << 16); }
__device__ __forceinline__ void unpack8(uint4 v, float* f) {
  f[0] = __uint_as_float(v.x << 16); f[1] = __uint_as_float(v.x & 0xffff0000u);
  f[2] = __uint_as_float(v.y << 16); f[3] = __uint_as_float(v.y & 0xffff0000u);
  f[4] = __uint_as_float(v.z << 16); f[5] = __uint_as_float(v.z & 0xffff0000u);
  f[6] = __uint_as_float(v.w << 16); f[7] = __uint_as_float(v.w & 0xffff0000u);
}
__device__ __forceinline__ uint4 pack8(const float* f) {
  uint4 v; v.x = pack2(f[0], f[1]); v.y = pack2(f[2], f[3]); v.z = pack2(f[4], f[5]); v.w = pack2(f[6], f[7]); return v;
}
__device__ __forceinline__ float wsum(float v) {
#pragma unroll
  for (int o = 32; o > 0; o >>= 1) v += __shfl_xor(v, o, 64);
  return v;
}
__device__ __forceinline__ float wmaxf(float v) {
#pragma unroll
  for (int o = 32; o > 0; o >>= 1) v = fmaxf(v, __shfl_xor(v, o, 64));
  return v;
}
__device__ __forceinline__ float sigmoidf_(float x) { return 1.f / (1.f + __expf(-x)); }

#define LROW 80
template <bool SEQ = false, class AL, class BL>
__device__ __forceinline__ void gemm_main(f32x4 (&acc)[4][4], AL aload, BL bload, int K, bfraw* sA, bfraw* sB) {
  int tid0_ = threadIdx.x; asm volatile("" : "+v"(tid0_));
  const int tid = tid0_, lane = tid & 63, wid = tid >> 6, wr = wid >> 1, wc = wid & 1, fr = lane & 15, fq = lane >> 4;
  uint4 ra0[4], rb0[4], ra1[4], rb1[4];
#define G_LOAD(ra_, rb_, kk_) _Pragma("unroll") for (int i = 0; i < 4; ++i) { int ch = tid + 256 * i; ra_[i] = aload(ch >> 3, (kk_) + (ch & 7) * 8); rb_[i] = bload(ch >> 3, (kk_) + (ch & 7) * 8); if (SEQ) __builtin_amdgcn_sched_barrier(0); }
#define G_STORE(ra_, rb_) _Pragma("unroll") for (int i = 0; i < 4; ++i) { int ch = tid + 256 * i; int r = ch >> 3, c = (ch & 7) * 8; *(uint4*)(sA + r * LROW + c) = ra_[i]; *(uint4*)(sB + r * LROW + c) = rb_[i]; }
#define G_COMPUTE _Pragma("unroll") for (int kk = 0; kk < 2; ++kk) { bf16x8 af[4], bfr[4]; \
        _Pragma("unroll") for (int m = 0; m < 4; ++m) af[m] = *(const bf16x8*)(sA + (wr * 64 + m * 16 + fr) * LROW + kk * 32 + fq * 8); \
        _Pragma("unroll") for (int n = 0; n < 4; ++n) bfr[n] = *(const bf16x8*)(sB + (wc * 64 + n * 16 + fr) * LROW + kk * 32 + fq * 8); \
      __builtin_amdgcn_s_setprio(1); \
      _Pragma("unroll") for (int m = 0; m < 4; ++m) _Pragma("unroll") for (int n = 0; n < 4; ++n) \
        acc[m][n] = __builtin_amdgcn_mfma_f32_16x16x32_bf16(af[m], bfr[n], acc[m][n], 0, 0, 0); \
      __builtin_amdgcn_s_setprio(0); }
  G_LOAD(ra0, rb0, 0)
  if (SEQ) {
#pragma unroll 1
    for (int k0 = 0; k0 < K; k0 += 64) {
      __syncthreads();
      G_STORE(ra0, rb0)
      __syncthreads();
      if (k0 + 64 < K) { G_LOAD(ra0, rb0, k0 + 64) }
      G_COMPUTE
    }
    __syncthreads();
    return;
  }
  if (K > 64) { G_LOAD(ra1, rb1, 64) }
#pragma unroll 1
  for (int k0 = 0; k0 < K; k0 += 128) {
    __syncthreads();
    G_STORE(ra0, rb0)
    __syncthreads();
    if (k0 + 128 < K) { G_LOAD(ra0, rb0, k0 + 128) }
    G_COMPUTE
    if (k0 + 64 < K) {
      __syncthreads();
      G_STORE(ra1, rb1)
      __syncthreads();
      if (k0 + 192 < K) { G_LOAD(ra1, rb1, k0 + 192) }
      G_COMPUTE
    }
  }
  __syncthreads();
}
#define ZERO_ACC(acc) _Pragma("unroll") for (int m_ = 0; m_ < 4; ++m_) _Pragma("unroll") for (int n_ = 0; n_ < 4; ++n_) acc[m_][n_] = f32x4{0.f, 0.f, 0.f, 0.f};
#define EPI_VARS const int tid = threadIdx.x, lane = tid & 63, wid = tid >> 6, wr = wid >> 1, wc = wid & 1, fr = lane & 15, fq = lane >> 4; (void)tid;
#define EPI_LOOP _Pragma("unroll") for (int m = 0; m < 4; ++m) _Pragma("unroll") for (int n = 0; n < 4; ++n) _Pragma("unroll") for (int j = 0; j < 4; ++j)
#define EPI_RC const int row = wr * 64 + m * 16 + fq * 4 + j, col = wc * 64 + n * 16 + fr;

__device__ __forceinline__ int swz(int row, int col) { return row * 128 + (col ^ (((row >> 2) & 1) << 4)); }
__device__ __forceinline__ int acc_to_lds_(const f32x4 (&acc)[4][4], float* sS) {
  EPI_VARS
  EPI_LOOP { EPI_RC sS[swz(row, col)] = acc[m][n][j]; }
  __syncthreads();
  int t_ = threadIdx.x; asm volatile("" : "+v"(t_));
  return t_;
}
#define acc_to_lds(acc, sS) const int etid_ = acc_to_lds_(acc, sS);
#define SEG_VARS(i_) const int idx_ = etid_ + 256 * (i_); const int row = idx_ >> 5, c4 = (idx_ & 31) * 4; const float4 v = *(const float4*)(sS + swz(row, c4));

__device__ __forceinline__ bool xcd_job(int it, int nct, int G, int& rt, int& ct) {
  const int x = blockIdx.x & 7, lr = blockIdx.x >> 3, nl = gridDim.x >> 3;
  const int j = lr + it * nl;
  const int nrt = (132 - x + 7) >> 3;
  if (j >= nrt * nct) return false;
  const int per = nrt * G; const int grp = j / per, rem = j - grp * per;
  rt = (rem / G) * 8 + x; ct = grp * G + rem % G;
  return true;
}

struct PlainLoad {
  const bfraw* base; int ld;
  __device__ __forceinline__ uint4 operator()(int r, int k) const { return *(const uint4*)(base + (size_t)r * ld + k); }
};

__device__ __forceinline__ void row_ssq_store(float (&ps)[4][4], float* sred, float* dst  ) {
  EPI_VARS
#pragma unroll
  for (int m = 0; m < 4; ++m)
#pragma unroll
    for (int j = 0; j < 4; ++j) {
      float v = ps[m][j];
      v += __shfl_xor(v, 1, 64); v += __shfl_xor(v, 2, 64); v += __shfl_xor(v, 4, 64); v += __shfl_xor(v, 8, 64);
      if (fr == 0) sred[wc * 128 + wr * 64 + m * 16 + fq * 4 + j] = v;
    }
  __syncthreads();
  if (tid < 128) dst[tid] = sred[tid] + sred[128 + tid];
  __syncthreads();
}

__device__ __forceinline__ void transpose_tile(const float* src, int R, int C, bfraw* dst, const float* scale, int tile, float* sT, int dld = 0) {
  if (dld == 0) dld = R;
  int tc = C / 64; int tk = tile / tc, tn = tile % tc; int k0 = tk * 64, n0 = tn * 64;
  int tid = threadIdx.x, c = tid & 63, r0 = tid >> 6;
  __syncthreads();
  for (int i = 0; i < 16; ++i) { int r = r0 + 4 * i; sT[r * 65 + c] = src[(size_t)(k0 + r) * C + n0 + c]; }
  __syncthreads();
  float sc = scale ? scale[k0 + c] : 1.f;
  for (int i = 0; i < 16; ++i) { int r = r0 + 4 * i; dst[(size_t)(n0 + r) * dld + k0 + c] = f2bf(sT[c * 65 + r] * sc); }
}

__device__ __forceinline__ void fold_job(const Params& P, int job, float* sm) {
  int hp = job >> 5, rem = job & 31, kt = rem >> 1, keyt = rem & 1;
  int p = hp & 1;
  float* sK = sm; float* sW = sm + 64 * 65;
  int tid = threadIdx.x, tx = tid & 15, ty = tid >> 4;
  float acc[4][4];
#pragma unroll
  for (int i = 0; i < 4; ++i)
#pragma unroll
    for (int j = 0; j < 4; ++j) acc[i][j] = 0.f;
  for (int ch = 0; ch < 2; ++ch) {
    __syncthreads();
    int c = tid & 63, r0 = tid >> 6;
    for (int i = 0; i < 16; ++i) {
      int r = r0 + 4 * i;
      sK[r * 65 + c] = P.peer_keys[((size_t)p * 128 + keyt * 64 + r) * 128 + ch * 64 + c];
      sW[r * 65 + c] = P.peer_wq[(size_t)(kt * 64 + r) * 2048 + hp * 128 + ch * 64 + c];
    }
    __syncthreads();
    for (int cc = 0; cc < 64; ++cc) {
      float kv[4], wv[4];
#pragma unroll
      for (int i = 0; i < 4; ++i) { kv[i] = sK[(ty * 4 + i) * 65 + cc]; wv[i] = sW[(tx * 4 + i) * 65 + cc]; }
#pragma unroll
      for (int i = 0; i < 4; ++i)
#pragma unroll
        for (int j = 0; j < 4; ++j) acc[i][j] += kv[i] * wv[j];
    }
  }
#pragma unroll
  for (int i = 0; i < 4; ++i) {
    int key = keyt * 64 + ty * 4 + i; int k = kt * 64 + tx * 4;
    float g0 = P.norm_ffn_g[k], g1 = P.norm_ffn_g[k + 1], g2 = P.norm_ffn_g[k + 2], g3 = P.norm_ffn_g[k + 3];
    uint2 v; v.x = pack2(acc[i][0] * g0, acc[i][1] * g1); v.y = pack2(acc[i][2] * g2, acc[i][3] * g3);
    *(uint2*)(P.Wt_q + (size_t)(hp * 128 + key) * 1024 + k) = v;
  }
}

__device__ __forceinline__ const float* xrow(const Params& P, int tau) {
  return tau < NPR ? P.x_prompt + (size_t)tau * 1024 : P.x_sample + (size_t)(tau - NPR) * 1024;
}

__device__ __forceinline__ void prep_transpose(const Params& P, int t, float* sT) {
  if (t < 576) transpose_tile(P.w_in, 1024, 2304, P.Wt_in, nullptr, t, sT, LDP);
  else if (t < 832) transpose_tile(P.w_out, 1024, 1024, P.Wt_out, nullptr, t - 576, sT);
  else if (t < 1088) transpose_tile(P.ple_gate_w, 1024, 1024, P.Wt_pg, P.norm_ple_g, t - 832, sT);
  else if (t < 1152) transpose_tile(P.ple_w, 256, 1024, P.Wt_ple, nullptr, t - 1088, sT);
  else if (t < 1160) transpose_tile(P.decay_b, 64, 512, P.Wt_dec, nullptr, t - 1152, sT);
  else if (t < 1168) transpose_tile(P.a_b, 64, 512, P.Wt_a, nullptr, t - 1160, sT);
  else if (t < 1184) transpose_tile(P.g_b, 128, 512, P.Wt_g, nullptr, t - 1168, sT);
  else { int u = t - 1184; int gi = u >> 2; transpose_tile(P.pool_w + gi * 16384, 128, 128, P.Wt_pool + gi * 16384, nullptr, u & 3, sT); }
}
__device__ __forceinline__ void late_prep_job(const Params& P, int job, char* smem) {
  if (job < 576) prep_transpose(P, 576 + job, (float*)smem);
  else fold_job(P, job - 576, (float*)smem);
}
#define N_LATE_PREP 1088

__device__ __forceinline__ void phase0(const Params& P, char* smem) {
  const int NJ_RMS = NT / 4, NJ_TR = 576 + 48, NJ_POOLCP = 704;
  const int total = NJ_RMS + NJ_TR + NJ_POOLCP;
  int tid = threadIdx.x, lane = tid & 63, wid = tid >> 6;
  for (int job = blockIdx.x; job < total; job += gridDim.x) {
    if (job < NJ_RMS) {
      int tau = job * 4 + wid;
      const float* xr = xrow(P, tau);
      float4 v[4]; float ss = 0.f;
#pragma unroll
      for (int j = 0; j < 4; ++j) { v[j] = *(const float4*)(xr + lane * 4 + 256 * j); ss += v[j].x * v[j].x + v[j].y * v[j].y + v[j].z * v[j].z + v[j].w * v[j].w; }
      ss = wsum(ss);
      float rs = rsqrtf(ss * (1.f / 1024.f) + 1e-6f);
#pragma unroll
      for (int j = 0; j < 4; ++j) {
        float4 g = *(const float4*)(P.norm_mix_g + lane * 4 + 256 * j);
        uint2 o; o.x = pack2(v[j].x * rs * g.x, v[j].y * rs * g.y); o.y = pack2(v[j].z * rs * g.z, v[j].w * rs * g.w);
        *(uint2*)(P.regA + (size_t)tau * LDP + lane * 4 + 256 * j) = o;
      }
    } else if (job < NJ_RMS + NJ_TR) {
      int t = job - NJ_RMS;
      prep_transpose(P, t < 576 ? t : 1152 + (t - 576), (float*)smem);
    } else {
      int e0 = (job - NJ_RMS - NJ_TR) * 1024 + tid * 4;
      if (e0 < 128 * 11 * 512) {
        int b = e0 / (11 * 512), rem = e0 % (11 * 512), j = rem / 512, c = rem % 512;
        float4 v = *(const float4*)(P.state_pool + ((size_t)b * 15 + j + 4) * 512 + c);
        *(float4*)(P.out + O_POS + ((size_t)b * 15 + j) * 512 + c) = v;
      }
    }
  }
}

__device__ __forceinline__ void phase1(const Params& P, char* smem) {
  bfraw* sA = (bfraw*)smem; bfraw* sB = sA + 128 * LROW;
  const int nct = DIN / 128;
  for (int it = 0;; ++it) {
    int rt, ct; if (!xcd_job(it, nct, 9, rt, ct)) break; int row0 = rt * 128, col0 = ct * 128;
    f32x4 acc[4][4]; ZERO_ACC(acc)
    gemm_main(acc, PlainLoad{P.regA + (size_t)row0 * LDP, LDP}, PlainLoad{P.Wt_in + (size_t)col0 * LDP, LDP}, 1024, sA, sB);
    float* sS = (float*)smem;
    acc_to_lds(acc, sS);
#pragma unroll 4
    for (int i = 0; i < 16; ++i) {
      SEG_VARS(i)
      int tau = row0 + row, c = col0 + c4;
      uint2 o; o.x = pack2(v.x, v.y); o.y = pack2(v.z, v.w);
      *(uint2*)(P.regZ + (size_t)tau * DIN + c) = o;
      if (tau < NPR) {
        int t = tau & 2047, b = tau >> 11;
        if (c < DSH) { if (t == 2047) *(float4*)(P.out + O_SHP + b * DSH + c) = v; }
        else if (t >= 2033) *(float4*)(P.out + O_POP + ((size_t)b * 15 + (t - 2033)) * 512 + (c - DSH)) = v;
      } else {
        int s = tau - NPR, b = s >> 2, t = s & 3;
        if (c < DSH) { if (t == 3) *(float4*)(P.out + O_SHS + b * DSH + c) = v; }
        else *(float4*)(P.out + O_POS + ((size_t)b * 15 + 11 + t) * 512 + (c - DSH)) = v;
      }
    }
  }
}

struct LoraLoad {
  const Params* P; int row0; int cb; int mode;
  __device__ __forceinline__ uint4 operator()(int r, int k) const {
    int tau = row0 + r; int zc = cb + k;
    float z[8], zp[8];
    unpack8(*(const uint4*)(P->regZ + (size_t)tau * DIN + zc), z);
    bool first; int b;
    if (tau < NPR) { first = (tau & 2047) == 0; b = 0; } else { int s = tau - NPR; first = (s & 3) == 0; b = s >> 2; }
    if (!first) unpack8(*(const uint4*)(P->regZ + (size_t)(tau - 1) * DIN + zc), zp);
    else if (tau < NPR) { for (int i = 0; i < 8; ++i) zp[i] = 0.f; }
    else {
      float4 a = *(const float4*)(P->state_shift + (size_t)b * DSH + zc), c = *(const float4*)(P->state_shift + (size_t)b * DSH + zc + 4);
      zp[0] = a.x; zp[1] = a.y; zp[2] = a.z; zp[3] = a.w; zp[4] = c.x; zp[5] = c.y; zp[6] = c.z; zp[7] = c.w;
    }
    float4 m0 = *(const float4*)(P->shift_mu + zc), m1 = *(const float4*)(P->shift_mu + zc + 4);
    float mu[8] = {m0.x, m0.y, m0.z, m0.w, m1.x, m1.y, m1.z, m1.w};
    float o[8];
#pragma unroll
    for (int i = 0; i < 8; ++i) {
      float zs = z[i] + (zp[i] - z[i]) * mu[i];
      o[i] = mode == 0 ? (1.f - 2.f / (1.f + __expf(2.f * zs))) : (mode == 1 ? zs : sigmoidf_(zs));
    }
    return pack8(o);
  }
};

struct PoolLoad {
  const Params* P; int row0; int gi;
  __device__ __forceinline__ uint4 operator()(int r, int k) const {
    int tau = row0 + r; int pc = gi * 128 + k; int zc = DSH + pc; int w = 2 << gi;
    float u[8], s[8], t8[8];
    unpack8(*(const uint4*)(P->regZ + (size_t)tau * DIN + zc), u);
#pragma unroll
    for (int i = 0; i < 8; ++i) s[i] = u[i];
    float cnt;
    if (tau < NPR) {
      int t = tau & 2047; int nv = min(t + 1, w); cnt = (float)nv;
      for (int d = 1; d < nv; ++d) {
        unpack8(*(const uint4*)(P->regZ + (size_t)(tau - d) * DIN + zc), t8);
#pragma unroll
        for (int i = 0; i < 8; ++i) s[i] += t8[i];
      }
    } else {
      int sidx = tau - NPR, b = sidx >> 2, t = sidx & 3; cnt = (float)w;
      for (int d = 1; d < w; ++d) {
        if (t - d >= 0) unpack8(*(const uint4*)(P->regZ + (size_t)(tau - d) * DIN + zc), t8);
        else {
          const float* sp = P->state_pool + ((size_t)b * 15 + (15 + t - d)) * 512 + pc;
          float4 a = *(const float4*)sp, c = *(const float4*)(sp + 4);
          t8[0] = a.x; t8[1] = a.y; t8[2] = a.z; t8[3] = a.w; t8[4] = c.x; t8[5] = c.y; t8[6] = c.z; t8[7] = c.w;
        }
#pragma unroll
        for (int i = 0; i < 8; ++i) s[i] += t8[i];
      }
    }
    float inv = 1.f / cnt; float o[8];
#pragma unroll
    for (int i = 0; i < 8; ++i) o[i] = s[i] * inv - u[i];
    return pack8(o);
  }
};

__device__ __forceinline__ void phase2(const Params& P, char* smem) {
  bfraw* sA = (bfraw*)smem; bfraw* sB = sA + 128 * LROW;
  float* Wd = (float*)P.regA; bfraw* Aa = P.regB; bfraw* Gg = P.regB + (size_t)NT * 512;
  for (int job = blockIdx.x; job < 4224; job += gridDim.x) {
    int item = job * 256 + threadIdx.x; int tau = item >> 6, chunk = item & 63;
    PoolLoad pl{&P, 0, chunk >> 4};
    *(uint4*)(P.regP + (size_t)tau * 512 + chunk * 8) = pl(tau, (chunk & 15) * 8);
  }
  for (int job = blockIdx.x; job < 1584; job += gridDim.x) {
    int kind = job / 528, jj = job % 528, rt = jj >> 2, ct = jj & 3; int row0 = rt * 128;
    f32x4 acc[4][4]; ZERO_ACC(acc)
    float* sS = (float*)smem;
    if (kind == 0) {
      gemm_main<true>(acc, LoraLoad{&P, row0, 1536, 0}, PlainLoad{P.Wt_dec + (size_t)ct * 128 * 64, 64}, 64, sA, sB);
      acc_to_lds(acc, sS);
#pragma unroll 4
      for (int i = 0; i < 16; ++i) { SEG_VARS(i) int c = ct * 128 + c4;
        float4 w0 = *(const float4*)(P.decay_w0 + c); float4 o;
        o.x = __expf(-0.6065306597f * sigmoidf_(w0.x + v.x)); o.y = __expf(-0.6065306597f * sigmoidf_(w0.y + v.y));
        o.z = __expf(-0.6065306597f * sigmoidf_(w0.z + v.z)); o.w = __expf(-0.6065306597f * sigmoidf_(w0.w + v.w));
        *(float4*)(Wd + (size_t)(row0 + row) * 512 + c) = o; }
    } else if (kind == 1) {
      gemm_main<true>(acc, LoraLoad{&P, row0, 1600, 1}, PlainLoad{P.Wt_a + (size_t)ct * 128 * 64, 64}, 64, sA, sB);
      acc_to_lds(acc, sS);
#pragma unroll 4
      for (int i = 0; i < 16; ++i) { SEG_VARS(i) int c = ct * 128 + c4;
        float4 a0 = *(const float4*)(P.a_0 + c); uint2 o;
        o.x = pack2(sigmoidf_(a0.x + v.x), sigmoidf_(a0.y + v.y)); o.y = pack2(sigmoidf_(a0.z + v.z), sigmoidf_(a0.w + v.w));
        *(uint2*)(Aa + (size_t)(row0 + row) * 512 + c) = o; }
    } else if (kind == 2) {
      gemm_main<true>(acc, LoraLoad{&P, row0, 1664, 2}, PlainLoad{P.Wt_g + (size_t)ct * 128 * 128, 128}, 128, sA, sB);
      acc_to_lds(acc, sS);
#pragma unroll 4
      for (int i = 0; i < 16; ++i) { SEG_VARS(i) int c = ct * 128 + c4;
        uint2 o; o.x = pack2(v.x, v.y); o.y = pack2(v.z, v.w);
        *(uint2*)(Gg + (size_t)(row0 + row) * 512 + c) = o; }
    }
  }
}

__device__ __forceinline__ void wkv_direct(const Params& P, int unit, float* sw) {
  const int lane = threadIdx.x & 63;
  const float* Wd = (const float*)P.regA; const bfraw* Aa = P.regB; const bfraw* Gg = P.regB + (size_t)NT * 512;
  bool prompt = unit < 64; int b, h, T, tok0;
  if (prompt) { b = unit >> 3; h = unit & 7; T = 2048; tok0 = b * 2048; }
  else { int u = unit - 64; b = u >> 3; h = u & 7; T = 4; tok0 = NPR + 4 * b; }
  float S[64];
  if (prompt) {
#pragma unroll
    for (int j = 0; j < 64; ++j) S[j] = 0.f;
  } else {
    const float* sp = P.state_wkv + (((size_t)b * 8 + h) * 64 + lane) * 64;
#pragma unroll
    for (int j = 0; j < 16; ++j) { float4 v = *(const float4*)(sp + j * 4); S[j * 4] = v.x; S[j * 4 + 1] = v.y; S[j * 4 + 2] = v.z; S[j * 4 + 3] = v.w; }
  }
  const int hc = h * 64 + lane;
  const float mu_r = P.shift_mu[hc], mu_k = P.shift_mu[512 + hc], mu_v = P.shift_mu[1024 + hc];
  const float kkw = P.k_k[hc], kaw = P.k_a[hc], rkw = P.r_k[hc], lg = P.lnx_g[hc], lb = P.lnx_b[hc];
  float pr, pk, pv;
  if (prompt) { pr = pk = pv = 0.f; }
  else { const float* ss = P.state_shift + (size_t)b * DSH; pr = ss[hc]; pk = ss[512 + hc]; pv = ss[1024 + hc]; }
  float* s_kk = sw; float* s_w = sw + 64; float* s_ka = sw + 128; float* s_k = sw + 192; float* s_r = sw + 256;
  for (int t = 0; t < T; ++t) {
    int tau = tok0 + t;
    const bfraw* zr = P.regZ + (size_t)tau * DIN;
    float zr_ = bf2f(zr[hc]), zk_ = bf2f(zr[512 + hc]), zv_ = bf2f(zr[1024 + hc]);
    float r = zr_ + (pr - zr_) * mu_r, k = zk_ + (pk - zk_) * mu_k, v = zv_ + (pv - zv_) * mu_v;
    pr = zr_; pk = zk_; pv = zv_;
    float a = bf2f(Aa[(size_t)tau * 512 + hc]), w = Wd[(size_t)tau * 512 + hc], g = bf2f(Gg[(size_t)tau * 512 + hc]);
    float kkf = k * kkw; float nrm = sqrtf(wsum(kkf * kkf)); float kk = kkf / fmaxf(nrm, 1e-12f);
    float k2 = k * (1.f + (a - 1.f) * kaw);
    float ka = kk * a;
    float bsum = wsum(r * k2 * rkw);
    __builtin_amdgcn_wave_barrier();
    s_kk[lane] = kk; s_w[lane] = w; s_ka[lane] = ka; s_k[lane] = k2; s_r[lane] = r;
    __builtin_amdgcn_wave_barrier();
    float skk = 0.f;
#pragma unroll
    for (int j = 0; j < 16; ++j) { float4 q = *(const float4*)(s_kk + j * 4); skk += S[j * 4] * q.x + S[j * 4 + 1] * q.y + S[j * 4 + 2] * q.z + S[j * 4 + 3] * q.w; }
    skk = -skk;
    float o = 0.f;
#pragma unroll
    for (int j = 0; j < 16; ++j) {
      float4 qw = *(const float4*)(s_w + j * 4), qa = *(const float4*)(s_ka + j * 4), qk = *(const float4*)(s_k + j * 4), qr = *(const float4*)(s_r + j * 4);
      S[j * 4] = S[j * 4] * qw.x + skk * qa.x + v * qk.x; o += S[j * 4] * qr.x;
      S[j * 4 + 1] = S[j * 4 + 1] * qw.y + skk * qa.y + v * qk.y; o += S[j * 4 + 1] * qr.y;
      S[j * 4 + 2] = S[j * 4 + 2] * qw.z + skk * qa.z + v * qk.z; o += S[j * 4 + 2] * qr.z;
      S[j * 4 + 3] = S[j * 4 + 3] * qw.w + skk * qa.w + v * qk.w; o += S[j * 4 + 3] * qr.w;
    }
    float mean = wsum(o) * (1.f / 64.f); float dd = o - mean; float var = wsum(dd * dd) * (1.f / 64.f);
    float y = (dd * rsqrtf(var + 64e-5f) * lg + lb + bsum * v) * g;
    P.regY[(size_t)tau * 1024 + hc] = f2bf(y);
  }
  float* so = P.out + (prompt ? O_WKP : O_WKS) + (((size_t)b * 8 + h) * 64 + lane) * 64;
#pragma unroll
  for (int j = 0; j < 16; ++j) *(float4*)(so + j * 4) = make_float4(S[j * 4], S[j * 4 + 1], S[j * 4 + 2], S[j * 4 + 3]);
}

#define MFMA16(a, b, c) __builtin_amdgcn_mfma_f32_16x16x32_bf16(a, b, c, 0, 0, 0)
__device__ __forceinline__ void wkv_chunk_pre(const Params& P, int unit, char* smem) {
  const int tid = threadIdx.x, lane = tid & 63, w = tid >> 6, fr = lane & 15, fq = lane >> 4;
  bfraw* Ah = (bfraw*)smem; bfraw* Bh = Ah + 2304; bfraw* Kh = Bh + 2304; bfraw* Rh = Kh + 2304;
  bfraw* AhT = Rh + 2304;
  bfraw* Vt = AhT + 2560; bfraw* NakT = Vt + 2560; bfraw* MbrT = NakT + 1280; bfraw* MkrT = MbrT + 1280; bfraw* Tt = MkrT + 1280;
  bfraw* VN = Tt + 1280; bfraw* nAt = VN + 2560; bfraw* nD0 = nAt + 2560;
  float* G = (float*)(nD0 + 2560);
  float* gC = G + 2048;
  float* NabT = G;
  const float* Wd = (const float*)P.regA; const bfraw* Aa = P.regB;
  const int b = unit >> 9, h = (unit >> 6) & 7, c = unit & 63;
  const int tok0 = b * 2048 + c * 32;
  __syncthreads();
  {
    const int t = tid >> 3, jg = tid & 7, j0 = jg * 8, hc = h * 64 + j0;
    const int tau = tok0 + t;
    const bool first = (c == 0 && t == 0);
    const bfraw* zr = P.regZ + (size_t)tau * DIN;
    float zr_[8], zk_[8], zv_[8], pr[8], pk[8], pv[8];
    unpack8(*(const uint4*)(zr + hc), zr_); unpack8(*(const uint4*)(zr + 512 + hc), zk_); unpack8(*(const uint4*)(zr + 1024 + hc), zv_);
    if (!first) { unpack8(*(const uint4*)(zr - DIN + hc), pr); unpack8(*(const uint4*)(zr - DIN + 512 + hc), pk); unpack8(*(const uint4*)(zr - DIN + 1024 + hc), pv); }
    else {
#pragma unroll
      for (int i = 0; i < 8; ++i) { pr[i] = 0.f; pk[i] = 0.f; pv[i] = 0.f; }
    }
    float a[8], wd[8], r[8], k[8], v[8], kk[8], k2[8];
    unpack8(*(const uint4*)(Aa + (size_t)tau * 512 + hc), a);
    { float4 x = *(const float4*)(Wd + (size_t)tau * 512 + hc), y = *(const float4*)(Wd + (size_t)tau * 512 + hc + 4);
      wd[0] = x.x; wd[1] = x.y; wd[2] = x.z; wd[3] = x.w; wd[4] = y.x; wd[5] = y.y; wd[6] = y.z; wd[7] = y.w; }
    float ss = 0.f, bs = 0.f;
#pragma unroll
    for (int i = 0; i < 8; ++i) {
      float mr = P.shift_mu[hc + i], mk = P.shift_mu[512 + hc + i], mv = P.shift_mu[1024 + hc + i];
      r[i] = zr_[i] + (pr[i] - zr_[i]) * mr; k[i] = zk_[i] + (pk[i] - zk_[i]) * mk; v[i] = zv_[i] + (pv[i] - zv_[i]) * mv;
      float kkf = k[i] * P.k_k[hc + i]; kk[i] = kkf; ss += kkf * kkf;
      k2[i] = k[i] * (1.f + (a[i] - 1.f) * P.k_a[hc + i]);
      bs += r[i] * k2[i] * P.r_k[hc + i];
    }
    ss += __shfl_xor(ss, 1, 64); ss += __shfl_xor(ss, 2, 64); ss += __shfl_xor(ss, 4, 64);
    bs += __shfl_xor(bs, 1, 64); bs += __shfl_xor(bs, 2, 64); bs += __shfl_xor(bs, 4, 64);
    if (jg == 0) P.bonus[(size_t)tau * 8 + h] = bs;
    float inv = 1.f / fmaxf(sqrtf(ss), 1e-12f);
    *(float4*)(G + t * 64 + j0) = make_float4(wd[0], wd[1], wd[2], wd[3]);
    *(float4*)(G + t * 64 + j0 + 4) = make_float4(wd[4], wd[5], wd[6], wd[7]);
    __syncthreads();
    if (tid < 64) {
      float g = 1.f;
      for (int t2 = 0; t2 < 32; ++t2) { g *= G[t2 * 64 + tid]; G[t2 * 64 + tid] = g; }
      gC[tid] = g;
    }
    __syncthreads();
    float ah[8], bh[8], kh[8], rh[8];
#pragma unroll
    for (int i = 0; i < 8; ++i) {
      float gt = G[t * 64 + j0 + i]; float gp = t > 0 ? G[(t - 1) * 64 + j0 + i] : 1.f; float ig = 1.f / gt;
      float kkn = kk[i] * inv;
      ah[i] = kkn * gp; bh[i] = kkn * a[i] * ig; kh[i] = k2[i] * ig; rh[i] = r[i] * gt;
    }
    uint4 pa = pack8(ah);
    *(uint4*)(Ah + t * 72 + j0) = pa; *(uint4*)(Bh + t * 72 + j0) = pack8(bh); *(uint4*)(Kh + t * 72 + j0) = pack8(kh); *(uint4*)(Rh + t * 72 + j0) = pack8(rh);
    unsigned int paw[4] = {pa.x, pa.y, pa.z, pa.w};
#pragma unroll
    for (int i = 0; i < 8; ++i) {
      AhT[(j0 + i) * 40 + t] = (bfraw)((i & 1) ? (paw[i >> 1] >> 16) : (paw[i >> 1] & 0xffffu));
      Vt[(j0 + i) * 40 + t] = f2bf(v[i]);
    }
  }
  __syncthreads();
  const f32x4 z4 = {0.f, 0.f, 0.f, 0.f};
  {
    const bfraw* Xp = (w & 1) ? Kh : Bh; const bfraw* Yp = (w >> 1) ? Rh : Ah;
    f32x4 acc[2][2] = {{z4, z4}, {z4, z4}};
#pragma unroll
    for (int ks = 0; ks < 2; ++ks) {
      bf16x8 xa[2], yb[2];
#pragma unroll
      for (int mt = 0; mt < 2; ++mt) { xa[mt] = *(const bf16x8*)(Xp + (mt * 16 + fr) * 72 + ks * 32 + fq * 8); yb[mt] = *(const bf16x8*)(Yp + (mt * 16 + fr) * 72 + ks * 32 + fq * 8); }
#pragma unroll
      for (int mt = 0; mt < 2; ++mt)
#pragma unroll
        for (int nt = 0; nt < 2; ++nt) acc[mt][nt] = MFMA16(xa[mt], yb[nt], acc[mt][nt]);
    }
    bfraw* dst = (w == 1) ? NakT : (w == 2 ? MbrT : MkrT);
#pragma unroll
    for (int mt = 0; mt < 2; ++mt)
#pragma unroll
      for (int nt = 0; nt < 2; ++nt)
#pragma unroll
        for (int jj = 0; jj < 4; ++jj) {
          int ta = mt * 16 + fq * 4 + jj, tt = nt * 16 + fr; float val = acc[mt][nt][jj];
          if (w == 0) NabT[tt * 32 + ta] = (ta < tt) ? val : 0.f;
          else { bool keep = (w == 1) ? (ta < tt) : (ta <= tt); dst[tt * 40 + ta] = f2bf(keep ? val : 0.f); }
        }
  }
  __syncthreads();
  const bf16x8 xv = *(const bf16x8*)(Vt + (16 * w + fr) * 40 + fq * 8);
  {
#pragma unroll
    for (int nt = 0; nt < 2; ++nt) {
      bf16x8 yb = *(const bf16x8*)(NakT + (nt * 16 + fr) * 40 + fq * 8);
      f32x4 acc = MFMA16(xv, yb, z4);
#pragma unroll
      for (int jj = 0; jj < 4; ++jj) VN[(16 * w + fq * 4 + jj) * 40 + nt * 16 + fr] = f2bf(acc[jj]);
    }
  }
  if (w == 0 && lane < 32) {
    float Tr[32];
#pragma unroll
    for (int t = 0; t < 32; ++t) {
      float a0 = (lane == t) ? 1.f : 0.f, a1 = 0.f, a2 = 0.f, a3 = 0.f;
#pragma unroll
      for (int q = 0; q < (t + 3) / 4; ++q) {
        float4 nv = *(const float4*)(NabT + t * 32 + q * 4);
        a0 -= Tr[q * 4] * nv.x;
        if (q * 4 + 1 < t) a1 -= Tr[q * 4 + 1] * nv.y;
        if (q * 4 + 2 < t) a2 -= Tr[q * 4 + 2] * nv.z;
        if (q * 4 + 3 < t) a3 -= Tr[q * 4 + 3] * nv.w;
      }
      float acc = (a0 + a1) + (a2 + a3);
      Tr[t] = acc;
      Tt[t * 40 + lane] = f2bf(acc);
    }
  }
  __syncthreads();
  bf16x8 xn, xd;
  {
    bf16x8 xa = *(const bf16x8*)(AhT + (16 * w + fr) * 40 + fq * 8);
    bf16x8 xvn = *(const bf16x8*)(VN + (16 * w + fr) * 40 + fq * 8);
#pragma unroll
    for (int nt = 0; nt < 2; ++nt) {
      bf16x8 yb = *(const bf16x8*)(Tt + (nt * 16 + fr) * 40 + fq * 8);
      f32x4 aA = MFMA16(xa, yb, z4), aD = MFMA16(xvn, yb, z4);
#pragma unroll
      for (int jj = 0; jj < 4; ++jj) {
        nAt[(16 * w + fq * 4 + jj) * 40 + nt * 16 + fr] = f2bf(-aA[jj]);
        nD0[(16 * w + fq * 4 + jj) * 40 + nt * 16 + fr] = f2bf(-aD[jj]);
      }
    }
    __builtin_amdgcn_wave_barrier();
    xn = *(const bf16x8*)(nAt + (16 * w + fr) * 40 + fq * 8);
    xd = *(const bf16x8*)(nD0 + (16 * w + fr) * 40 + fq * 8);
  }
  char* pq = (char*)P.regPQ + (size_t)unit * 12288;
  char* lo = (char*)P.out + (size_t)unit * 12288;
  bfraw* PmT = (bfraw*)pq; bfraw* QT = (bfraw*)(pq + 8192);
  uint2* Lb = (uint2*)lo; uint2* Ob = (uint2*)(lo + 8192);
#pragma unroll
  for (int nt = 0; nt < 2; ++nt) {
    bf16x8 ymb = *(const bf16x8*)(MbrT + (nt * 16 + fr) * 40 + fq * 8), ymk = *(const bf16x8*)(MkrT + (nt * 16 + fr) * 40 + fq * 8);
    f32x4 aQ = MFMA16(xn, ymb, z4);
    f32x4 aO = MFMA16(xv, ymk, z4); aO = MFMA16(xd, ymb, aO);
    int tt = nt * 16 + fr; float q[4];
#pragma unroll
    for (int jj = 0; jj < 4; ++jj) q[jj] = aQ[jj] + bf2f(Rh[tt * 72 + 16 * w + fq * 4 + jj]);
    uint2 o; o.x = pack2(q[0], q[1]); o.y = pack2(q[2], q[3]);
    *(uint2*)(QT + tt * 64 + 16 * w + fq * 4) = o;
    uint2 o2; o2.x = pack2(aO[0], aO[1]); o2.y = pack2(aO[2], aO[3]);
    Ob[(w * 2 + nt) * 64 + lane] = o2;
  }
#pragma unroll
  for (int nt = 0; nt < 4; ++nt) {
    bf16x8 ybB, ybK;
#pragma unroll
    for (int e = 0; e < 8; ++e) { ybB[e] = (short)Bh[(fq * 8 + e) * 72 + nt * 16 + fr]; ybK[e] = (short)Kh[(fq * 8 + e) * 72 + nt * 16 + fr]; }
    f32x4 aP = MFMA16(xn, ybB, z4);
    f32x4 aL = MFMA16(xv, ybK, z4); aL = MFMA16(xd, ybB, aL);
    int jp = nt * 16 + fr; float gc = gC[jp]; float pm[4], l[4];
#pragma unroll
    for (int jj = 0; jj < 4; ++jj) { int j = 16 * w + fq * 4 + jj; pm[jj] = gc * ((j == jp ? 1.f : 0.f) + aP[jj]); l[jj] = gc * aL[jj]; }
    uint2 o; o.x = pack2(pm[0], pm[1]); o.y = pack2(pm[2], pm[3]);
    *(uint2*)(PmT + jp * 64 + 16 * w + fq * 4) = o;
    uint2 o2; o2.x = pack2(l[0], l[1]); o2.y = pack2(l[2], l[3]);
    Lb[(w * 4 + nt) * 64 + lane] = o2;
  }
}

__device__ __forceinline__ f32x4 unpack4(uint2 u) {
  f32x4 r; r[0] = __uint_as_float(u.x << 16); r[1] = __uint_as_float(u.x & 0xffff0000u); r[2] = __uint_as_float(u.y << 16); r[3] = __uint_as_float(u.y & 0xffff0000u); return r;
}
struct SeqOps { bf16x8 pm[4][2]; bf16x8 qt[2][2]; uint2 l[4]; uint2 o0[2]; };
__device__ __forceinline__ void seq_load(const Params& P, int bh, int c, int w, int lane, SeqOps& o, int cmax = 63) {
  const int fr = lane & 15, fq = lane >> 4;
  const int unit = bh * 64 + (c < cmax ? c : cmax);
  const char* pq = (const char*)P.regPQ + (size_t)unit * 12288; const char* lo = (const char*)P.out + (size_t)unit * 12288;
  const bfraw* PmT = (const bfraw*)pq; const bfraw* QT = (const bfraw*)(pq + 8192);
  const uint2* Lb = (const uint2*)lo; const uint2* Ob = (const uint2*)(lo + 8192);
#pragma unroll
  for (int nt = 0; nt < 4; ++nt)
#pragma unroll
    for (int ks = 0; ks < 2; ++ks) o.pm[nt][ks] = *(const bf16x8*)(PmT + (nt * 16 + fr) * 64 + ks * 32 + fq * 8);
#pragma unroll
  for (int nt = 0; nt < 2; ++nt)
#pragma unroll
    for (int ks = 0; ks < 2; ++ks) o.qt[nt][ks] = *(const bf16x8*)(QT + (nt * 16 + fr) * 64 + ks * 32 + fq * 8);
#pragma unroll
  for (int nt = 0; nt < 4; ++nt) o.l[nt] = Lb[(w * 4 + nt) * 64 + lane];
#pragma unroll
  for (int nt = 0; nt < 2; ++nt) o.o0[nt] = Ob[(w * 2 + nt) * 64 + lane];
}
__device__ __forceinline__ void seq_step(const Params& P, int b, int h, int c, int w, int lane, float* strip, f32x4 (&S)[4], const SeqOps& o) {
  const int fr = lane & 15, fq = lane >> 4;
  bfraw* Oraw = (bfraw*)((char*)P.out + 50331648);
  __builtin_amdgcn_wave_barrier();
#pragma unroll
  for (int nt = 0; nt < 4; ++nt)
#pragma unroll
    for (int jj = 0; jj < 4; ++jj) strip[(fq * 4 + jj) * 68 + nt * 16 + fr] = S[nt][jj];
  __builtin_amdgcn_wave_barrier();
  bf16x8 xh[2], xl[2];
#pragma unroll
  for (int ks = 0; ks < 2; ++ks) {
    float4 p0 = *(const float4*)(strip + fr * 68 + ks * 32 + fq * 8), p1 = *(const float4*)(strip + fr * 68 + ks * 32 + fq * 8 + 4);
    float xs[8] = {p0.x, p0.y, p0.z, p0.w, p1.x, p1.y, p1.z, p1.w};
    unsigned int hp[4], lp[4];
#pragma unroll
    for (int e = 0; e < 4; ++e) {
      hp[e] = pack2(xs[2 * e], xs[2 * e + 1]);
      lp[e] = pack2(xs[2 * e] - __uint_as_float(hp[e] << 16), xs[2 * e + 1] - __uint_as_float(hp[e] & 0xffff0000u));
    }
    xh[ks] = __builtin_bit_cast(bf16x8, make_uint4(hp[0], hp[1], hp[2], hp[3]));
    xl[ks] = __builtin_bit_cast(bf16x8, make_uint4(lp[0], lp[1], lp[2], lp[3]));
  }
  f32x4 aO[2];
#pragma unroll
  for (int nt = 0; nt < 2; ++nt) {
    aO[nt] = unpack4(o.o0[nt]);
#pragma unroll
    for (int ks = 0; ks < 2; ++ks) { aO[nt] = MFMA16(xh[ks], o.qt[nt][ks], aO[nt]); aO[nt] = MFMA16(xl[ks], o.qt[nt][ks], aO[nt]); }
  }
#pragma unroll
  for (int nt = 0; nt < 4; ++nt) {
    f32x4 aS = unpack4(o.l[nt]);
#pragma unroll
    for (int ks = 0; ks < 2; ++ks) { aS = MFMA16(xh[ks], o.pm[nt][ks], aS); aS = MFMA16(xl[ks], o.pm[nt][ks], aS); }
    S[nt] = aS;
  }
  const int tok0 = b * 2048 + c * 32;
#pragma unroll
  for (int nt = 0; nt < 2; ++nt) {
    uint2 ov; ov.x = pack2(aO[nt][0], aO[nt][1]); ov.y = pack2(aO[nt][2], aO[nt][3]);
    *(uint2*)(Oraw + (size_t)(tok0 + nt * 16 + fr) * 512 + h * 64 + 16 * w + fq * 4) = ov;
  }
}
__device__ __forceinline__ void wkv_seq(const Params& P, int bh, char* smem, int c0, int c1) {
  const int tid = threadIdx.x, lane = tid & 63, w = tid >> 6, fr = lane & 15, fq = lane >> 4;
  float* strip = (float*)smem + w * 16 * 68;
  const int b = bh >> 3, h = bh & 7;
  f32x4* sb = (f32x4*)P.Sbuf + ((size_t)(bh * 4 + w) * 4) * 64 + lane;
  f32x4 S[4];
#pragma unroll
  for (int nt = 0; nt < 4; ++nt) S[nt] = (c0 == 0) ? f32x4{0.f, 0.f, 0.f, 0.f} : sb[nt * 64];
  const int cm = c1 - 1;
  SeqOps o0, o1, o2;
  seq_load(P, bh, c0, w, lane, o0, cm);
  seq_load(P, bh, c0 + 1, w, lane, o1, cm);
#pragma unroll 1
  for (int c = c0; c < c1; c += 3) {
    seq_load(P, bh, c + 2, w, lane, o2, cm);
    seq_step(P, b, h, c, w, lane, strip, S, o0);
    seq_load(P, bh, c + 3, w, lane, o0, cm);
    if (c + 1 < c1) seq_step(P, b, h, c + 1, w, lane, strip, S, o1);
    seq_load(P, bh, c + 4, w, lane, o1, cm);
    if (c + 2 < c1) seq_step(P, b, h, c + 2, w, lane, strip, S, o2);
  }
  if (c1 < 64) {
#pragma unroll
    for (int nt = 0; nt < 4; ++nt) sb[nt * 64] = S[nt];
    return;
  }
  float* so = P.out + O_WKP + ((size_t)bh * 64) * 64;
#pragma unroll
  for (int nt = 0; nt < 4; ++nt)
#pragma unroll
    for (int jj = 0; jj < 4; ++jj) so[(16 * w + fq * 4 + jj) * 64 + nt * 16 + fr] = S[nt][jj];
}
__device__ __forceinline__ void phase3a(const Params& P, char* smem) {
  for (int u = blockIdx.x; u < 2048; u += gridDim.x) wkv_chunk_pre(P, (u >> 5) * 64 + (u & 31), smem);
}
__device__ __forceinline__ void phase3x(const Params& P, char* smem) {
  if (blockIdx.x < 64) { wkv_seq(P, blockIdx.x, smem, 0, 32); return; }
  const int nb = gridDim.x - 64;
  bfraw* sA = (bfraw*)smem; bfraw* sB = sA + 128 * LROW;
  for (int u = blockIdx.x - 64; u < 2048; u += nb) wkv_chunk_pre(P, (u >> 5) * 64 + 32 + (u & 31), smem);
  __syncthreads();
  for (int job = (blockIdx.x - 64 + nb - (2048 % nb)) % nb; job < 528; job += nb) {
    int rt = job >> 2, gi = job & 3; int row0 = rt * 128;
    f32x4 acc[4][4]; ZERO_ACC(acc)
    float* sS = (float*)smem;
    gemm_main(acc, PlainLoad{P.regP + (size_t)row0 * 512 + gi * 128, 512}, PlainLoad{P.Wt_pool + (size_t)gi * 16384, 128}, 128, sA, sB);
    acc_to_lds(acc, sS);
#pragma unroll 4
    for (int i = 0; i < 16; ++i) { SEG_VARS(i) int c = gi * 128 + c4;
      float4 ps = *(const float4*)(P.pool_scale + c);
      uint2 o; o.x = pack2(v.x * ps.x, v.y * ps.y); o.y = pack2(v.z * ps.z, v.w * ps.w);
      *(uint2*)(P.regY + (size_t)(row0 + row) * 1024 + 512 + c) = o; }
  }
}

struct F32Load {
  const float* base; int ld;
  __device__ __forceinline__ uint4 operator()(int r, int k) const {
    const float* p = base + (size_t)r * ld + k;
    float4 a = *(const float4*)p, c = *(const float4*)(p + 4);
    uint4 o; o.x = pack2(a.x, a.y); o.y = pack2(a.z, a.w); o.z = pack2(c.x, c.y); o.w = pack2(c.z, c.w); return o;
  }
};
__device__ __forceinline__ void fold_job_mfma(const Params& P, int job, char* smem) {
  bfraw* sA = (bfraw*)smem; bfraw* sB = sA + 128 * LROW;
  const int hp = job >> 3, k0 = (job & 7) * 128, p = hp & 1;
  f32x4 acc[4][4]; ZERO_ACC(acc)
  float* sS = (float*)smem;
  gemm_main(acc, F32Load{P.peer_keys + (size_t)p * 128 * 128, 128}, F32Load{P.peer_wq + (size_t)k0 * 2048 + hp * 128, 2048}, 128, sA, sB);
  acc_to_lds(acc, sS);
#pragma unroll 4
  for (int i = 0; i < 16; ++i) { SEG_VARS(i)
    float4 g = *(const float4*)(P.norm_ffn_g + k0 + c4);
    uint2 o; o.x = pack2(v.x * g.x, v.y * g.y); o.y = pack2(v.z * g.z, v.w * g.w);
    *(uint2*)(P.Wt_q + (size_t)(hp * 128 + row) * 1024 + k0 + c4) = o; }
}

__device__ __forceinline__ void phase3b(const Params& P, char* smem, float* sred) {
  int wid = threadIdx.x >> 6;
  bfraw* sA = (bfraw*)smem; bfraw* sB = sA + 128 * LROW;
  if (blockIdx.x < 64) { wkv_seq(P, blockIdx.x, smem, 32, 64); return; }
  const int nb = gridDim.x - 64;
  for (int job = blockIdx.x - 64; job < 256; job += nb) wkv_direct(P, 64 + job * 4 + wid, (float*)smem + wid * 320);
  __syncthreads();
  __syncthreads();
  for (int job = (blockIdx.x - 64 + nb - (256 % nb)) % nb; job < 128; job += nb) fold_job_mfma(P, job, smem);
  __syncthreads();
  for (int job = (blockIdx.x - 64 + 2 * nb - ((256 + 128) % nb)) % nb; job < 576; job += nb) { __syncthreads(); prep_transpose(P, 576 + job, (float*)smem); }
}

__device__ __forceinline__ void phase3c(const Params& P) {
  const int lane = threadIdx.x & 63, wid = threadIdx.x >> 6;
  const bfraw* Oraw = (const bfraw*)((const char*)P.out + 50331648);
  const bfraw* Gg = P.regB + (size_t)NT * 512;
  const int c0 = lane * 8, hd = lane >> 3;
  float mu[8], lg[8], lb[8];
  { float4 a = *(const float4*)(P.shift_mu + 1024 + c0), c = *(const float4*)(P.shift_mu + 1024 + c0 + 4);
    mu[0] = a.x; mu[1] = a.y; mu[2] = a.z; mu[3] = a.w; mu[4] = c.x; mu[5] = c.y; mu[6] = c.z; mu[7] = c.w;
    a = *(const float4*)(P.lnx_g + c0); c = *(const float4*)(P.lnx_g + c0 + 4);
    lg[0] = a.x; lg[1] = a.y; lg[2] = a.z; lg[3] = a.w; lg[4] = c.x; lg[5] = c.y; lg[6] = c.z; lg[7] = c.w;
    a = *(const float4*)(P.lnx_b + c0); c = *(const float4*)(P.lnx_b + c0 + 4);
    lb[0] = a.x; lb[1] = a.y; lb[2] = a.z; lb[3] = a.w; lb[4] = c.x; lb[5] = c.y; lb[6] = c.z; lb[7] = c.w; }
#pragma unroll 2
  for (int tau = blockIdx.x * 4 + wid; tau < NPR; tau += gridDim.x * 4) {
    const bool first = (tau & 2047) == 0;
    float o[8], zv[8], pv[8], g[8];
    unpack8(*(const uint4*)(Oraw + (size_t)tau * 512 + c0), o);
    unpack8(*(const uint4*)(P.regZ + (size_t)tau * DIN + 1024 + c0), zv);
    unpack8(*(const uint4*)(P.regZ + (size_t)(first ? tau : tau - 1) * DIN + 1024 + c0), pv);
    unpack8(*(const uint4*)(Gg + (size_t)tau * 512 + c0), g);
    const float bon = P.bonus[(size_t)tau * 8 + hd];
    float sm = 0.f;
#pragma unroll
    for (int i = 0; i < 8; ++i) sm += o[i];
    sm += __shfl_xor(sm, 1, 64); sm += __shfl_xor(sm, 2, 64); sm += __shfl_xor(sm, 4, 64);
    const float mean = sm * (1.f / 64.f);
    float sq = 0.f;
#pragma unroll
    for (int i = 0; i < 8; ++i) { o[i] -= mean; sq += o[i] * o[i]; }
    sq += __shfl_xor(sq, 1, 64); sq += __shfl_xor(sq, 2, 64); sq += __shfl_xor(sq, 4, 64);
    const float rs = rsqrtf(sq * (1.f / 64.f) + 64e-5f);
    float y[8];
#pragma unroll
    for (int i = 0; i < 8; ++i) {
      float p = first ? 0.f : pv[i];
      float v = zv[i] + (p - zv[i]) * mu[i];
      y[i] = (o[i] * rs * lg[i] + lb[i] + bon * v) * g[i];
    }
    *(uint4*)(P.regY + (size_t)tau * 1024 + c0) = pack8(y);
  }
}

__device__ __forceinline__ int filler_rank(int nbusy_lr, int& nfill) {
  const int b = blockIdx.x;
  if (gridDim.x != 512) { nfill = gridDim.x; return b; }
  const int x = b & 7, lr = b >> 3;
  nfill = 512 - 4 * nbusy_lr;
  if (x < 4 && lr < nbusy_lr) return -1;
  const int busy_before = lr < nbusy_lr ? 4 * lr + 4 : 4 * nbusy_lr;
  return b - busy_before;
}

__device__ __forceinline__ void phase4(const Params& P, char* smem, float* sred) {
  bfraw* sA = (bfraw*)smem; bfraw* sB = sA + 128 * LROW;
  bfraw* hb = P.regA;
  const int NG = 132 * 8, NCONV = 8192;
  for (int it = 0;; ++it) {
    {
      int rt, ct; if (!xcd_job(it, 8, 8, rt, ct)) break; int row0 = rt * 128, col0 = ct * 128;
      f32x4 acc[4][4]; ZERO_ACC(acc)
      gemm_main(acc, PlainLoad{P.regY + (size_t)row0 * 1024, 1024}, PlainLoad{P.Wt_out + (size_t)col0 * 1024, 1024}, 1024, sA, sB);
      float* sS = (float*)smem;
      acc_to_lds(acc, sS);
#pragma unroll 4
      for (int i = 0; i < 16; ++i) { SEG_VARS(i)
        int tau = row0 + row, c = col0 + c4;
        float4 xv = *(const float4*)(xrow(P, tau) + c);
        float4 h; h.x = xv.x + v.x; h.y = xv.y + v.y; h.z = xv.z + v.z; h.w = xv.w + v.w;
        *(float4*)(P.out + (size_t)tau * 1024 + c) = h;
        uint2 o; o.x = pack2(h.x, h.y); o.y = pack2(h.z, h.w);
        *(uint2*)(hb + (size_t)tau * 1024 + c) = o;
        float ss = h.x * h.x + h.y * h.y + h.z * h.z + h.w * h.w;
        ss += __shfl_xor(ss, 1, 64); ss += __shfl_xor(ss, 2, 64); ss += __shfl_xor(ss, 4, 64); ss += __shfl_xor(ss, 8, 64); ss += __shfl_xor(ss, 16, 64);
        if ((etid_ & 31) == 0) P.ssq1[(size_t)ct * NT + tau] = ss; }
    }
  }
  int nfill4; const int fr4 = filler_rank(8, nfill4);
  for (int job0 = NG + fr4 * 4; fr4 >= 0 && job0 < NG + NCONV; job0 += nfill4 * 4) {
    int job = job0;
    for (int jq = 0; jq < 4; ++jq, ++job) {
      size_t e0 = ((size_t)(job - NG) * 256 + threadIdx.x) * 16;
      const bool isu = e0 < (size_t)16777216;
      const float* src = isu ? P.peer_u + e0 : P.peer_v + (e0 - 16777216);
      const float sc = isu ? 256.f : 32.f;
      unsigned int wv[4];
#pragma unroll
      for (int q = 0; q < 4; ++q) {
        float4 a = *(const float4*)(src + q * 4);
        int wq = __builtin_amdgcn_cvt_pk_fp8_f32(a.x * sc, a.y * sc, 0, false);
        wq = __builtin_amdgcn_cvt_pk_fp8_f32(a.z * sc, a.w * sc, wq, true);
        wv[q] = (unsigned int)wq;
      }
      *(uint4*)((unsigned char*)P.regZ + e0) = make_uint4(wv[0], wv[1], wv[2], wv[3]);
    }
  }
}

struct PLoad {
  const Params* P; int row0;
  __device__ __forceinline__ uint4 operator()(int r, int k) const {
    int tau = row0 + r;
    const float* pr = (tau < NPR ? P->p_prompt + (size_t)tau * 256 : P->p_sample + (size_t)(tau - NPR) * 256) + k;
    float4 a = *(const float4*)pr, c = *(const float4*)(pr + 4);
    uint4 o; o.x = pack2(a.x, a.y); o.y = pack2(a.z, a.w); o.z = pack2(c.x, c.y); o.w = pack2(c.z, c.w); return o;
  }
};
#define TK_INS(x) { _Pragma("unroll") for (int i_ = 15; i_ > 0; --i_) s[i_] = __builtin_amdgcn_fmed3f(s[i_ - 1], s[i_], x); s[0] = fmaxf(s[0], x); }
__device__ __forceinline__ void phase5(const Params& P, char* smem, float* sred) {
  bfraw* sA = (bfraw*)smem; bfraw* sB = sA + 128 * LROW;
  const bfraw* hb = P.regA; float* TK = (float*)P.regB;
  float* sS = (float*)smem;
  for (int it = 0;; ++it) {
    int rt, ct; if (!xcd_job(it, 16, 8, rt, ct)) break; int row0 = rt * 128, col0 = ct * 128;
    EPI_VARS
    if (tid < 128) {
      float s = 0.f;
#pragma unroll
      for (int c = 0; c < 8; ++c) s += P.ssq1[(size_t)c * NT + row0 + tid];
      sred[tid] = rsqrtf(s * (1.f / 1024.f) + 1e-6f);
    }
    f32x4 acc[4][4]; ZERO_ACC(acc)
    gemm_main<true>(acc, PlainLoad{hb + (size_t)row0 * 1024, 1024}, PlainLoad{P.Wt_q + (size_t)col0 * 1024, 1024}, 1024, sA, sB);
    EPI_LOOP { EPI_RC
      float v = acc[m][n][j] * sred[row];
      unsigned int bits = (__float_as_uint(v) & ~127u) | (unsigned)col;
      sS[row * 128 + (col ^ (row & 31))] = __uint_as_float(bits); }
    __syncthreads();
    int tk_ = threadIdx.x; asm volatile("" : "+v"(tk_));
    int r = tk_ & 127, q = tk_ >> 7;
    float s[16];
#pragma unroll
    for (int i = 0; i < 16; ++i) s[i] = -3.0e38f;
    for (int i = 0; i < 64; ++i) { float x = sS[r * 128 + ((q * 64 + i) ^ (r & 31))]; TK_INS(x) }
    __syncthreads();
    if (q == 1) {
#pragma unroll
      for (int i = 0; i < 16; ++i) sS[r * 17 + i] = s[i];
    }
    __syncthreads();
    if (q == 0) {
#pragma unroll
      for (int i = 0; i < 16; ++i) { float x = sS[r * 17 + i]; TK_INS(x) }
      float* dst = TK + (size_t)(row0 + r) * 256 + ct * 16;
#pragma unroll
      for (int i = 0; i < 4; ++i) *(float4*)(dst + i * 4) = make_float4(s[i * 4], s[i * 4 + 1], s[i * 4 + 2], s[i * 4 + 3]);
    }
    __syncthreads();
  }
  int nfill5; const int fr5 = filler_rank(16, nfill5);
  for (int job = fr5; fr5 >= 0 && job < 132 * 8; job += nfill5) {
    __syncthreads();
    int rt = job >> 3, ct = job & 7; int row0 = rt * 128, col0 = ct * 128;
    f32x4 acc[4][4]; ZERO_ACC(acc)
    gemm_main(acc, PLoad{&P, row0}, PlainLoad{P.Wt_ple + (size_t)col0 * 256, 256}, 256, sA, sB);
    acc_to_lds(acc, sS);
#pragma unroll 4
    for (int i = 0; i < 16; ++i) { SEG_VARS(i)
      uint2 o; o.x = pack2(v.x, v.y); o.y = pack2(v.z, v.w);
      *(uint2*)(P.regY + (size_t)(row0 + row) * 1024 + col0 + c4) = o; }
  }
}

typedef float f32x2 __attribute__((ext_vector_type(2)));
__device__ __forceinline__ float gelu_exact(float x) { return 0.5f * x * (1.f + erff(x * 0.70710678118f)); }
__device__ __forceinline__ float dot16_fp8(uint4 r, const f32x2 (&xn2)[8]) {
  f32x2 acc = __builtin_amdgcn_cvt_pk_f32_fp8((int)r.x, false) * xn2[0];
  acc += __builtin_amdgcn_cvt_pk_f32_fp8((int)r.x, true) * xn2[1];
  acc += __builtin_amdgcn_cvt_pk_f32_fp8((int)r.y, false) * xn2[2];
  acc += __builtin_amdgcn_cvt_pk_f32_fp8((int)r.y, true) * xn2[3];
  acc += __builtin_amdgcn_cvt_pk_f32_fp8((int)r.z, false) * xn2[4];
  acc += __builtin_amdgcn_cvt_pk_f32_fp8((int)r.z, true) * xn2[5];
  acc += __builtin_amdgcn_cvt_pk_f32_fp8((int)r.w, false) * xn2[6];
  acc += __builtin_amdgcn_cvt_pk_f32_fp8((int)r.w, true) * xn2[7];
  return acc.x + acc.y;
}
__device__ __forceinline__ void axpy16_fp8(uint4 r, float a, f32x2 (&o2)[8]) {
  f32x2 a2 = {a, a};
  o2[0] += a2 * __builtin_amdgcn_cvt_pk_f32_fp8((int)r.x, false);
  o2[1] += a2 * __builtin_amdgcn_cvt_pk_f32_fp8((int)r.x, true);
  o2[2] += a2 * __builtin_amdgcn_cvt_pk_f32_fp8((int)r.y, false);
  o2[3] += a2 * __builtin_amdgcn_cvt_pk_f32_fp8((int)r.y, true);
  o2[4] += a2 * __builtin_amdgcn_cvt_pk_f32_fp8((int)r.z, false);
  o2[5] += a2 * __builtin_amdgcn_cvt_pk_f32_fp8((int)r.z, true);
  o2[6] += a2 * __builtin_amdgcn_cvt_pk_f32_fp8((int)r.w, false);
  o2[7] += a2 * __builtin_amdgcn_cvt_pk_f32_fp8((int)r.w, true);
}
__device__ __forceinline__ float reduce8(const float (&p)[8], int lane) {
  float q[4], r[2], s;
  const bool b0 = lane & 1, b1 = lane & 2, b2 = lane & 4;
#pragma unroll
  for (int k = 0; k < 4; ++k) { float send = b0 ? p[k] : p[k + 4]; float keep = b0 ? p[k + 4] : p[k]; q[k] = keep + __shfl_xor(send, 1, 64); }
#pragma unroll
  for (int k = 0; k < 2; ++k) { float send = b1 ? q[k] : q[k + 2]; float keep = b1 ? q[k + 2] : q[k]; r[k] = keep + __shfl_xor(send, 2, 64); }
  { float send = b2 ? r[0] : r[1]; float keep = b2 ? r[1] : r[0]; s = keep + __shfl_xor(send, 4, 64); }
  s += __shfl_xor(s, 8, 64); s += __shfl_xor(s, 16, 64); s += __shfl_xor(s, 32, 64);
  return s;
}
#define PEER_LOAD(buf, tab, bt) _Pragma("unroll") for (int k_ = 0; k_ < 8; ++k_) { int e_ = __builtin_amdgcn_readfirstlane(sexp[(bt) * 8 + k_]); buf[k_] = *(const uint4*)(tab + (size_t)e_ * 1024 + lane * 16); }
#define PEER_UCOMP(buf, bt) { float p_[8]; _Pragma("unroll") for (int k_ = 0; k_ < 8; ++k_) p_[k_] = dot16_fp8(buf[k_], xn2); float s_ = reduce8(p_, lane); \
    if ((lane >> 3) == ((bt) & 7)) { if ((bt) < 8) d0 = s_; else d1 = s_; } }
#define PEER_VCOMP(buf, bt) { float asel_ = (bt) < 8 ? act0 : act1; _Pragma("unroll") for (int k_ = 0; k_ < 8; ++k_) { \
    const int br_ = ((k_ & 1) << 2) | (k_ & 2) | ((k_ >> 2) & 1); \
    float a_ = __uint_as_float((unsigned)__builtin_amdgcn_readlane((int)__float_as_uint(asel_), (((bt) & 7) << 3) | br_)); axpy16_fp8(buf[k_], a_, o2); } }

__device__ __forceinline__ void peer_token(const Params& P, int tau, float* sw, bool dry = false) {
  const int lane = threadIdx.x & 63;
  float* scand = sw; int* sexp = (int*)(sw + 64); float* sgate = sw + 192;
  const unsigned char* U8 = (const unsigned char*)P.regZ; const unsigned char* V8 = U8 + (size_t)16777216;
  float* hrow = P.out + (size_t)tau * 1024;
  float x[16]; f32x2 xn2[8];
#pragma unroll
  for (int j = 0; j < 4; ++j) { float4 a = *(const float4*)(hrow + lane * 16 + j * 4); x[j * 4] = a.x; x[j * 4 + 1] = a.y; x[j * 4 + 2] = a.z; x[j * 4 + 3] = a.w; }
  float ss = 0.f;
#pragma unroll
  for (int i = 0; i < 16; ++i) ss += x[i] * x[i];
  ss = wsum(ss);
  const float rstd = rsqrtf(ss * (1.f / 1024.f) + 1e-6f) * (1.f / 256.f);
#pragma unroll
  for (int j = 0; j < 4; ++j) {
    float4 g = *(const float4*)(P.norm_ffn_g + lane * 16 + j * 4);
    xn2[j * 2] = f32x2{x[j * 4] * rstd * g.x, x[j * 4 + 1] * rstd * g.y};
    xn2[j * 2 + 1] = f32x2{x[j * 4 + 2] * rstd * g.z, x[j * 4 + 3] * rstd * g.w};
  }
  int ca, cb; { int c = lane;
    if (c < 16) { ca = 0; cb = c; } else if (c < 24) { ca = 1; cb = c - 16; } else if (c < 29) { ca = 2; cb = c - 24; }
    else if (c < 33) { ca = 3; cb = c - 29; } else if (c < 36) { ca = 4; cb = c - 33; } else if (c < 38) { ca = 5; cb = c - 36; }
    else if (c < 40) { ca = 6; cb = c - 38; } else if (c < 42) { ca = 7; cb = c - 40; } else if (c < 50) { ca = c - 34; cb = 0; } else { ca = 0; cb = 0; } }
  const float* tk = (const float*)P.regB + (size_t)tau * 256;
  float k1n = tk[ca], k2n = tk[16 + cb];
  for (int hh = 0; hh < 8; ++hh) {
    const float k1 = k1n, k2 = k2n;
    { const int hn = hh < 7 ? hh + 1 : 7; k1n = tk[(hn * 2) * 16 + ca]; k2n = tk[(hn * 2 + 1) * 16 + cb]; }
    float s = lane < 50 ? k1 + k2 : -3.0e38f;
    __builtin_amdgcn_wave_barrier();
    scand[lane] = s;
    __builtin_amdgcn_wave_barrier();
    int rank = 0;
#pragma unroll
    for (int c4 = 0; c4 < 13; ++c4) {
      float4 q = *(const float4*)(scand + c4 * 4);
      rank += (q.x > s || (q.x == s && c4 * 4 < lane)) ? 1 : 0;
      rank += (q.y > s || (q.y == s && c4 * 4 + 1 < lane)) ? 1 : 0;
      if (c4 < 12) { rank += (q.z > s || (q.z == s && c4 * 4 + 2 < lane)) ? 1 : 0; rank += (q.w > s || (q.w == s && c4 * 4 + 3 < lane)) ? 1 : 0; }
    }
    bool sel = lane < 50 && rank < 16;
    float mx = wmaxf(s);
    float e = sel ? __expf(s - mx) : 0.f;
    float Z = wsum(e);
    if (sel) { sexp[hh * 16 + rank] = (int)((__float_as_uint(k1) & 127u) * 128u + (__float_as_uint(k2) & 127u)); sgate[hh * 16 + rank] = e / Z; }
  }
  __builtin_amdgcn_wave_barrier();
  float d0 = 0.f, d1 = 0.f;
  uint4 A[8], B[8];
  PEER_LOAD(A, U8, 0)
  for (int b2 = 0; b2 < 8; ++b2) {
    PEER_LOAD(B, U8, 2 * b2 + 1)
    PEER_UCOMP(A, 2 * b2)
    if (b2 < 7) { PEER_LOAD(A, U8, 2 * b2 + 2) } else { PEER_LOAD(A, V8, 0) }
    PEER_UCOMP(B, 2 * b2 + 1)
  }
  const int slotA = (lane & ~7) | ((lane & 1) << 2) | (lane & 2) | ((lane >> 2) & 1);
  const float act0 = gelu_exact(d0) * sgate[slotA] * (1.f / 32.f), act1 = gelu_exact(d1) * sgate[64 + slotA] * (1.f / 32.f);
  f32x2 o2[8];
#pragma unroll
  for (int i = 0; i < 8; ++i) o2[i] = f32x2{0.f, 0.f};
  for (int b2 = 0; b2 < 8; ++b2) {
    PEER_LOAD(B, V8, 2 * b2 + 1)
    PEER_VCOMP(A, 2 * b2)
    if (b2 < 7) { PEER_LOAD(A, V8, 2 * b2 + 2) }
    PEER_VCOMP(B, 2 * b2 + 1)
  }
  float o[16]; float s2 = 0.f;
#pragma unroll
  for (int i = 0; i < 8; ++i) { o[2 * i] = x[2 * i] + o2[i].x; o[2 * i + 1] = x[2 * i + 1] + o2[i].y; }
#pragma unroll
  for (int i = 0; i < 16; ++i) s2 += o[i] * o[i];
  s2 = wsum(s2);
  if (dry) { if (s2 == 123.456f) P.rstd2[tau] = s2; return; }
  if (lane == 0) P.rstd2[tau] = rsqrtf(s2 * (1.f / 1024.f) + 1e-6f);
  bfraw* hb = P.regA + (size_t)tau * 1024;
#pragma unroll
  for (int j = 0; j < 4; ++j) *(float4*)(hrow + lane * 16 + j * 4) = make_float4(o[j * 4], o[j * 4 + 1], o[j * 4 + 2], o[j * 4 + 3]);
  *(uint4*)(hb + lane * 16) = pack8(o); *(uint4*)(hb + lane * 16 + 8) = pack8(o + 8);
}

__device__ __forceinline__ void phase6(const Params& P, char* smem, bool dry = false) {
  const int wid = threadIdx.x >> 6;
  float* sw = (float*)smem + wid * 320;
  for (int tau = blockIdx.x * 4 + wid; tau < NT; tau += gridDim.x * 4) peer_token(P, tau, sw, dry);
}

__device__ __forceinline__ void phase7(const Params& P, char* smem, float* sred) {
  bfraw* sA = (bfraw*)smem; bfraw* sB = sA + 128 * LROW;
  const bfraw* hb = P.regA;
  for (int it = 0;; ++it) {
    int rt, ct; if (!xcd_job(it, 8, 8, rt, ct)) break; int row0 = rt * 128, col0 = ct * 128;
    f32x4 acc[4][4]; ZERO_ACC(acc)
    float* sS = (float*)smem;
    gemm_main(acc, PlainLoad{hb + (size_t)row0 * 1024, 1024}, PlainLoad{P.Wt_pg + (size_t)col0 * 1024, 1024}, 1024, sA, sB);
    acc_to_lds(acc, sS);
#pragma unroll 2
    for (int i = 0; i < 16; ++i) { SEG_VARS(i)
      int tau = row0 + row, c = col0 + c4;
      float rs = P.rstd2[tau];
      float4 hv = *(float4*)(P.out + (size_t)tau * 1024 + c);
      uint2 ep = *(const uint2*)(P.regY + (size_t)tau * 1024 + c);
      hv.x += __uint_as_float(ep.x << 16) * sigmoidf_(v.x * rs);
      hv.y += __uint_as_float(ep.x & 0xffff0000u) * sigmoidf_(v.y * rs);
      hv.z += __uint_as_float(ep.y << 16) * sigmoidf_(v.z * rs);
      hv.w += __uint_as_float(ep.y & 0xffff0000u) * sigmoidf_(v.w * rs);
      *(float4*)(P.out + (size_t)tau * 1024 + c) = hv;
      float ss = hv.x * hv.x + hv.y * hv.y + hv.z * hv.z + hv.w * hv.w;
      ss += __shfl_xor(ss, 1, 64); ss += __shfl_xor(ss, 2, 64); ss += __shfl_xor(ss, 4, 64); ss += __shfl_xor(ss, 8, 64); ss += __shfl_xor(ss, 16, 64);
      if ((etid_ & 31) == 0) P.ssq3[(size_t)ct * NT + tau] = ss; }
  }
}

__device__ __forceinline__ void phase8(const Params& P) {
  for (int job = blockIdx.x; job < NT; job += gridDim.x) {
    int tau = job; int c = threadIdx.x * 4;
    float s = 0.f;
#pragma unroll
    for (int i = 0; i < 8; ++i) s += P.ssq3[(size_t)i * NT + tau];
    float rs = rsqrtf(s * (1.f / 1024.f) + 1e-6f);
    float4 v = *(float4*)(P.out + (size_t)tau * 1024 + c); float4 g = *(const float4*)(P.final_norm_g + c);
    v.x *= rs * g.x; v.y *= rs * g.y; v.z *= rs * g.z; v.w *= rs * g.w;
    *(float4*)(P.out + (size_t)tau * 1024 + c) = v;
  }
}


#define XB_TMO      128
#define XB_XCNT(j)  (256  + 64 * (j))
#define XB_XSUB(j)  (1280 + 64 * (j))
#define XB_XGEN(j)  (2304 + 64 * (j))
#define XB_TOP      3328
#define XB_TOPGEN   3392
#define XCD_BAR_WORDS 3456
#define XB_SPIN_CAP (1u << 18)
#define LAS __attribute__((address_space(3)))
__device__ __forceinline__ unsigned xb_ld(unsigned* p)              { return __hip_atomic_load(p, __ATOMIC_RELAXED, __HIP_MEMORY_SCOPE_AGENT); }
__device__ __forceinline__ unsigned xb_add(unsigned* p, unsigned v) { return __hip_atomic_fetch_add(p, v, __ATOMIC_RELAXED, __HIP_MEMORY_SCOPE_AGENT); }
__device__ __forceinline__ unsigned xb_xcc_id() { return (unsigned)__builtin_amdgcn_s_getreg((3 << 11) | 20) & 0xFu; }
#define XB_SPIN(cond, bar) do { unsigned _sp = 0; while (cond) { __builtin_amdgcn_s_sleep(1); \
    if ((++_sp & 255u) == 0u) { if (xb_ld(&(bar)[XB_TMO])) break; if (_sp > XB_SPIN_CAP) { atomicAdd(&(bar)[XB_TMO], 1u); break; } } } } while (0)
struct XcdBarrier { unsigned* bar; unsigned x; volatile LAS unsigned* st; };
__device__ __forceinline__ XcdBarrier xcd_barrier_post(unsigned* bar, volatile LAS unsigned* st) {
    XcdBarrier b; b.bar = bar; b.x = xb_xcc_id(); b.st = st;
    if (threadIdx.x == 0) (void)xb_add(&bar[XB_XCNT(b.x)], 1u);
    return b;
}
__device__ __forceinline__ void xcd_barrier_complete(unsigned* bar, unsigned x, unsigned& nloc, unsigned& nx) {
    const unsigned G = gridDim.x * gridDim.y * gridDim.z;
    unsigned sum, cnt, mine, sp = 0u;
    for (;;) {
        sum = 0u; cnt = 0u; mine = 0u;
#pragma unroll
        for (unsigned j = 0; j < 16; ++j) { const unsigned c = xb_ld(&bar[XB_XCNT(j)]); sum += c; cnt += (c > 0u) ? 1u : 0u; mine = (j == x) ? c : mine; }
        if (sum == G) break;
        __builtin_amdgcn_s_sleep(1);
        if ((++sp & 255u) == 0u) { if (xb_ld(&bar[XB_TMO])) break; if (sp > XB_SPIN_CAP) { atomicAdd(&bar[XB_TMO], 1u); break; } }
    }
    nloc = mine > 0u ? mine : 1u; nx = cnt > 0u ? cnt : 1u;
}
__device__ __forceinline__ void xcd_barrier(const XcdBarrier& b) {
    asm volatile("s_waitcnt vmcnt(0)" ::: "memory");
    __syncthreads();
    if (threadIdx.x == 0) {
        unsigned* bar = b.bar;
        __builtin_amdgcn_s_waitcnt(0);
        unsigned nloc = b.st[0], nx = b.st[1];
        if (nloc == 0u) { xcd_barrier_complete(bar, b.x, nloc, nx); b.st[0] = nloc; b.st[1] = nx; }
        const unsigned old = xb_add(&bar[XB_XSUB(b.x)], 1u);
        const unsigned gen = old / nloc;
        if (old + 1u == (gen + 1u) * nloc) {
            __builtin_amdgcn_fence(__ATOMIC_RELEASE, "agent");
            asm volatile("s_waitcnt vmcnt(0)" ::: "memory");
            const unsigned og = xb_add(&bar[XB_TOP], 1u);
            const unsigned tg = og / nx;
            if (og + 1u == (tg + 1u) * nx) xb_add(&bar[XB_TOPGEN], 1u);
            else XB_SPIN(xb_ld(&bar[XB_TOPGEN]) == tg, bar);
            __builtin_amdgcn_fence(__ATOMIC_ACQUIRE, "agent");
            xb_add(&bar[XB_XGEN(b.x)], 1u);
            asm volatile("s_waitcnt vmcnt(0)" ::: "memory");
        } else {
            XB_SPIN(xb_ld(&bar[XB_XGEN(b.x)]) == gen, bar);
            __builtin_amdgcn_fence(__ATOMIC_ACQUIRE, "agent");
            asm volatile("s_waitcnt vmcnt(0)" ::: "memory");
        }
    }
    __syncthreads();
}

__global__ void __launch_bounds__(256, 2) mega(Params P) {
  __shared__ __attribute__((aligned(16))) char smem[65536];
  __shared__ float sred[256];
  cg::grid_group grid = cg::this_grid();
  __shared__ uint4 xb_words;
  if (threadIdx.x == 0) xb_words = make_uint4(0u, 0u, 0u, 0u);
  __syncthreads();
  XcdBarrier xb = xcd_barrier_post(P.bar, (volatile LAS unsigned*)&xb_words);
  if (P.phase_hi > 1000) grid.sync();
#ifndef REPMASK
#define REPMASK 0
#endif
#define RUNPH(n, call) if (P.phase_lo <= n && n < P.phase_hi) { call; if ((REPMASK >> n) & 1) { call; } if (n + 1 < P.phase_hi) xcd_barrier(xb); }
  RUNPH(0, phase0(P, smem))
  RUNPH(1, phase1(P, smem))
  RUNPH(2, phase2(P, smem))
  RUNPH(3, phase3a(P, smem))
  RUNPH(4, phase3x(P, smem))
  RUNPH(5, phase3b(P, smem, sred))
  RUNPH(6, phase3c(P))
  RUNPH(7, phase4(P, smem, sred))
  RUNPH(8, phase5(P, smem, sred))
  RUNPH(9, phase6(P, smem))
  RUNPH(10, phase7(P, smem, sred))
  RUNPH(11, phase8(P))
}

extern "C" void kernel_launch(void* const* d_in, const int* in_sizes, int n_in, void* d_out, int out_size, void* d_ws, size_t ws_size,
                              hipStream_t stream) {
  static int grid_blocks = 0;
  if (!grid_blocks) {
    int dev = 0, cus = 0, per_cu = 0;
    hipGetDevice(&dev);
    hipDeviceGetAttribute(&cus, hipDeviceAttributeMultiprocessorCount, dev);
    hipOccupancyMaxActiveBlocksPerMultiprocessor(&per_cu, mega, 256, 0);
    if (per_cu > 2) per_cu = 2;
    grid_blocks = cus * per_cu;
  }
  Params P{};
  const float** pf = (const float**)&P;
  for (int i = 0; i < 32; ++i) pf[i] = (const float*)d_in[i];
  P.out = (float*)d_out;
  char* w = (char*)d_ws; size_t off = 0;
  auto take = [&](size_t bytes) { char* p = w + off; off += (bytes + 255) & ~(size_t)255; return p; };
  P.Wt_in = (bfraw*)take((size_t)2304 * LDP * 2);
  P.Wt_out = (bfraw*)take((size_t)1024 * 1024 * 2);
  P.Wt_q = (bfraw*)take((size_t)2048 * 1024 * 2);
  P.Wt_pg = (bfraw*)take((size_t)1024 * 1024 * 2);
  P.Wt_ple = (bfraw*)take((size_t)1024 * 256 * 2);
  P.Wt_dec = (bfraw*)take((size_t)512 * 64 * 2);
  P.Wt_a = (bfraw*)take((size_t)512 * 64 * 2);
  P.Wt_g = (bfraw*)take((size_t)512 * 128 * 2);
  P.Wt_pool = (bfraw*)take((size_t)4 * 128 * 128 * 2);
  P.ssq1 = (float*)take((size_t)8 * NT * 4);
  P.rstd2 = (float*)take((size_t)NT * 4);
  P.ssq3 = (float*)take((size_t)8 * NT * 4);
  P.Sbuf = P.ssq1;
  P.regA = (bfraw*)take((size_t)NT * LDP * 2);
  P.regB = (bfraw*)take((size_t)NT * 1024 * 2);
  P.regY = (bfraw*)take((size_t)NT * 1024 * 2);
  P.bar = (unsigned*)take((size_t)4096 * 4);
  P.bonus = (float*)take((size_t)NPR * 8 * 4);
  P.regPQ = (bfraw*)take((size_t)4096 * 12288);
  P.regP = (bfraw*)take((size_t)NT * 512 * 2);
  P.regZ = (bfraw*)take((size_t)NT * 2304 * 2);
  P.phase_lo = 0; P.phase_hi = 12;
  hipMemsetAsync(P.bar, 0, 4096 * 4, stream);
  void* args[] = {&P};
  hipError_t e = hipLaunchCooperativeKernel((void*)mega, dim3(grid_blocks), dim3(256), args, 0, stream);
  if (e != hipSuccess) fprintf(stderr, "cooperative launch failed: %s (grid %d)\n", hipGetErrorString(e), grid_blocks);
}
```
